# Optimizing an MI355X kernel written in HIP

```python
import jax, jax.numpy as jnp
from jax import lax
import numpy as np

D_MODEL = 1024
BATCH = 2
SEQ = 8192
DEPTH = 1

MEM_LEN = 256
EPS = 1e-6

M_HEADS = 4
M_DV = D_MODEL // 8
M_DQK = M_DV // 2
M_CONV = 4
M_CHUNK = 64

A_HEADS = 8
A_KV_HEADS = 2
A_DH = 64
WINDOW = 128
A_BLOCK = 128

X_HEADS = 4
X_DH = D_MODEL // X_HEADS

P_HEADS = 8
P_NKEYS = 128
P_EXPERTS = P_NKEYS * P_NKEYS
P_KEY_DIM = 128
P_TOPK = 16
P_TOKEN_BLOCK = 128

IN_SIZES = (M_HEADS * M_DQK, M_HEADS * M_DQK, M_HEADS * M_DV, M_HEADS * M_DV, M_HEADS, M_HEADS,
            A_HEADS * A_DH, A_KV_HEADS * A_DH, A_KV_HEADS * A_DH)
P_IN = sum(IN_SIZES)
MIX_WIDTH = M_HEADS * M_DV + A_HEADS * A_DH

kernel_name = "hybrid_mlstm_swa_sinks_peer_layer"


def rmsnorm(x, g):
    xf = x.astype(jnp.float32)
    y = xf * lax.rsqrt(jnp.mean(xf * xf, axis=-1, keepdims=True) + EPS)
    return (y * g.astype(jnp.float32)).astype(x.dtype)


def causal_depthwise_conv(x, w, b):
    y = lax.conv_general_dilated(
        x, w[:, None, :].astype(x.dtype), window_strides=(1,),
        padding=[(w.shape[0] - 1, 0)], dimension_numbers=('NWC', 'WIO', 'NWC'),
        feature_group_count=x.shape[-1])
    return y + b.astype(x.dtype)


def mlstm_chunkwise(q, k, v, i_pre, f_pre):
    B, S, H, _ = q.shape
    L = M_CHUNK
    nc = S // L
    f32 = jnp.float32

    def chunks(t):
        t = t.astype(f32).reshape((B, nc, L, H) + t.shape[3:])
        return jnp.moveaxis(t, (1, 3), (0, 2))

    qc = chunks(q) * (M_DQK ** -0.5)
    kc = chunks(k)
    vc = chunks(v)
    ic = chunks(i_pre)
    lfc = chunks(jax.nn.log_sigmoid(f_pre.astype(f32)))
    causal = jnp.tril(jnp.ones((L, L), dtype=bool))

    def step(carry, inp):
        C, n, m = carry
        qb, kb, vb, ib, lfb = inp
        b = jnp.cumsum(lfb, axis=-1)
        log_d = jnp.where(causal, b[..., :, None] - b[..., None, :] + ib[..., None, :], -jnp.inf)
        inter = b + m[..., None]
        m_t = jnp.maximum(inter, jnp.max(log_d, axis=-1))
        d = jnp.exp(log_d - m_t[..., None])
        s = jnp.einsum('bhtk,bhsk->bhts', qb, kb) * d
        w_inter = jnp.exp(inter - m_t)
        num = jnp.einsum('bhts,bhsv->bhtv', s, vb) + w_inter[..., None] * jnp.einsum('bhvk,bhtk->bhtv', C, qb)
        den = jnp.sum(s, axis=-1) + w_inter * jnp.einsum('bhk,bhtk->bht', n, qb)
        h = num / jnp.maximum(jnp.abs(den), jnp.exp(-m_t))[..., None]
        m_new = m_t[..., -1]
        w = jnp.exp(b[..., -1:] - b + ib - m_new[..., None])
        decay = jnp.exp(b[..., -1] + m - m_new)
        C_new = decay[..., None, None] * C + jnp.einsum('bhs,bhsv,bhsk->bhvk', w, vb, kb)
        n_new = decay[..., None] * n + jnp.einsum('bhs,bhsk->bhk', w, kb)
        return (C_new, n_new, m_new), h

    init = (jnp.zeros((B, H, M_DV, M_DQK), f32), jnp.zeros((B, H, M_DQK), f32), jnp.zeros((B, H), f32))
    _, h = lax.scan(step, init, (qc, kc, vc, ic, lfc))
    h = jnp.moveaxis(h, (0, 2), (1, 3)).reshape(B, S, H, M_DV)
    return h.astype(v.dtype)


def sliding_window_gqa_sinks(q, k, v, sinks):
    B, S, Hq, dh = q.shape
    Hkv = k.shape[2]
    G = Hq // Hkv
    nb = S // A_BLOCK
    f32 = jnp.float32
    qb = q.astype(f32).reshape(B, nb, A_BLOCK, Hkv, G, dh)

    def band_blocks(t):
        t = t.astype(f32)
        prev = jnp.concatenate([jnp.zeros_like(t[:, :A_BLOCK]), t[:, :S - A_BLOCK]], axis=1)
        return jnp.concatenate([prev.reshape(B, nb, A_BLOCK, Hkv, dh),
                                t.reshape(B, nb, A_BLOCK, Hkv, dh)], axis=2)

    kb = band_blocks(k)
    vb = band_blocks(v)
    qi = jnp.arange(A_BLOCK)[:, None]
    kj = jnp.arange(2 * A_BLOCK)[None, :]
    diff = qi - kj + A_BLOCK
    band = (diff >= 0) & (diff < WINDOW)
    exists = (jnp.arange(nb)[:, None, None] > 0) | (kj >= A_BLOCK)[None]
    mask = band[None] & exists

    scores = jnp.einsum('bnqhgd,bnkhd->bnhgqk', qb, kb) * (dh ** -0.5)
    scores = jnp.where(mask[None, :, None, None], scores, -jnp.inf)
    sink = sinks.astype(f32).reshape(Hkv, G)[None, None, :, :, None, None]
    mx = jnp.maximum(jnp.max(scores, axis=-1, keepdims=True), sink)
    p = jnp.exp(scores - mx)
    probs = p / (jnp.sum(p, axis=-1, keepdims=True) + jnp.exp(sink - mx))
    out = jnp.einsum('bnhgqk,bnkhd->bnqhgd', probs, vb)
    return out.reshape(B, S, Hq * dh).astype(q.dtype)


def memory_cross_attention(xn, memn, w_q, w_k, w_v, w_o):
    B, S, D = xn.shape
    M = memn.shape[1]
    f32 = jnp.float32
    q = (xn @ w_q).reshape(B, S, X_HEADS, X_DH).astype(f32)
    k = (memn @ w_k).reshape(B, M, X_HEADS, X_DH).astype(f32)
    v = (memn @ w_v).reshape(B, M, X_HEADS, X_DH).astype(f32)
    p = jax.nn.softmax(jnp.einsum('bshd,bmhd->bhsm', q, k) * (X_DH ** -0.5), axis=-1)
    o = jnp.einsum('bhsm,bmhd->bshd', p, v).reshape(B, S, X_HEADS * X_DH).astype(xn.dtype)
    return o @ w_o


def peer_ffn(xn, w_pq, sub_keys1, sub_keys2, expert_down, expert_up):
    B, S, D = xn.shape
    T = P_TOKEN_BLOCK
    xt = xn.reshape(-1, T, D)

    def block(xb):
        qh = (xb @ w_pq).reshape(T, P_HEADS, 2, P_KEY_DIM).astype(jnp.float32)
        s1 = jnp.einsum('thd,nd->thn', qh[:, :, 0], sub_keys1.astype(jnp.float32))
        s2 = jnp.einsum('thd,nd->thn', qh[:, :, 1], sub_keys2.astype(jnp.float32))
        v1, i1 = lax.top_k(s1, P_TOPK)
        v2, i2 = lax.top_k(s2, P_TOPK)
        cand_s = (v1[..., :, None] + v2[..., None, :]).reshape(T, P_HEADS, P_TOPK * P_TOPK)
        cand_i = (i1[..., :, None] * P_NKEYS + i2[..., None, :]).reshape(T, P_HEADS, P_TOPK * P_TOPK)
        top_s, pos = lax.top_k(cand_s, P_TOPK)
        eidx = jnp.take_along_axis(cand_i, pos, axis=-1)
        g = jax.nn.softmax(top_s, axis=-1)
        u = expert_down[eidx]
        a = jax.nn.gelu(jnp.einsum('thkd,td->thk', u, xb), approximate=False)
        coef = (g * a.astype(jnp.float32)).astype(xb.dtype)
        return jnp.einsum('thk,thkd->td', coef, expert_up[eidx])

    return lax.map(block, xt).reshape(B, S, D)


def setup_inputs(seed: int = 0) -> dict:
    key = jax.random.key(seed)
    ks = jax.random.split(key, 24)
    f32 = jnp.float32

    def nrm(k, shape, scale):
        return jax.random.normal(k, shape, f32) * scale

    Dn = D_MODEL ** -0.5
    qk_ch = 2 * M_HEADS * M_DQK
    return {
        "x": nrm(ks[0], (BATCH, SEQ, D_MODEL), 1.0),
        "mem": nrm(ks[1], (BATCH, MEM_LEN, D_MODEL), 1.0),
        "g_mix": 1.0 + nrm(ks[2], (DEPTH, D_MODEL), 0.02),
        "w_in": nrm(ks[3], (DEPTH, D_MODEL, P_IN), Dn),
        "conv_w": nrm(ks[4], (DEPTH, M_CONV, qk_ch), M_CONV ** -0.5),
        "conv_b": nrm(ks[5], (DEPTH, qk_ch), 0.02),
        "b_igate": nrm(ks[6], (DEPTH, M_HEADS), 0.1),
        "b_fgate": jnp.linspace(3.0, 6.0, M_HEADS, dtype=f32)[None] + nrm(ks[7], (DEPTH, M_HEADS), 0.1),
        "g_mhead": 1.0 + nrm(ks[8], (DEPTH, M_HEADS * M_DV), 0.02),
        "sinks": nrm(ks[9], (DEPTH, A_HEADS), 0.5),
        "w_out": nrm(ks[10], (DEPTH, MIX_WIDTH, D_MODEL), MIX_WIDTH ** -0.5),
        "g_cross": 1.0 + nrm(ks[11], (DEPTH, D_MODEL), 0.02),
        "g_mem": 1.0 + nrm(ks[12], (DEPTH, D_MODEL), 0.02),
        "w_xq": nrm(ks[13], (DEPTH, D_MODEL, X_HEADS * X_DH), Dn),
        "w_xk": nrm(ks[14], (DEPTH, D_MODEL, X_HEADS * X_DH), Dn),
        "w_xv": nrm(ks[15], (DEPTH, D_MODEL, X_HEADS * X_DH), Dn),
        "w_xo": nrm(ks[16], (DEPTH, X_HEADS * X_DH, D_MODEL), (X_HEADS * X_DH) ** -0.5),
        "g_ffn": 1.0 + nrm(ks[17], (DEPTH, D_MODEL), 0.02),
        "w_pq": nrm(ks[18], (DEPTH, D_MODEL, P_HEADS * 2 * P_KEY_DIM), Dn),
        "sub_keys1": nrm(ks[19], (DEPTH, P_NKEYS, P_KEY_DIM), P_KEY_DIM ** -0.5),
        "sub_keys2": nrm(ks[20], (DEPTH, P_NKEYS, P_KEY_DIM), P_KEY_DIM ** -0.5),
        "expert_down": nrm(ks[21], (DEPTH, P_EXPERTS, D_MODEL), Dn),
        "expert_up": nrm(ks[22], (DEPTH, P_EXPERTS, D_MODEL), Dn),
        "g_final": 1.0 + nrm(ks[23], (D_MODEL,), 0.02),
    }


def reference(x, mem, g_mix, w_in, conv_w, conv_b, b_igate, b_fgate, g_mhead, sinks, w_out,
              g_cross, g_mem, w_xq, w_xk, w_xv, w_xo, g_ffn, w_pq, sub_keys1, sub_keys2,
              expert_down, expert_up, g_final):
    B, S, _ = x.shape
    split_points = [int(c) for c in np.cumsum(IN_SIZES)[:-1]]
    h = x
    for l in range(DEPTH):
        xn = rmsnorm(h, g_mix[l])
        proj = xn @ w_in[l]
        mq, mk, mv, mo, mi, mf, aq, ak, av = jnp.split(proj, split_points, axis=-1)
        qk = jax.nn.silu(causal_depthwise_conv(jnp.concatenate([mq, mk], axis=-1), conv_w[l], conv_b[l]))
        mq, mk = jnp.split(qk, 2, axis=-1)
        hm = mlstm_chunkwise(mq.reshape(B, S, M_HEADS, M_DQK), mk.reshape(B, S, M_HEADS, M_DQK),
                             mv.reshape(B, S, M_HEADS, M_DV),
                             mi + b_igate[l].astype(mi.dtype), mf + b_fgate[l].astype(mf.dtype))
        hm = rmsnorm(hm, g_mhead[l].reshape(M_HEADS, M_DV)).reshape(B, S, M_HEADS * M_DV)
        hm = (jax.nn.sigmoid(mo) * hm).astype(x.dtype)
        ha = sliding_window_gqa_sinks(aq.reshape(B, S, A_HEADS, A_DH), ak.reshape(B, S, A_KV_HEADS, A_DH),
                                      av.reshape(B, S, A_KV_HEADS, A_DH), sinks[l])
        h = h + jnp.concatenate([hm, ha], axis=-1) @ w_out[l]
        h = h + memory_cross_attention(rmsnorm(h, g_cross[l]), rmsnorm(mem, g_mem[l]),
                                       w_xq[l], w_xk[l], w_xv[l], w_xo[l])
        h = h + peer_ffn(rmsnorm(h, g_ffn[l]), w_pq[l], sub_keys1[l], sub_keys2[l],
                         expert_down[l], expert_up[l])
    return rmsnorm(h, g_final)
```

```cpp
#include <hip/hip_runtime.h>
#include <cstdio>
#include <cstdint>
namespace pg8 {
#define PG8_LAS __attribute__((address_space(3)))
typedef unsigned short bf16_t;
typedef short bf16x8 __attribute__((ext_vector_type(8)));
typedef float f32x4 __attribute__((ext_vector_type(4)));
typedef unsigned u32x4 __attribute__((ext_vector_type(4)));
constexpr int BM = 256, BK = 64, HALF = 128, HTB = HALF * BK * 2  , STAGE_BYTES = 8 * HTB, NXCD = 8, WGM = 8;

__host__ __device__ __forceinline__ int lds_byte(int r, int c) { const int st = (r >> 4) * 2 + (c >> 5), rr = r & 15, cc = c & 31, ob = rr * 64 + cc * 2; return st * 1024 + (ob ^ (((ob >> 9) & 1) << 5)); }
__host__ __device__ __forceinline__ void stage_rc(int b, int& R, int& C) { const int st = b / 1024, sb = b % 1024, swz = sb ^ (((sb >> 9) & 1) << 5); R = (st >> 1) * 16 + swz / 64; C = (st & 1) * 32 + (swz % 64) / 2; }
__host__ __device__ __forceinline__ int perm32(int rho) { const int n = rho >> 4, i = rho & 15; return 8 * (i >> 2) + 4 * n + (i & 3); }

struct Unit { int pm, pn; };
struct Gemm { const bf16_t* A; const bf16_t* Bt; int M, N, K; };

struct StaticOrder {
    int nM, nN, nwg, G, c;
    __host__ __device__ void init(int M, int N, int G_, int c_) { nM = M / BM; nN = N / BM; nwg = nM * nN; G = G_; c = c_; }
    __host__ __device__ bool next(int i, Unit& u) const {
        const long L = (long)i * G + c; if (L >= nwg) return false;
        int wgid = (int)L; { const int q = nwg / NXCD, r = nwg % NXCD, xcd = wgid % NXCD, off = wgid / NXCD; wgid = (xcd < r ? xcd * (q + 1) : r * (q + 1) + (xcd - r) * q) + off; }
        const int nig = WGM * nN, gid = wgid / nig, fm = gid * WGM, gsz = (nM - fm) < WGM ? (nM - fm) : WGM;
        u.pm = fm + ((wgid % nig) % gsz); u.pn = (wgid % nig) / gsz; return true;
    }
    __device__ __forceinline__ void a_ready(const Unit&) const {}
    __device__ __forceinline__ void done(const Unit&) const {}
};
__device__ __forceinline__ unsigned cvt_pk_bf16(float lo, float hi) { unsigned r; asm volatile("v_cvt_pk_bf16_f32 %0, %1, %2" : "=v"(r) : "v"(lo), "v"(hi)); return r; }
typedef float f32x2 __attribute__((ext_vector_type(2)));
__device__ __forceinline__ f32x2 gelu_pk(f32x2 v) {
    const f32x2 av = __builtin_elementwise_abs(v), d = av * 0.2316418882f + 1.0f;
    f32x2 t; t.x = __builtin_amdgcn_rcpf(d.x); t.y = __builtin_amdgcn_rcpf(d.y);
    f32x2 q = t * 0.5307027145f + (-0.7265760135f); q = q * t + 0.7107068705f; q = q * t + (-0.142248368f); q = q * t + 0.127414796f; q = q * t;
    const f32x2 s = (v * v) * (-0.72134752044f);
    f32x2 e; e.x = __builtin_amdgcn_exp2f(s.x); e.y = __builtin_amdgcn_exp2f(s.y);
    const f32x2 m = v * (q * e), r = v - m;
    f32x2 o; o.x = v.x < 0.f ? m.x : r.x; o.y = v.y < 0.f ? m.y : r.y; return o;
}

template <class Epi, class Sched, bool STAMP = false>
__device__ __forceinline__ void gemm_phase(PG8_LAS unsigned char* lds, const Gemm g, const Sched& S, const Epi& E, unsigned long long* stamps) {
    const int tid = threadIdx.x, wid = __builtin_amdgcn_readfirstlane(tid >> 6), lane = tid & 63, wr = wid >> 2, wc = wid & 3, fr = lane & 15, fq = lane >> 4;
    const int K = g.K, nt = K / BK;
    int ts_lo = 0, ts_hi = 0, nts = 0; const unsigned long long rt_entry = STAMP ? (unsigned long long)wall_clock64() : 0ull;
#define PG8_STAMP() do { if (STAMP && wid == 0 && nts < 64) { const unsigned long long _c = (unsigned long long)clock64(); \
        ts_lo = (lane == nts) ? (int)(unsigned)_c : ts_lo; ts_hi = (lane == nts) ? (int)(unsigned)(_c >> 32) : ts_hi; ++nts; } } while (0)
    PG8_STAMP();
    unsigned voffA[2], voffB[2];
#pragma unroll
    for (int i = 0; i < 2; ++i) { int R, C; stage_rc(tid * 16 + i * 8192, R, C); const int Rb = Epi::PERM ? ((R & ~31) + perm32(R & 31)) : R;
        voffA[i] = (unsigned)(R * K + C) * 2u; voffB[i] = (unsigned)(Rb * K + C) * 2u; }
    const size_t kstep = (size_t)(BK * 2);
    const size_t hstep = (size_t)HALF * K * 2;
    const size_t tstep = 2 * hstep;
    const unsigned ldsw = (unsigned)wid * 1024u;
    const int aoff = lds_byte(wr * 64 + fr, fq * 8), boff = lds_byte(wc * 32 + fr, fq * 8);
#define PG8_SA(b, h) (((b) * 2 + (h)) * HTB)
#define PG8_SB(b, h) ((4 + (b) * 2 + (h)) * HTB)
#define PG8_STAGE(bufoff, gbase, voff) do { _Pragma("unroll") for (int _i = 0; _i < 2; ++_i) \
        __builtin_amdgcn_global_load_lds((const unsigned*)((const char*)(gbase) + (voff)[_i]), (PG8_LAS unsigned*)(lds + (bufoff) + ldsw + _i * 8192), 16, 0, 0); } while (0)
#define PG8_LDA(dst, b, h) do { _Pragma("unroll") for (int m = 0; m < 4; ++m) _Pragma("unroll") for (int k = 0; k < 2; ++k) dst[m][k] = *(const PG8_LAS bf16x8*)(lds + PG8_SA(b, h) + aoff + m * 2048 + k * 1024); } while (0)
#define PG8_LDB(dst, b, h) do { _Pragma("unroll") for (int n = 0; n < 2; ++n) _Pragma("unroll") for (int k = 0; k < 2; ++k) dst[n][k] = *(const PG8_LAS bf16x8*)(lds + PG8_SB(b, h) + boff + n * 2048 + k * 1024); } while (0)
#define PG8_MMA(ai, bj, At, Bt) do { __builtin_amdgcn_s_setprio(1); _Pragma("unroll") for (int m = 0; m < 4; ++m) _Pragma("unroll") for (int n = 0; n < 2; ++n) _Pragma("unroll") for (int k = 0; k < 2; ++k) \
        acc[ai][bj][m][n] = __builtin_amdgcn_mfma_f32_16x16x32_bf16(Bt[n][k], At[m][k], acc[ai][bj][m][n], 0, 0, 0); __builtin_amdgcn_s_setprio(0); } while (0)
#define PG8_WAIT_V(n) asm volatile("s_waitcnt vmcnt(" #n ")" ::: "memory")
#define PG8_WAIT_L(n) asm volatile("s_waitcnt lgkmcnt(" #n ")" ::: "memory")
#define PG8_BAR __builtin_amdgcn_s_barrier()
#define PG8_SCHED __builtin_amdgcn_sched_barrier(0)
    Unit cur, nxt; int ui = 0;
    if (!S.next(0, cur)) return;
    f32x4 acc[2][2][4][2];
#pragma unroll
    for (int a = 0; a < 2; ++a)
#pragma unroll
        for (int b = 0; b < 2; ++b)
#pragma unroll
            for (int m = 0; m < 4; ++m)
#pragma unroll
                for (int n = 0; n < 2; ++n) acc[a][b][m][n] = (f32x4){0.f, 0.f, 0.f, 0.f};
    bf16x8 At[4][2], B0[2][2], B1[2][2];
    const char* cA = (const char*)g.A + (size_t)cur.pm * tstep; const char* cB = (const char*)g.Bt + (size_t)cur.pn * tstep;
    S.a_ready(cur);
    PG8_STAGE(PG8_SB(0, 0), cB, voffB); PG8_STAGE(PG8_SA(0, 0), cA, voffA); PG8_STAGE(PG8_SB(0, 1), cB + hstep, voffB); PG8_STAGE(PG8_SA(0, 1), cA + hstep, voffA);
    if (wr == 1) PG8_BAR;
    PG8_WAIT_V(4); PG8_BAR;
    PG8_STAGE(PG8_SB(1, 0), cB + kstep, voffB); PG8_STAGE(PG8_SA(1, 0), cA + kstep, voffA); PG8_STAGE(PG8_SB(1, 1), cB + hstep + kstep, voffB);
    PG8_WAIT_V(6); PG8_BAR;
    PG8_STAMP();
    for (;;) {
        const bool has_next = S.next(ui + 1, nxt);
        const char* nA = has_next ? (const char*)g.A + (size_t)nxt.pm * tstep : cA; const char* nB = has_next ? (const char*)g.Bt + (size_t)nxt.pn * tstep : cB;
        for (int t = 0; t < nt; t += 2) {
            const bool last = (t == nt - 2);
            const char* a1 = cA + (size_t)(t + 1) * kstep;
            const char* a2 = last ? nA : cA + (size_t)(t + 2) * kstep; const char* b2 = last ? nB : cB + (size_t)(t + 2) * kstep;
            const char* a3 = a2 + kstep; const char* b3 = b2 + kstep;
            if (last && has_next) S.a_ready(nxt);
            PG8_LDB(B0, 0, 0); PG8_SCHED; PG8_LDA(At, 0, 0); PG8_STAGE(PG8_SA(1, 1), a1 + hstep, voffA);
            PG8_WAIT_L(8); PG8_BAR; PG8_WAIT_L(0); PG8_MMA(0, 0, At, B0); PG8_BAR; PG8_SCHED;
            PG8_LDB(B1, 0, 1); PG8_STAGE(PG8_SB(0, 0), b2, voffB);
            PG8_BAR; PG8_WAIT_L(0); PG8_MMA(0, 1, At, B1); PG8_BAR;
            PG8_LDA(At, 0, 1); PG8_STAGE(PG8_SA(0, 0), a2, voffA);
            PG8_BAR; PG8_WAIT_L(0); PG8_MMA(1, 0, At, B0); PG8_BAR; PG8_SCHED;
            PG8_STAGE(PG8_SB(0, 1), b2 + hstep, voffB);
            PG8_WAIT_V(6); PG8_BAR; PG8_MMA(1, 1, At, B1); PG8_BAR;
            PG8_LDB(B0, 1, 0); PG8_SCHED; PG8_LDA(At, 1, 0); PG8_STAGE(PG8_SA(0, 1), a2 + hstep, voffA);
            PG8_WAIT_L(8); PG8_BAR; PG8_WAIT_L(0); PG8_MMA(0, 0, At, B0); PG8_BAR; PG8_SCHED;
            PG8_LDB(B1, 1, 1); PG8_STAGE(PG8_SB(1, 0), b3, voffB);
            PG8_BAR; PG8_WAIT_L(0); PG8_MMA(0, 1, At, B1); PG8_BAR;
            PG8_LDA(At, 1, 1); PG8_STAGE(PG8_SA(1, 0), a3, voffA);
            PG8_BAR; PG8_WAIT_L(0); PG8_MMA(1, 0, At, B0); PG8_BAR; PG8_SCHED;
            PG8_STAGE(PG8_SB(1, 1), b3 + hstep, voffB);
            PG8_WAIT_V(6); PG8_BAR; PG8_MMA(1, 1, At, B1); PG8_BAR;
        }
        PG8_STAMP();
        if constexpr (!Epi::AFTER_DRAIN) { E(acc, cur, wr, wc, fr, fq); S.done(cur); }
        PG8_STAMP();
        if (!has_next) break;
#pragma unroll
        for (int a = 0; a < 2; ++a)
#pragma unroll
            for (int b = 0; b < 2; ++b)
#pragma unroll
                for (int m = 0; m < 4; ++m)
#pragma unroll
                    for (int n = 0; n < 2; ++n) acc[a][b][m][n] = (f32x4){0.f, 0.f, 0.f, 0.f};
        cur = nxt; cA = nA; cB = nB; ++ui;
    }
    PG8_WAIT_V(0);
    if (wr == 0) PG8_BAR;
    PG8_BAR;
    if constexpr (Epi::AFTER_DRAIN) { E.fused(acc, cur, wr, wc, fr, fq, lds, wid, lane); S.done(cur); }
    PG8_STAMP();
    if (STAMP && wid == 0) { stamps[lane] = lane < nts ? (((unsigned long long)(unsigned)ts_hi << 32) | (unsigned)ts_lo) : 0ull;
        if (lane == 62) stamps[62] = rt_entry; if (lane == 63) stamps[63] = (unsigned long long)wall_clock64(); }
#undef PG8_STAMP
#undef PG8_SA
#undef PG8_SB
#undef PG8_STAGE
#undef PG8_LDA
#undef PG8_LDB
#undef PG8_MMA
#undef PG8_WAIT_V
#undef PG8_WAIT_L
#undef PG8_BAR
#undef PG8_SCHED
}
}

#define LAS __attribute__((address_space(3)))
typedef unsigned short bf16_t;
typedef short bf16x8 __attribute__((ext_vector_type(8)));
typedef short bf16x4 __attribute__((ext_vector_type(4)));
typedef float f32x4 __attribute__((ext_vector_type(4)));
typedef unsigned u32x4 __attribute__((ext_vector_type(4)));
typedef unsigned u32x2 __attribute__((ext_vector_type(2)));

constexpr int D = 1024, NB = 2, SEQ = 8192, MTOK = NB * SEQ, MEMLEN = 256;
constexpr int NPROJ = 2304;
constexpr int C_MQ = 0, C_MK = 256, C_MV = 512, C_MO = 1024, C_AQ = 1536, C_AK = 2048, C_AV = 2176;
constexpr float EPS = 1e-6f;
constexpr int NTHREADS = 512, NWAVES = 8;
constexpr int LDS_BYTES = 144 * 1024;

constexpr size_t MiB = (size_t)1 << 20;
constexpr size_t WS_A = 0;
constexpr size_t WS_B = 72 * MiB;
constexpr size_t WS_C = 104 * MiB;
constexpr size_t WS_ED = 136 * MiB;
constexpr size_t WS_EU = 168 * MiB;
constexpr size_t WS_WIN = 200 * MiB;
constexpr size_t WS_WOUT = WS_WIN + 2304 * 1024 * 2;
constexpr size_t WS_WXQ = WS_WOUT + 2 * MiB;
constexpr size_t WS_WXKV = WS_WXQ + 2 * MiB;
constexpr size_t WS_WXO = WS_WXKV + 4 * MiB;
constexpr size_t WS_WPQ = WS_WXO + 2 * MiB;
constexpr size_t WS_G = 219 * MiB;
constexpr size_t WS_GATES = WS_G;
constexpr size_t WS_KMEM = WS_GATES + 512 * 1024;
constexpr size_t WS_VTMEM = WS_KMEM + MiB;
constexpr size_t WS_SSQ = WS_VTMEM + MiB;
constexpr size_t WS_DN = WS_SSQ + MiB;
constexpr size_t WS_DECAY = WS_DN + 256 * 1024;
constexpr size_t WS_SK = WS_DECAY + 4096;
constexpr size_t WS_BAR = 223 * MiB;
constexpr size_t WS_END = 224 * MiB;

struct Args {
    const float* in[24];
    float* out;
    unsigned char* ws;
    int ph_lo, ph_hi;
};
enum { I_X = 0, I_MEM, I_GMIX, I_WIN, I_CONVW, I_CONVB, I_BI, I_BF, I_GMHEAD, I_SINKS, I_WOUT, I_GCROSS, I_GMEM, I_WXQ, I_WXK, I_WXV, I_WXO,
       I_GFFN, I_WPQ, I_SK1, I_SK2, I_EDOWN, I_EUP, I_GFINAL };

typedef __bf16 bf16x2_t __attribute__((ext_vector_type(2)));
typedef float f32x2_t __attribute__((ext_vector_type(2)));
__device__ __forceinline__ unsigned pk2(float lo, float hi) { f32x2_t v = {lo, hi}; bf16x2_t b = __builtin_convertvector(v, bf16x2_t); return __builtin_bit_cast(unsigned, b); }
__device__ __forceinline__ bf16_t f2bf(float f) { return (bf16_t)(pk2(f, 0.f) & 0xffffu); }
__device__ __forceinline__ float bf2f(unsigned b) { return __uint_as_float(b << 16); }
__device__ __forceinline__ float bflo(unsigned w) { return __uint_as_float(w << 16); }
__device__ __forceinline__ float bfhi(unsigned w) { return __uint_as_float(w & 0xffff0000u); }
__device__ __forceinline__ float wave_sum(float v) {
#pragma unroll
    for (int o = 1; o < 64; o <<= 1) v += __shfl_xor(v, o);
    return v;
}
__device__ __forceinline__ float sigmoidf_(float x) { return 1.f / (1.f + __expf(-x)); }
#define LDS_FENCE() asm volatile("s_waitcnt lgkmcnt(0)" ::: "memory")

__device__ __forceinline__ unsigned dppu(unsigned x, int ctrl_sel) {
    switch (ctrl_sel) {
        case 0: return (unsigned)__builtin_amdgcn_update_dpp(0, (int)x, 0xB1, 0xF, 0xF, true);
        case 1: return (unsigned)__builtin_amdgcn_update_dpp(0, (int)x, 0x4E, 0xF, 0xF, true);
        case 2: return (unsigned)__builtin_amdgcn_update_dpp(0, (int)x, 0x141, 0xF, 0xF, true);
        default: return (unsigned)__builtin_amdgcn_update_dpp(0, (int)x, 0x140, 0xF, 0xF, true);
    }
}
__device__ __forceinline__ unsigned row16_max_u32(unsigned x) {
    unsigned y;
    y = dppu(x, 0); x = x > y ? x : y;
    y = dppu(x, 1); x = x > y ? x : y;
    y = dppu(x, 2); x = x > y ? x : y;
    y = dppu(x, 3); x = x > y ? x : y;
    return x;
}
__device__ __forceinline__ float row16_sum_f32(float x) {
    x += __uint_as_float(dppu(__float_as_uint(x), 0));
    x += __uint_as_float(dppu(__float_as_uint(x), 1));
    x += __uint_as_float(dppu(__float_as_uint(x), 2));
    x += __uint_as_float(dppu(__float_as_uint(x), 3));
    return x;
}
__device__ __forceinline__ float row16_max_f32(float x) {
    x = fmaxf(x, __uint_as_float(dppu(__float_as_uint(x), 0)));
    x = fmaxf(x, __uint_as_float(dppu(__float_as_uint(x), 1)));
    x = fmaxf(x, __uint_as_float(dppu(__float_as_uint(x), 2)));
    x = fmaxf(x, __uint_as_float(dppu(__float_as_uint(x), 3)));
    return x;
}
__device__ __forceinline__ f32x4 mfma16(bf16x8 a, bf16x8 b, f32x4 c) { return __builtin_amdgcn_mfma_f32_16x16x32_bf16(a, b, c, 0, 0, 0); }

__device__ __forceinline__ float row_rscale(const float* ssq, int row) {
    float s = 0.f;
#pragma unroll
    for (int p = 0; p < 16; ++p) s += ssq[(size_t)p * MTOK + row];
    return rsqrtf(s * (1.f / D) + EPS);
}
struct EpiRowBf16 {
    static constexpr bool PERM = true, AFTER_DRAIN = false;
    bf16_t* O; int ldc; const float* ssq; float mul;
    __device__ __forceinline__ void operator()(const f32x4 (&acc)[2][2][4][2], const pg8::Unit& u, int wr, int wc, int fr, int fq) const {
        const int row0 = u.pm * 256 + wr * 64 + fr, col0 = u.pn * 256 + wc * 32 + 8 * fq;
#pragma unroll
        for (int ai = 0; ai < 2; ++ai)
#pragma unroll
            for (int m = 0; m < 4; ++m) {
                const int row = row0 + ai * 128 + m * 16;
                const float sc = ssq ? row_rscale(ssq, row) * mul : mul;
                bf16_t* rowp = O + (size_t)row * ldc + col0;
#pragma unroll
                for (int bj = 0; bj < 2; ++bj) {
                    const f32x4 v0 = acc[ai][bj][m][0] * sc, v1 = acc[ai][bj][m][1] * sc;
                    u32x4 w; w.x = pk2(v0[0], v0[1]); w.y = pk2(v0[2], v0[3]); w.z = pk2(v1[0], v1[1]); w.w = pk2(v1[2], v1[3]);
                    *(u32x4*)(rowp + bj * 128) = w;
                }
            }
    }
};
struct EpiResid {
    static constexpr bool PERM = true, AFTER_DRAIN = false;
    float* H; const float* R; bf16_t* Hb; float* ssq;
    __device__ __forceinline__ void operator()(const f32x4 (&acc)[2][2][4][2], const pg8::Unit& u, int wr, int wc, int fr, int fq) const {
        const int row0 = u.pm * 256 + wr * 64 + fr, col0 = u.pn * 256 + wc * 32 + 8 * fq;
#pragma unroll
        for (int ai = 0; ai < 2; ++ai)
#pragma unroll
            for (int m = 0; m < 4; ++m) {
                const int row = row0 + ai * 128 + m * 16;
                const size_t off = (size_t)row * D + col0;
                float ss = 0.f;
#pragma unroll
                for (int bj = 0; bj < 2; ++bj) {
                    const f32x4 r0 = *(const f32x4*)(R + off + bj * 128), r1 = *(const f32x4*)(R + off + bj * 128 + 4);
                    const f32x4 v0 = acc[ai][bj][m][0] + r0, v1 = acc[ai][bj][m][1] + r1;
                    *(f32x4*)(H + off + bj * 128) = v0; *(f32x4*)(H + off + bj * 128 + 4) = v1;
                    u32x4 w; w.x = pk2(v0[0], v0[1]); w.y = pk2(v0[2], v0[3]); w.z = pk2(v1[0], v1[1]); w.w = pk2(v1[2], v1[3]);
                    *(u32x4*)(Hb + off + bj * 128) = w;
                    ss += v0[0] * v0[0] + v0[1] * v0[1] + v0[2] * v0[2] + v0[3] * v0[3] + v1[0] * v1[0] + v1[1] * v1[1] + v1[2] * v1[2] + v1[3] * v1[3];
                }
                ss += __shfl_xor(ss, 16); ss += __shfl_xor(ss, 32);
                if (fq == 0) ssq[(size_t)(u.pn * 4 + wc) * MTOK + row] = ss;
            }
    }
};
struct EpiKV {
    static constexpr bool PERM = true, AFTER_DRAIN = false;
    bf16_t* Kmem; bf16_t* VT;
    __device__ __forceinline__ void operator()(const f32x4 (&acc)[2][2][4][2], const pg8::Unit& u, int wr, int wc, int fr, int fq) const {
        const int row0 = u.pm * 256 + wr * 64 + fr, col0 = u.pn * 256 + wc * 32 + 8 * fq;
#pragma unroll
        for (int ai = 0; ai < 2; ++ai)
#pragma unroll
            for (int m = 0; m < 4; ++m) {
                const int row = row0 + ai * 128 + m * 16;
#pragma unroll
                for (int bj = 0; bj < 2; ++bj) {
                    const f32x4 v0 = acc[ai][bj][m][0], v1 = acc[ai][bj][m][1];
                    const int c = col0 + bj * 128;
                    if (c < 1024) {
                        u32x4 w; w.x = pk2(v0[0], v0[1]); w.y = pk2(v0[2], v0[3]); w.z = pk2(v1[0], v1[1]); w.w = pk2(v1[2], v1[3]);
                        *(u32x4*)(Kmem + (size_t)row * 1024 + c) = w;
                    } else {
                        bf16_t* p = VT + ((size_t)(row >> 8) * 1024 + (c - 1024)) * 256 + (row & 255);
#pragma unroll
                        for (int j = 0; j < 4; ++j) { p[(size_t)j * 256] = f2bf(v0[j]); p[(size_t)(4 + j) * 256] = f2bf(v1[j]); }
                    }
                }
            }
    }
};

__device__ __forceinline__ void p0_transpose_item(const float* W, int ldw, int col0, int K, bf16_t* WT, int row0, const float* g, LAS float* scr, int item, int nblk, int lane) {
    const int kb = item / nblk, nb = item % nblk, k0 = 64 * kb, n0 = 32 * nb;
#pragma unroll 8
    for (int i = 0; i < 32; ++i) {
        const int kk = 2 * i + (lane >> 5);
        float v = W[(size_t)(k0 + kk) * ldw + col0 + n0 + (lane & 31)];
        if (g) v *= g[k0 + kk];
        scr[kk * 33 + (lane & 31)] = v;
    }
    LDS_FENCE();
    const int c = lane & 7;
#pragma unroll
    for (int j = 0; j < 4; ++j) {
        const int n = (lane >> 3) + 8 * j; const LAS float* s = scr + (8 * c) * 33 + n;
        u32x4 o; o.x = pk2(s[0 * 33], s[1 * 33]); o.y = pk2(s[2 * 33], s[3 * 33]); o.z = pk2(s[4 * 33], s[5 * 33]); o.w = pk2(s[6 * 33], s[7 * 33]);
        *(u32x4*)(WT + (size_t)(row0 + n0 + n) * K + k0 + 8 * c) = o;
    }
    LDS_FENCE();
}
__device__ __forceinline__ void rms_row_to_bf16(const float* xrow, const float* g, bf16_t* orow, int lane, f32x4 (&v)[4]) {
    const f32x4* xr = (const f32x4*)xrow + lane;
    float s = 0.f;
#pragma unroll
    for (int j = 0; j < 4; ++j) { v[j] = xr[64 * j]; s += (v[j][0] * v[j][0] + v[j][1] * v[j][1]) + (v[j][2] * v[j][2] + v[j][3] * v[j][3]); }
    const float r = rsqrtf(wave_sum(s) * (1.f / D) + EPS);
    unsigned long long* o8 = (unsigned long long*)orow + lane;
#pragma unroll
    for (int j = 0; j < 4; ++j) {
        const f32x4 gv = ((const f32x4*)g)[lane + 64 * j];
        v[j] = v[j] * r * gv;
        o8[64 * j] = (unsigned long long)pk2(v[j][0], v[j][1]) | ((unsigned long long)pk2(v[j][2], v[j][3]) << 32);
    }
}
__device__ __forceinline__ void phase0(const Args& a, LAS unsigned char* lds) {
    const int tid = threadIdx.x, lane = tid & 63, wave = tid >> 6;
    const int G = gridDim.x, gw = blockIdx.x * NWAVES + wave, NGW = G * NWAVES;
    unsigned char* ws = a.ws;
    LAS float* scr = (LAS float*)(lds + wave * 8704);
    {
        constexpr int I_W1 = 16 * 48, I_W2 = 16 * 24, I_SQ = 16 * 32, I_PQ = 16 * 64;
        constexpr int NITEMS = I_W1 + I_W2 + 5 * I_SQ + I_PQ;
        for (int it = gw; it < NITEMS; it += NGW) {
            int r = it;
            if (r < I_W1) { p0_transpose_item(a.in[I_WIN], 2312, 0, D, (bf16_t*)(ws + WS_WIN), 0, nullptr, scr, r, 48, lane); continue; } r -= I_W1;
            if (r < I_W2) { p0_transpose_item(a.in[I_WIN], 2312, 1544, D, (bf16_t*)(ws + WS_WIN), 1536, nullptr, scr, r, 24, lane); continue; } r -= I_W2;
            if (r < I_SQ) { p0_transpose_item(a.in[I_WOUT], D, 0, D, (bf16_t*)(ws + WS_WOUT), 0, nullptr, scr, r, 32, lane); continue; } r -= I_SQ;
            if (r < I_SQ) { p0_transpose_item(a.in[I_WXQ], D, 0, D, (bf16_t*)(ws + WS_WXQ), 0, a.in[I_GCROSS], scr, r, 32, lane); continue; } r -= I_SQ;
            if (r < I_SQ) { p0_transpose_item(a.in[I_WXK], D, 0, D, (bf16_t*)(ws + WS_WXKV), 0, nullptr, scr, r, 32, lane); continue; } r -= I_SQ;
            if (r < I_SQ) { p0_transpose_item(a.in[I_WXV], D, 0, D, (bf16_t*)(ws + WS_WXKV), 1024, nullptr, scr, r, 32, lane); continue; } r -= I_SQ;
            if (r < I_SQ) { p0_transpose_item(a.in[I_WXO], D, 0, D, (bf16_t*)(ws + WS_WXO), 0, nullptr, scr, r, 32, lane); continue; } r -= I_SQ;
            p0_transpose_item(a.in[I_WPQ], 2048, 0, D, (bf16_t*)(ws + WS_WPQ), 0, a.in[I_GFFN], scr, r, 64, lane);
        }
    }
    {
        const size_t T = (size_t)G * NTHREADS, gt = (size_t)blockIdx.x * NTHREADS + tid;
        const size_t N8 = (size_t)16384 * 1024 / 8;
        const float* gf = a.in[I_GFFN];
        for (size_t i = gt; i < 2 * N8; i += T) {
            const bool up = i >= N8; const size_t j = up ? i - N8 : i;
            const float* src = (up ? a.in[I_EUP] : a.in[I_EDOWN]) + j * 8;
            f32x4 v0 = *(const f32x4*)src, v1 = *(const f32x4*)(src + 4);
            if (!up) { const int c = (int)((j * 8) & 1023); const f32x4 g0 = *(const f32x4*)(gf + c), g1 = *(const f32x4*)(gf + c + 4); v0 = v0 * g0; v1 = v1 * g1; }
            u32x4 w; w.x = pk2(v0[0], v0[1]); w.y = pk2(v0[2], v0[3]); w.z = pk2(v1[0], v1[1]); w.w = pk2(v1[2], v1[3]);
            *(u32x4*)((bf16_t*)(ws + (up ? WS_EU : WS_ED)) + j * 8) = w;
        }
        for (size_t i = gt; i < 2 * 16384 / 8; i += T) {
            const bool s2 = i >= 2048; const size_t j = s2 ? i - 2048 : i;
            const float* src = (s2 ? a.in[I_SK2] : a.in[I_SK1]) + j * 8;
            const f32x4 v0 = *(const f32x4*)src, v1 = *(const f32x4*)(src + 4);
            u32x4 w; w.x = pk2(v0[0], v0[1]); w.y = pk2(v0[2], v0[3]); w.z = pk2(v1[0], v1[1]); w.w = pk2(v1[2], v1[3]);
            *(u32x4*)((bf16_t*)(ws + WS_SK) + (s2 ? 16384 : 0) + j * 8) = w;
        }
    }
    {
        const float* win = a.in[I_WIN];
        float* gates = (float*)(ws + WS_GATES);
        const float* bi = a.in[I_BI]; const float* bfg = a.in[I_BF];
        for (int row = gw; row < MTOK; row += NGW) {
            f32x4 v[4];
            rms_row_to_bf16(a.in[I_X] + (size_t)row * D, a.in[I_GMIX], (bf16_t*)(ws + WS_B) + (size_t)row * D, lane, v);
            float gsum[8];
#pragma unroll
            for (int c = 0; c < 8; ++c) gsum[c] = 0.f;
#pragma unroll
            for (int j = 0; j < 4; ++j)
#pragma unroll
                for (int e = 0; e < 4; ++e) {
                    const int k = 4 * lane + 256 * j + e;
                    const f32x4 w0 = *(const f32x4*)(win + (size_t)k * 2312 + 1536), w1 = *(const f32x4*)(win + (size_t)k * 2312 + 1540);
                    const float xv = v[j][e];
                    gsum[0] += xv * w0[0]; gsum[1] += xv * w0[1]; gsum[2] += xv * w0[2]; gsum[3] += xv * w0[3];
                    gsum[4] += xv * w1[0]; gsum[5] += xv * w1[1]; gsum[6] += xv * w1[2]; gsum[7] += xv * w1[3];
                }
#pragma unroll
            for (int c = 0; c < 8; ++c) gsum[c] = wave_sum(gsum[c]);
            if (lane < 8) {
                float val = 0.f;
#pragma unroll
                for (int c = 0; c < 8; ++c) val = (lane == c) ? gsum[c] : val;
                if (lane < 4) val += bi[lane];
                else { const float f = val + bfg[lane - 4]; val = fminf(f, 0.f) - log1pf(__expf(-fabsf(f))); }
                gates[(size_t)row * 8 + lane] = val;
            }
        }
    }
    for (int row = gw; row < NB * MEMLEN; row += NGW) {
        f32x4 v[4];
        rms_row_to_bf16(a.in[I_MEM] + (size_t)row * D, a.in[I_GMEM], (bf16_t*)(ws + WS_C) + (size_t)row * D, lane, v);
    }
}

constexpr int LQ = 72;
__device__ __forceinline__ void conv8(const bf16_t* src, int tok_in_seq, const float* cw, const float* cb, int ch, float (&y)[8]) {
#pragma unroll
    for (int e = 0; e < 8; ++e) y[e] = cb[ch + e];
#pragma unroll
    for (int j = 0; j < 4; ++j) {
        if (tok_in_seq - 3 + j >= 0) {
            const u32x4 xv = *(const u32x4*)(src + (ptrdiff_t)(j - 3) * NPROJ);
            const f32x4 w0 = *(const f32x4*)(cw + j * 512 + ch), w1 = *(const f32x4*)(cw + j * 512 + ch + 4);
            y[0] += w0[0] * bflo(xv.x); y[1] += w0[1] * bfhi(xv.x); y[2] += w0[2] * bflo(xv.y); y[3] += w0[3] * bfhi(xv.y);
            y[4] += w1[0] * bflo(xv.z); y[5] += w1[1] * bfhi(xv.z); y[6] += w1[2] * bflo(xv.w); y[7] += w1[3] * bfhi(xv.w);
        }
    }
#pragma unroll
    for (int e = 0; e < 8; ++e) y[e] = y[e] * sigmoidf_(y[e]);
}
__device__ __forceinline__ float chunk_cumsum(float lf, int lane) {
    float b = lf;
#pragma unroll
    for (int o = 1; o < 64; o <<= 1) { const float t = __shfl_up(b, o); if (lane >= o) b += t; }
    return b;
}

__device__ __forceinline__ void mlstm_local(const Args& a, LAS unsigned char* lds, int task) {
    const int tid = threadIdx.x, lane = tid & 63, wave = tid >> 6;
    const int b = task >> 9, h = (task >> 7) & 3, c = task & 127;
    const int row0 = b * SEQ + c * 64;
    const bf16_t* proj = (const bf16_t*)(a.ws + WS_A);
    const float* gates = (const float*)(a.ws + WS_GATES);
    LAS bf16_t* VTw = (LAS bf16_t*)lds;
    LAS bf16_t* KT = (LAS bf16_t*)(lds + 144 * LQ * 2);
    LAS float* wS = (LAS float*)(lds + 144 * LQ * 2 + 64 * LQ * 2);
    if (wave == 0) {
        const float ig = gates[(size_t)(row0 + lane) * 8 + h], lf = gates[(size_t)(row0 + lane) * 8 + 4 + h];
        const float bs = chunk_cumsum(lf, lane);
        const float bL = __shfl(bs, 63);
        wS[lane] = __expf(bL - bs + ig);
        if (lane == 63) ((float*)(a.ws + WS_DECAY))[task] = __expf(bL);
    }
    {
        const int s = tid >> 3, cg = (tid & 7) * 8;
        float y[8];
        conv8(proj + (size_t)(row0 + s) * NPROJ + C_MK + h * 64 + cg, c * 64 + s, a.in[I_CONVW], a.in[I_CONVB], 256 + h * 64 + cg, y);
#pragma unroll
        for (int e = 0; e < 8; ++e) KT[(cg + e) * LQ + s] = f2bf(y[e]);
    }
    __syncthreads();
    {
        const int s = tid >> 3, vg = (tid & 7) * 16;
        const float w = wS[s];
        const u32x4 x0 = *(const u32x4*)(proj + (size_t)(row0 + s) * NPROJ + C_MV + h * 128 + vg), x1 = *(const u32x4*)(proj + (size_t)(row0 + s) * NPROJ + C_MV + h * 128 + vg + 8);
        const unsigned xs[8] = {x0.x, x0.y, x0.z, x0.w, x1.x, x1.y, x1.z, x1.w};
#pragma unroll
        for (int e = 0; e < 8; ++e) { VTw[(vg + 2 * e) * LQ + s] = f2bf(w * bflo(xs[e])); VTw[(vg + 2 * e + 1) * LQ + s] = f2bf(w * bfhi(xs[e])); }
        if ((tid & 7) == 0) VTw[128 * LQ + s] = f2bf(w);
        for (int i = tid; i < 15 * 64; i += NTHREADS) VTw[(129 + (i >> 6)) * LQ + (i & 63)] = 0;
    }
    __syncthreads();
    float* dC = (float*)(a.ws + WS_B) + (size_t)task * 8192;
    float* dn = (float*)(a.ws + WS_DN) + (size_t)task * 64;
    for (int T = wave; T < 36; T += 8) {
        const int mt = T >> 2, nt = T & 3;
        f32x4 acc = {0.f, 0.f, 0.f, 0.f};
#pragma unroll
        for (int ks = 0; ks < 2; ++ks) {
            const bf16x8 av = *(const LAS bf16x8*)(VTw + (mt * 16 + (lane & 15)) * LQ + ks * 32 + 8 * (lane >> 4));
            const bf16x8 bv = *(const LAS bf16x8*)(KT + (nt * 16 + (lane & 15)) * LQ + ks * 32 + 8 * (lane >> 4));
            acc = mfma16(av, bv, acc);
        }
        const int col = nt * 16 + (lane & 15);
        if (mt < 8) {
#pragma unroll
            for (int r = 0; r < 4; ++r) dC[(mt * 16 + (lane >> 4) * 4 + r) * 64 + col] = acc[r];
        } else if ((lane >> 4) == 0) dn[col] = acc[0];
    }
    __syncthreads();
}

__device__ __forceinline__ void mlstm_scan(const Args& a) {
    const size_t T = (size_t)gridDim.x * NTHREADS;
    const float* decay = (const float*)(a.ws + WS_DECAY);
    for (size_t chain = (size_t)blockIdx.x * NTHREADS + threadIdx.x; chain < 8 * 8256; chain += T) {
        const int bh = (int)(chain / 8256), e = (int)(chain % 8256);
        float* p; size_t stride;
        if (e < 8192) { p = (float*)(a.ws + WS_B) + (size_t)bh * 128 * 8192 + e; stride = 8192; }
        else { p = (float*)(a.ws + WS_DN) + (size_t)bh * 128 * 64 + (e - 8192); stride = 64; }
        float C = 0.f;
        for (int c0 = 0; c0 < 128; c0 += 8) {
            float t[8];
#pragma unroll
            for (int j = 0; j < 8; ++j) t[j] = p[(size_t)(c0 + j) * stride];
#pragma unroll
            for (int j = 0; j < 8; ++j) { p[(size_t)(c0 + j) * stride] = C; C = decay[bh * 128 + c0 + j] * C + t[j]; }
        }
    }
}

__device__ __forceinline__ void mlstm_out(const Args& a, LAS unsigned char* lds, int task) {
    const int tid = threadIdx.x, lane = tid & 63, wave = tid >> 6;
    const int b = task >> 9, h = (task >> 7) & 3, c = task & 127;
    const int row0 = b * SEQ + c * 64;
    const bf16_t* proj = (const bf16_t*)(a.ws + WS_A);
    const float* gates = (const float*)(a.ws + WS_GATES);
    LAS bf16_t* Qs = (LAS bf16_t*)lds;
    LAS bf16_t* Ks = Qs + 64 * LQ;
    LAS bf16_t* Qp = Ks + 64 * LQ;
    LAS bf16_t* Ps = Qp + 64 * LQ;
    LAS bf16_t* VT = Ps + 64 * LQ;
    LAS bf16_t* Cs = VT + 144 * LQ;
    LAS float* bS = (LAS float*)(Cs + 144 * LQ);
    LAS float* iS = bS + 64;
    LAS float* denS = iS + 64;
    LAS float* ssqS = denS + 64;
    if (wave == 0) {
        const float ig = gates[(size_t)(row0 + lane) * 8 + h], lf = gates[(size_t)(row0 + lane) * 8 + 4 + h];
        bS[lane] = chunk_cumsum(lf, lane); iS[lane] = ig;
    }
    {
        const int s = tid >> 3, cg = (tid & 7) * 8;
        float y[8];
        conv8(proj + (size_t)(row0 + s) * NPROJ + C_MK + h * 64 + cg, c * 64 + s, a.in[I_CONVW], a.in[I_CONVB], 256 + h * 64 + cg, y);
        u32x4 w; w.x = pk2(y[0], y[1]); w.y = pk2(y[2], y[3]); w.z = pk2(y[4], y[5]); w.w = pk2(y[6], y[7]);
        *(LAS u32x4*)(Ks + s * LQ + cg) = w;
        const int vg = (tid & 7) * 16;
        const u32x4 x0 = *(const u32x4*)(proj + (size_t)(row0 + s) * NPROJ + C_MV + h * 128 + vg), x1 = *(const u32x4*)(proj + (size_t)(row0 + s) * NPROJ + C_MV + h * 128 + vg + 8);
        const unsigned xs[8] = {x0.x, x0.y, x0.z, x0.w, x1.x, x1.y, x1.z, x1.w};
#pragma unroll
        for (int e = 0; e < 8; ++e) { VT[(vg + 2 * e) * LQ + s] = (bf16_t)(xs[e] & 0xffffu); VT[(vg + 2 * e + 1) * LQ + s] = (bf16_t)(xs[e] >> 16); }
        if ((tid & 7) == 0) VT[128 * LQ + s] = 0x3F80;
        for (int i = tid; i < 15 * 64; i += NTHREADS) { VT[(129 + (i >> 6)) * LQ + (i & 63)] = 0; Cs[(129 + (i >> 6)) * LQ + (i & 63)] = 0; }
        const float* st = (const float*)(a.ws + WS_B) + (size_t)task * 8192;
        const int v = tid >> 2, k0 = (tid & 3) * 16;
#pragma unroll
        for (int j = 0; j < 4; ++j) {
            const f32x4 t = *(const f32x4*)(st + v * 64 + k0 + 4 * j);
            u32x2 o; o.x = pk2(t[0], t[1]); o.y = pk2(t[2], t[3]);
            *(LAS u32x2*)(Cs + v * LQ + k0 + 4 * j) = o;
        }
        if (tid < 64) Cs[128 * LQ + tid] = f2bf(((const float*)(a.ws + WS_DN))[(size_t)task * 64 + tid]);
    }
    __syncthreads();
    {
        const int s = tid >> 3, cg = (tid & 7) * 8;
        float y[8];
        conv8(proj + (size_t)(row0 + s) * NPROJ + C_MQ + h * 64 + cg, c * 64 + s, a.in[I_CONVW], a.in[I_CONVB], h * 64 + cg, y);
        const float eb = __expf(bS[s]);
#pragma unroll
        for (int e = 0; e < 8; ++e) y[e] *= 0.125f;
        u32x4 w; w.x = pk2(y[0], y[1]); w.y = pk2(y[2], y[3]); w.z = pk2(y[4], y[5]); w.w = pk2(y[6], y[7]);
        *(LAS u32x4*)(Qs + s * LQ + cg) = w;
        w.x = pk2(y[0] * eb, y[1] * eb); w.y = pk2(y[2] * eb, y[3] * eb); w.z = pk2(y[4] * eb, y[5] * eb); w.w = pk2(y[6] * eb, y[7] * eb);
        *(LAS u32x4*)(Qp + s * LQ + cg) = w;
    }
    __syncthreads();
    {
        const int mt = wave >> 1;
#pragma unroll
        for (int i = 0; i < 2; ++i) {
            const int nt = (wave & 1) * 2 + i;
            f32x4 acc = {0.f, 0.f, 0.f, 0.f};
#pragma unroll
            for (int ks = 0; ks < 2; ++ks) {
                const bf16x8 av = *(const LAS bf16x8*)(Qs + (mt * 16 + (lane & 15)) * LQ + ks * 32 + 8 * (lane >> 4));
                const bf16x8 bv = *(const LAS bf16x8*)(Ks + (nt * 16 + (lane & 15)) * LQ + ks * 32 + 8 * (lane >> 4));
                acc = mfma16(av, bv, acc);
            }
            const int s = nt * 16 + (lane & 15);
            const float bs = bS[s], is = iS[s];
#pragma unroll
            for (int r = 0; r < 4; ++r) {
                const int t = mt * 16 + (lane >> 4) * 4 + r;
                const float p = (s <= t) ? acc[r] * __expf(bS[t] - bs + is) : 0.f;
                Ps[t * LQ + s] = f2bf(p);
            }
        }
    }
    __syncthreads();
    const int mt = wave & 3, ng = wave >> 2;
    f32x4 acc[5];
#pragma unroll
    for (int i = 0; i < 5; ++i) acc[i] = (f32x4){0.f, 0.f, 0.f, 0.f};
#pragma unroll
    for (int ks = 0; ks < 4; ++ks) {
        const LAS bf16_t* Ab = (ks < 2) ? Ps : Qp; const LAS bf16_t* Bb = (ks < 2) ? VT : Cs;
        const int ko = (ks & 1) * 32 + 8 * (lane >> 4);
        const bf16x8 av = *(const LAS bf16x8*)(Ab + (mt * 16 + (lane & 15)) * LQ + ko);
#pragma unroll
        for (int i = 0; i < 4; ++i) {
            const bf16x8 bv = *(const LAS bf16x8*)(Bb + ((ng * 4 + i) * 16 + (lane & 15)) * LQ + ko);
            acc[i] = mfma16(av, bv, acc[i]);
        }
        if (ng == 0) {
            const bf16x8 bv = *(const LAS bf16x8*)(Bb + (128 + (lane & 15)) * LQ + ko);
            acc[4] = mfma16(av, bv, acc[4]);
        }
    }
    if (ng == 0 && (lane & 15) == 0) {
#pragma unroll
        for (int r = 0; r < 4; ++r) denS[mt * 16 + (lane >> 4) * 4 + r] = acc[4][r];
    }
    __syncthreads();
    float rinv[4];
#pragma unroll
    for (int r = 0; r < 4; ++r) {
        const float den = denS[mt * 16 + (lane >> 4) * 4 + r];
        rinv[r] = 1.f / fmaxf(fabsf(den), 1.f);
        float ss = 0.f;
#pragma unroll
        for (int i = 0; i < 4; ++i) { acc[i][r] *= rinv[r]; ss += acc[i][r] * acc[i][r]; }
        ss = row16_sum_f32(ss);
        if ((lane & 15) == 0) ssqS[ng * 64 + mt * 16 + (lane >> 4) * 4 + r] = ss;
    }
    __syncthreads();
    bf16_t* mix = (bf16_t*)(a.ws + WS_C);
    const float* gmh = a.in[I_GMHEAD];
#pragma unroll
    for (int r = 0; r < 4; ++r) {
        const int t = mt * 16 + (lane >> 4) * 4 + r;
        const float rn = rsqrtf((ssqS[t] + ssqS[64 + t]) * (1.f / 128.f) + EPS);
#pragma unroll
        for (int i = 0; i < 4; ++i) {
            const int v = (ng * 4 + i) * 16 + (lane & 15);
            const float mo = bf2f(proj[(size_t)(row0 + t) * NPROJ + C_MO + h * 128 + v]);
            mix[(size_t)(row0 + t) * D + h * 128 + v] = f2bf(acc[i][r] * rn * gmh[h * 128 + v] * sigmoidf_(mo));
        }
    }
    __syncthreads();
}

constexpr int LV = 264;
__device__ __forceinline__ void swa_task(const Args& a, LAS unsigned char* lds, int task) {
    const int tid = threadIdx.x, lane = tid & 63, wave = tid >> 6;
    const int b = task >> 9, qh = (task >> 6) & 7, blk = task & 63, kvh = qh >> 2;
    const int rowq0 = b * SEQ + blk * 128;
    const bf16_t* proj = (const bf16_t*)(a.ws + WS_A);
    LAS bf16_t* Ksm = (LAS bf16_t*)lds;
    LAS bf16_t* VTs = Ksm + 256 * LQ;
    {
        const int j = tid >> 1, half = tid & 1;
        const bool ex = (blk > 0) || (j >= 128);
        u32x4 kv[4], vv[4];
#pragma unroll
        for (int i = 0; i < 4; ++i) { kv[i] = (u32x4){0u, 0u, 0u, 0u}; vv[i] = (u32x4){0u, 0u, 0u, 0u}; }
        if (ex) {
            const bf16_t* kp = proj + (size_t)(rowq0 - 128 + j) * NPROJ + C_AK + kvh * 64 + half * 32;
            const bf16_t* vp = proj + (size_t)(rowq0 - 128 + j) * NPROJ + C_AV + kvh * 64 + half * 32;
#pragma unroll
            for (int i = 0; i < 4; ++i) { kv[i] = *(const u32x4*)(kp + 8 * i); vv[i] = *(const u32x4*)(vp + 8 * i); }
        }
#pragma unroll
        for (int i = 0; i < 4; ++i) {
            *(LAS u32x4*)(Ksm + j * LQ + half * 32 + 8 * i) = kv[i];
            const unsigned xs[4] = {vv[i].x, vv[i].y, vv[i].z, vv[i].w};
#pragma unroll
            for (int e = 0; e < 4; ++e) { VTs[(half * 32 + 8 * i + 2 * e) * LV + j] = (bf16_t)(xs[e] & 0xffffu); VTs[(half * 32 + 8 * i + 2 * e + 1) * LV + j] = (bf16_t)(xs[e] >> 16); }
        }
    }
    __syncthreads();
    const int qi = 16 * wave + (lane & 15);
    bf16x8 qf[2];
#pragma unroll
    for (int ks = 0; ks < 2; ++ks) qf[ks] = *(const bf16x8*)(proj + (size_t)(rowq0 + qi) * NPROJ + C_AQ + qh * 64 + ks * 32 + 8 * (lane >> 4));
    f32x4 sc[10];
    const float sink = a.in[I_SINKS][qh];
    float mx = sink;
#pragma unroll
    for (int t = 0; t < 9; ++t) {
        const int kt = wave + t;
        f32x4 acc = {0.f, 0.f, 0.f, 0.f};
#pragma unroll
        for (int ks = 0; ks < 2; ++ks) {
            const bf16x8 kf = *(const LAS bf16x8*)(Ksm + (kt * 16 + (lane & 15)) * LQ + ks * 32 + 8 * (lane >> 4));
            acc = mfma16(kf, qf[ks], acc);
        }
#pragma unroll
        for (int r = 0; r < 4; ++r) {
            const int j = kt * 16 + (lane >> 4) * 4 + r;
            const bool valid = (j >= qi + 1) && (j <= qi + 128) && (blk > 0 || j >= 128);
            acc[r] = valid ? acc[r] * 0.125f : -INFINITY;
            mx = fmaxf(mx, acc[r]);
        }
        sc[t] = acc;
    }
    mx = fmaxf(mx, __shfl_xor(mx, 16)); mx = fmaxf(mx, __shfl_xor(mx, 32));
    float sum = 0.f;
#pragma unroll
    for (int t = 0; t < 9; ++t)
#pragma unroll
        for (int r = 0; r < 4; ++r) { const float p = __expf(sc[t][r] - mx); sc[t][r] = p; sum += p; }
    sum += __shfl_xor(sum, 16); sum += __shfl_xor(sum, 32);
    const float inv = 1.f / (sum + __expf(sink - mx));
    sc[9] = (f32x4){0.f, 0.f, 0.f, 0.f};
    bf16x8 pf[5];
#pragma unroll
    for (int p = 0; p < 5; ++p) {
        const f32x4 x0 = sc[2 * p] * inv, x1 = sc[2 * p + 1] * inv;
        u32x4 w; w.x = pk2(x0[0], x0[1]); w.y = pk2(x0[2], x0[3]); w.z = pk2(x1[0], x1[1]); w.w = pk2(x1[2], x1[3]);
        pf[p] = __builtin_bit_cast(bf16x8, w);
    }
    bf16_t* mix = (bf16_t*)(a.ws + WS_C);
#pragma unroll
    for (int dt = 0; dt < 4; ++dt) {
        f32x4 acc = {0.f, 0.f, 0.f, 0.f};
#pragma unroll
        for (int p = 0; p < 5; ++p) {
            const int k0 = wave + 2 * p, k1 = (k0 + 1 > 15) ? 15 : k0 + 1;
            const LAS bf16_t* vr = VTs + (dt * 16 + (lane & 15)) * LV + 4 * (lane >> 4);
            const u32x2 lo = *(const LAS u32x2*)(vr + k0 * 16), hi = *(const LAS u32x2*)(vr + k1 * 16);
            const u32x4 w = {lo.x, lo.y, hi.x, hi.y};
            acc = mfma16(__builtin_bit_cast(bf16x8, w), pf[p], acc);
        }
#ifdef PROBE_SWA_INV
        acc = (f32x4){inv, sum, mx, inv};
#endif
        u32x2 o; o.x = pk2(acc[0], acc[1]); o.y = pk2(acc[2], acc[3]);
        *(u32x2*)(mix + (size_t)(rowq0 + qi) * D + 512 + qh * 64 + dt * 16 + 4 * (lane >> 4)) = o;
    }
    __syncthreads();
}

__device__ __forceinline__ void xattn_task(const Args& a, LAS unsigned char* lds, int task) {
    const int tid = threadIdx.x, lane = tid & 63, wave = tid >> 6;
    const int b = task >> 8, h = (task >> 6) & 3, qt = task & 63;
    const int rowq = b * SEQ + qt * 128 + wave * 16 + (lane & 15);
    const bf16_t* qx = (const bf16_t*)(a.ws + WS_A);
    bf16_t* ox = (bf16_t*)(a.ws + WS_A + 32 * MiB);
    const bf16_t* kmem = (const bf16_t*)(a.ws + WS_KMEM);
    const bf16_t* vtm = (const bf16_t*)(a.ws + WS_VTMEM);
    LAS bf16_t* Ts = (LAS bf16_t*)lds;
    bf16x8 qf[8];
#pragma unroll
    for (int ks = 0; ks < 8; ++ks) qf[ks] = *(const bf16x8*)(qx + (size_t)rowq * D + h * 256 + ks * 32 + 8 * (lane >> 4));
    f32x4 sc[16];
#pragma unroll
    for (int kc = 0; kc < 4; ++kc) {
        {
            const int j = tid >> 3, seg = tid & 7;
            const bf16_t* src = kmem + (size_t)(b * 256 + kc * 64 + j) * D + h * 256 + seg * 32;
#pragma unroll
            for (int i = 0; i < 4; ++i) *(LAS u32x4*)(Ts + j * LV + seg * 32 + 8 * i) = *(const u32x4*)(src + 8 * i);
        }
        __syncthreads();
#pragma unroll
        for (int kt = 0; kt < 4; ++kt) {
            f32x4 acc = {0.f, 0.f, 0.f, 0.f};
#pragma unroll
            for (int ks = 0; ks < 8; ++ks) {
                const bf16x8 kf = *(const LAS bf16x8*)(Ts + (kt * 16 + (lane & 15)) * LV + ks * 32 + 8 * (lane >> 4));
                acc = mfma16(kf, qf[ks], acc);
            }
            sc[kc * 4 + kt] = acc;
        }
        __syncthreads();
    }
    float mx = -INFINITY;
#pragma unroll
    for (int t = 0; t < 16; ++t)
#pragma unroll
        for (int r = 0; r < 4; ++r) mx = fmaxf(mx, sc[t][r]);
    mx = fmaxf(mx, __shfl_xor(mx, 16)); mx = fmaxf(mx, __shfl_xor(mx, 32));
    float sum = 0.f;
#pragma unroll
    for (int t = 0; t < 16; ++t)
#pragma unroll
        for (int r = 0; r < 4; ++r) { const float p = __expf(sc[t][r] - mx); sc[t][r] = p; sum += p; }
    sum += __shfl_xor(sum, 16); sum += __shfl_xor(sum, 32);
    const float inv = 1.f / sum;
    bf16x8 pf[8];
#pragma unroll
    for (int p = 0; p < 8; ++p) {
        const f32x4 x0 = sc[2 * p] * inv, x1 = sc[2 * p + 1] * inv;
        u32x4 w; w.x = pk2(x0[0], x0[1]); w.y = pk2(x0[2], x0[3]); w.z = pk2(x1[0], x1[1]); w.w = pk2(x1[2], x1[3]);
        pf[p] = __builtin_bit_cast(bf16x8, w);
    }
    for (int dc = 0; dc < 4; ++dc) {
        {
            const int j = tid >> 3, seg = tid & 7;
            const bf16_t* src = vtm + ((size_t)b * 1024 + h * 256 + dc * 64 + j) * 256 + seg * 32;
#pragma unroll
            for (int i = 0; i < 4; ++i) *(LAS u32x4*)(Ts + j * LV + seg * 32 + 8 * i) = *(const u32x4*)(src + 8 * i);
        }
        __syncthreads();
#pragma unroll
        for (int dt = 0; dt < 4; ++dt) {
            f32x4 acc = {0.f, 0.f, 0.f, 0.f};
#pragma unroll
            for (int p = 0; p < 8; ++p) {
                const LAS bf16_t* vr = Ts + (dt * 16 + (lane & 15)) * LV + 4 * (lane >> 4) + p * 32;
                const u32x2 lo = *(const LAS u32x2*)(vr), hi = *(const LAS u32x2*)(vr + 16);
                const u32x4 w = {lo.x, lo.y, hi.x, hi.y};
                acc = mfma16(__builtin_bit_cast(bf16x8, w), pf[p], acc);
            }
            u32x2 o; o.x = pk2(acc[0], acc[1]); o.y = pk2(acc[2], acc[3]);
            *(u32x2*)(ox + (size_t)rowq * D + h * 256 + dc * 64 + dt * 16 + 4 * (lane >> 4)) = o;
        }
        __syncthreads();
    }
}

constexpr int LSK = 136;
__device__ __forceinline__ unsigned f2sort(float f) { const unsigned u = __float_as_uint(f); return u ^ ((unsigned)((int)u >> 31) | 0x80000000u); }
__device__ __forceinline__ float sort2f(unsigned s) { return __uint_as_float((s & 0x80000000u) ? (s ^ 0x80000000u) : ~s); }

template <int NT>
__device__ __forceinline__ void top16(unsigned (&key)[NT][4], unsigned (&top)[4], int l15) {
#pragma unroll
    for (int r = 0; r < 4; ++r) top[r] = 0u;
    for (int it = 0; it < 16; ++it) {
#pragma unroll
        for (int r = 0; r < 4; ++r) {
            unsigned m = key[0][r];
#pragma unroll
            for (int t = 1; t < NT; ++t) m = m > key[t][r] ? m : key[t][r];
            m = row16_max_u32(m);
            top[r] = (l15 == it) ? m : top[r];
#pragma unroll
            for (int t = 0; t < NT; ++t) key[t][r] = (key[t][r] == m) ? 0u : key[t][r];
        }
    }
}
__device__ __forceinline__ float gelu_erf(float x) { return 0.5f * x * (1.f + erff(x * 0.70710678118654752f)); }

__device__ __forceinline__ void peer_block(const Args& a, LAS unsigned char* lds, int bt) {
    const int tid = threadIdx.x, lane = tid & 63, wave = tid >> 6, l15 = lane & 15, lq = lane >> 4;
    const bf16_t* pq = (const bf16_t*)(a.ws + WS_A);
    LAS bf16_t* SKs = (LAS bf16_t*)lds;
    LAS u32x2* SEL = (LAS u32x2*)(lds + 2 * 128 * LSK * 2);
#ifndef NO_SCORE
    {
        const int tt = wave & 3, hb = (wave >> 2) * 4;
        const int trow = bt * 64 + tt * 16 + l15;
        for (int hh = 0; hh < 4; ++hh) {
            const int h = hb + hh;
            unsigned tc[2][4];
#pragma unroll
            for (int c = 0; c < 2; ++c) {
                bf16x8 af[4];
#pragma unroll
                for (int ks = 0; ks < 4; ++ks) af[ks] = *(const bf16x8*)(pq + (size_t)trow * 2048 + h * 256 + c * 128 + ks * 32 + 8 * lq);
                unsigned key[8][4];
#pragma unroll
                for (int nt = 0; nt < 8; ++nt) {
                    f32x4 acc = {0.f, 0.f, 0.f, 0.f};
#pragma unroll
                    for (int ks = 0; ks < 4; ++ks) {
                        const bf16x8 bv = *(const LAS bf16x8*)(SKs + (c * 128 + nt * 16 + l15) * LSK + ks * 32 + 8 * lq);
                        acc = mfma16(af[ks], bv, acc);
                    }
#pragma unroll
                    for (int r = 0; r < 4; ++r) key[nt][r] = (f2sort(acc[r]) & ~127u) | (unsigned)(nt * 16 + l15);
                }
                top16<8>(key, tc[c], l15);
            }
            const int gb = lane & 48;
#pragma unroll 1
            for (int r = 0; r < 4; ++r) {
                const unsigned t1 = r == 0 ? tc[0][0] : (r == 1 ? tc[0][1] : (r == 2 ? tc[0][2] : tc[0][3]));
                const unsigned t2 = r == 0 ? tc[1][0] : (r == 1 ? tc[1][1] : (r == 2 ? tc[1][2] : tc[1][3]));
                const float v1 = sort2f(t1 & ~127u), v2 = sort2f(t2 & ~127u);
                const int i1 = (int)(t1 & 127u), i2 = (int)(t2 & 127u);
                int ci[4], cj[4]; bool ok[4];
                ci[0] = 0; cj[0] = l15; ok[0] = true;
                ci[1] = l15; cj[1] = 0; ok[1] = l15 >= 1;
                ci[2] = l15 < 7 ? 1 : (l15 < 11 ? 2 : (l15 < 14 ? 3 : 4)); cj[2] = l15 < 7 ? l15 + 1 : (l15 < 11 ? l15 - 6 : (l15 < 14 ? l15 - 10 : l15 - 13)); ok[2] = true;
                ci[3] = 5 + l15; cj[3] = 1; ok[3] = l15 < 3;
                if (!ok[3]) ci[3] = 0;
                unsigned ck[1][4]; int ce[4];
#pragma unroll
                for (int s = 0; s < 4; ++s) {
                    const float a1 = __uint_as_float((unsigned)__builtin_amdgcn_ds_bpermute((gb + ci[s]) * 4, (int)__float_as_uint(v1)));
                    const float a2 = __uint_as_float((unsigned)__builtin_amdgcn_ds_bpermute((gb + cj[s]) * 4, (int)__float_as_uint(v2)));
                    const int e1 = __builtin_amdgcn_ds_bpermute((gb + ci[s]) * 4, i1);
                    const int e2 = __builtin_amdgcn_ds_bpermute((gb + cj[s]) * 4, i2);
                    ce[s] = e1 * 128 + e2;
                    ck[0][s] = ok[s] ? ((f2sort(a1 + a2) & ~63u) | (unsigned)(l15 * 4 + s)) : 0u;
                }
                unsigned topk = 0u;
                for (int it = 0; it < 16; ++it) {
                    unsigned m = ck[0][0] > ck[0][1] ? ck[0][0] : ck[0][1];
                    const unsigned m2 = ck[0][2] > ck[0][3] ? ck[0][2] : ck[0][3];
                    m = m > m2 ? m : m2;
                    m = row16_max_u32(m);
                    topk = (l15 == it) ? m : topk;
#pragma unroll
                    for (int s = 0; s < 4; ++s) ck[0][s] = (ck[0][s] == m) ? 0u : ck[0][s];
                }
                const int own = (int)((topk >> 2) & 15u), slot = (int)(topk & 3u);
                int eid = 0;
#pragma unroll
                for (int s = 0; s < 4; ++s) { const int t = __builtin_amdgcn_ds_bpermute((gb + own) * 4, ce[s]); eid = (slot == s) ? t : eid; }
                const float ts = sort2f(topk & ~63u);
                const float tmax = row16_max_f32(ts);
                const float p = __expf(ts - tmax);
                const float g = p / row16_sum_f32(p);
                u32x2 o; o.x = (unsigned)eid; o.y = __float_as_uint(g);
                SEL[(tt * 16 + lq * 4 + r) * 128 + h * 16 + l15] = o;
            }
        }
    }
#endif
    __syncthreads();
#ifndef NO_GATHER
    const bf16_t* ED = (const bf16_t*)(a.ws + WS_ED);
    const bf16_t* EU = (const bf16_t*)(a.ws + WS_EU);
    for (int tk = 0; tk < 8; ++tk) {
        const int tl = wave * 8 + tk, row = bt * 64 + tl;
        float* hrow = a.out + (size_t)row * D;
        f32x4 hv[4];
        hv[0] = *(const f32x4*)(hrow + 8 * lane); hv[1] = *(const f32x4*)(hrow + 8 * lane + 4);
        hv[2] = *(const f32x4*)(hrow + 512 + 8 * lane); hv[3] = *(const f32x4*)(hrow + 512 + 8 * lane + 4);
        float ss = 0.f;
#pragma unroll
        for (int j = 0; j < 4; ++j) ss += hv[j][0] * hv[j][0] + hv[j][1] * hv[j][1] + hv[j][2] * hv[j][2] + hv[j][3] * hv[j][3];
        const float r2 = rsqrtf(wave_sum(ss) * (1.f / D) + EPS);
        const u32x2 s0 = SEL[tl * 128 + lane], s1 = SEL[tl * 128 + 64 + lane];
        float co[2];
#pragma unroll
        for (int half = 0; half < 2; ++half) {
            const unsigned ev = half ? s1.x : s0.x;
            float mine = 0.f;
            for (int k0 = 0; k0 < 64; k0 += 4) {
                float part[4];
#pragma unroll
                for (int kk = 0; kk < 4; ++kk) {
                    const unsigned e = (unsigned)__builtin_amdgcn_readlane((int)ev, k0 + kk);
                    const bf16_t* er = ED + (size_t)e * D;
                    const u32x4 x0 = *(const u32x4*)(er + 8 * lane), x1 = *(const u32x4*)(er + 512 + 8 * lane);
                    float d = 0.f;
                    d += hv[0][0] * bflo(x0.x) + hv[0][1] * bfhi(x0.x) + hv[0][2] * bflo(x0.y) + hv[0][3] * bfhi(x0.y);
                    d += hv[1][0] * bflo(x0.z) + hv[1][1] * bfhi(x0.z) + hv[1][2] * bflo(x0.w) + hv[1][3] * bfhi(x0.w);
                    d += hv[2][0] * bflo(x1.x) + hv[2][1] * bfhi(x1.x) + hv[2][2] * bflo(x1.y) + hv[2][3] * bfhi(x1.y);
                    d += hv[3][0] * bflo(x1.z) + hv[3][1] * bfhi(x1.z) + hv[3][2] * bflo(x1.w) + hv[3][3] * bfhi(x1.w);
                    part[kk] = d;
                }
#pragma unroll
                for (int kk = 0; kk < 4; ++kk) { const float tot = wave_sum(part[kk]); mine = (lane == k0 + kk) ? tot : mine; }
            }
            const float g = __uint_as_float(half ? s1.y : s0.y);
            co[half] = g * gelu_erf(mine * r2);
        }
        f32x4 acc[4];
#pragma unroll
        for (int j = 0; j < 4; ++j) acc[j] = (f32x4){0.f, 0.f, 0.f, 0.f};
#pragma unroll
        for (int half = 0; half < 2; ++half) {
            const unsigned ev = half ? s1.x : s0.x;
            const float cv = co[half];
            for (int k0 = 0; k0 < 64; k0 += 4) {
#pragma unroll
                for (int kk = 0; kk < 4; ++kk) {
                    const unsigned e = (unsigned)__builtin_amdgcn_readlane((int)ev, k0 + kk);
                    const float cf = __uint_as_float((unsigned)__builtin_amdgcn_readlane((int)__float_as_uint(cv), k0 + kk));
                    const bf16_t* er = EU + (size_t)e * D;
                    const u32x4 x0 = *(const u32x4*)(er + 8 * lane), x1 = *(const u32x4*)(er + 512 + 8 * lane);
                    acc[0][0] += cf * bflo(x0.x); acc[0][1] += cf * bfhi(x0.x); acc[0][2] += cf * bflo(x0.y); acc[0][3] += cf * bfhi(x0.y);
                    acc[1][0] += cf * bflo(x0.z); acc[1][1] += cf * bfhi(x0.z); acc[1][2] += cf * bflo(x0.w); acc[1][3] += cf * bfhi(x0.w);
                    acc[2][0] += cf * bflo(x1.x); acc[2][1] += cf * bfhi(x1.x); acc[2][2] += cf * bflo(x1.y); acc[2][3] += cf * bfhi(x1.y);
                    acc[3][0] += cf * bflo(x1.z); acc[3][1] += cf * bfhi(x1.z); acc[3][2] += cf * bflo(x1.w); acc[3][3] += cf * bfhi(x1.w);
                }
            }
        }
        float s3 = 0.f;
#pragma unroll
        for (int j = 0; j < 4; ++j) { hv[j] = hv[j] + acc[j]; s3 += hv[j][0] * hv[j][0] + hv[j][1] * hv[j][1] + hv[j][2] * hv[j][2] + hv[j][3] * hv[j][3]; }
        float r3 = rsqrtf(wave_sum(s3) * (1.f / D) + EPS);
#ifdef PROBE_NAN
        if (!(fabsf(r3) < 1e30f)) { r3 = 0.f;
#pragma unroll
            for (int j = 0; j < 4; ++j) hv[j] = (f32x4){0.f, 0.f, 0.f, 0.f}; }
#endif
        const float* gf = a.in[I_GFINAL];
        *(f32x4*)(hrow + 8 * lane) = hv[0] * r3 * *(const f32x4*)(gf + 8 * lane);
        *(f32x4*)(hrow + 8 * lane + 4) = hv[1] * r3 * *(const f32x4*)(gf + 8 * lane + 4);
        *(f32x4*)(hrow + 512 + 8 * lane) = hv[2] * r3 * *(const f32x4*)(gf + 512 + 8 * lane);
        *(f32x4*)(hrow + 512 + 8 * lane + 4) = hv[3] * r3 * *(const f32x4*)(gf + 512 + 8 * lane + 4);
    }
#endif
    __syncthreads();
}
__device__ __forceinline__ void peer_phase(const Args& a, LAS unsigned char* lds) {
    const int tid = threadIdx.x;
    {
        LAS bf16_t* SKs = (LAS bf16_t*)lds;
        const bf16_t* sk = (const bf16_t*)(a.ws + WS_SK);
        for (int i = tid; i < 2 * 128 * 16; i += NTHREADS) {
            const int rowi = i >> 4, seg = i & 15;
            *(LAS u32x4*)(SKs + rowi * LSK + seg * 8) = *(const u32x4*)(sk + rowi * 128 + seg * 8);
        }
    }
    __syncthreads();
    for (int bt = blockIdx.x; bt < MTOK / 64; bt += gridDim.x) peer_block(a, lds, bt);
}

#define XB_TMO      128
#define XB_XCNT(j)  (256  + 64 * (j))
#define XB_XSUB(j)  (1280 + 64 * (j))
#define XB_XGEN(j)  (2304 + 64 * (j))
#define XB_TOP      3328
#define XB_TOPGEN   3392
#define XCD_BAR_WORDS 3456
#define XB_SPIN_CAP (1u << 22)
__device__ __forceinline__ unsigned xb_ld(unsigned* p)              { return __hip_atomic_load(p, __ATOMIC_RELAXED, __HIP_MEMORY_SCOPE_AGENT); }
__device__ __forceinline__ unsigned xb_add(unsigned* p, unsigned v) { return __hip_atomic_fetch_add(p, v, __ATOMIC_RELAXED, __HIP_MEMORY_SCOPE_AGENT); }
__device__ __forceinline__ unsigned xb_xcc_id() { return (unsigned)__builtin_amdgcn_s_getreg((3 << 11) | 20) & 0xFu; }
#define XB_SPIN(cond, bar) do { unsigned _sp = 0; while (cond) { __builtin_amdgcn_s_sleep(1); \
    if ((++_sp & 255u) == 0u) { if (xb_ld(&(bar)[XB_TMO])) break; if (_sp > XB_SPIN_CAP) { atomicAdd(&(bar)[XB_TMO], 1u); break; } } } } while (0)
struct XcdBarrier { unsigned* bar; unsigned x; volatile LAS unsigned* st; };
__device__ __forceinline__ XcdBarrier xcd_barrier_post(unsigned* bar, volatile LAS unsigned* st) {
    XcdBarrier b; b.bar = bar; b.x = xb_xcc_id(); b.st = st;
    if (threadIdx.x == 0) (void)xb_add(&bar[XB_XCNT(b.x)], 1u);
    return b;
}
__device__ __forceinline__ void xcd_barrier_complete(unsigned* bar, unsigned x, unsigned& nloc, unsigned& nx) {
    const unsigned G = gridDim.x * gridDim.y * gridDim.z;
    unsigned sum, cnt, mine, sp = 0u;
    for (;;) {
        sum = 0u; cnt = 0u; mine = 0u;
#pragma unroll
        for (unsigned j = 0; j < 16; ++j) { const unsigned c = xb_ld(&bar[XB_XCNT(j)]); sum += c; cnt += (c > 0u) ? 1u : 0u; mine = (j == x) ? c : mine; }
        if (sum == G) break;
        __builtin_amdgcn_s_sleep(1);
        if ((++sp & 255u) == 0u) { if (xb_ld(&bar[XB_TMO])) break; if (sp > XB_SPIN_CAP) { atomicAdd(&bar[XB_TMO], 1u); break; } }
    }
    nloc = mine > 0u ? mine : 1u; nx = cnt > 0u ? cnt : 1u;
}
__device__ __forceinline__ void xcd_barrier(const XcdBarrier& b) {
    asm volatile("s_waitcnt vmcnt(0)" ::: "memory");
    __syncthreads();
    if (threadIdx.x == 0) {
        unsigned* bar = b.bar;
        __builtin_amdgcn_s_waitcnt(0);
        unsigned nloc = b.st[0], nx = b.st[1];
        if (nloc == 0u) { xcd_barrier_complete(bar, b.x, nloc, nx); b.st[0] = nloc; b.st[1] = nx; }
        const unsigned old = xb_add(&bar[XB_XSUB(b.x)], 1u);
        const unsigned gen = old / nloc;
        if (old + 1u == (gen + 1u) * nloc) {
            __builtin_amdgcn_fence(__ATOMIC_RELEASE, "agent");
            asm volatile("s_waitcnt vmcnt(0)" ::: "memory");
            const unsigned og = xb_add(&bar[XB_TOP], 1u);
            const unsigned tg = og / nx;
            if (og + 1u == (tg + 1u) * nx) xb_add(&bar[XB_TOPGEN], 1u);
            else XB_SPIN(xb_ld(&bar[XB_TOPGEN]) == tg, bar);
            __builtin_amdgcn_fence(__ATOMIC_ACQUIRE, "agent");
            xb_add(&bar[XB_XGEN(b.x)], 1u);
            asm volatile("s_waitcnt vmcnt(0)" ::: "memory");
        } else {
            XB_SPIN(xb_ld(&bar[XB_XGEN(b.x)]) == gen, bar);
            __builtin_amdgcn_fence(__ATOMIC_ACQUIRE, "agent");
            asm volatile("s_waitcnt vmcnt(0)" ::: "memory");
        }
    }
    __syncthreads();
}


#ifndef PROBE_FROM_X
#define PROBE_FROM_X 0
#endif
__device__ __forceinline__ void dbg_final(const Args& a, const bf16_t* scan, int ld, int ncols) {
    const int lane = threadIdx.x & 63, wave = threadIdx.x >> 6;
    for (int row = blockIdx.x * NWAVES + wave; row < MTOK; row += gridDim.x * NWAVES) {
        float* hrow = a.out + (size_t)row * D;
        f32x4 hv[4]; float ss = 0.f;
#pragma unroll
        for (int j = 0; j < 4; ++j) { hv[j] = *(const f32x4*)((PROBE_FROM_X ? a.in[I_X] + (size_t)row * D : hrow) + 4 * lane + 256 * j); ss += hv[j][0] * hv[j][0] + hv[j][1] * hv[j][1] + hv[j][2] * hv[j][2] + hv[j][3] * hv[j][3]; }
        float bad = 0.f;
        if (scan) for (int c = lane; c < ncols; c += 64) { const float v = bf2f(scan[(size_t)row * ld + c]); if (!(fabsf(v) < 1e30f)) bad = 1.f; }
        bad = wave_sum(bad);
        float r3 = rsqrtf(wave_sum(ss) * (1.f / D) + EPS);
        if (!(fabsf(r3) < 1e30f) || bad > 0.f) r3 = 0.f;
#pragma unroll
        for (int j = 0; j < 4; ++j) { f32x4 o = hv[j] * r3 * *(const f32x4*)(a.in[I_GFINAL] + 4 * lane + 256 * j);
            if (r3 == 0.f) o = (f32x4){0.f, 0.f, 0.f, 0.f};
            *(f32x4*)(hrow + 4 * lane + 256 * j) = o; }
    }
}
constexpr int NPHASES = 11;
__global__ __launch_bounds__(NTHREADS, 2) void hybrid_fwd(Args a) {
    extern __shared__ __attribute__((aligned(16))) unsigned char smem[];
    LAS unsigned char* lds = (LAS unsigned char*)smem;
    volatile LAS unsigned* xbw = (volatile LAS unsigned*)(lds + LDS_BYTES - 16);
    unsigned char* ws = a.ws;
    const int G = gridDim.x;
    if (threadIdx.x == 0) { xbw[0] = 0u; xbw[1] = 0u; xbw[2] = 0u; xbw[3] = 0u; }
    __syncthreads();
    XcdBarrier xb; xb.bar = (unsigned*)(ws + WS_BAR); xb.x = 0; xb.st = xbw;
    const bool multi = (a.ph_hi - a.ph_lo) > 1;
    if (multi) xb = xcd_barrier_post((unsigned*)(ws + WS_BAR), xbw);
#ifndef ONLY_PHASE
#define PHON(n) 1
#else
#define PHON(n) ((n) == ONLY_PHASE)
#endif
#define PH_BEGIN(n) if (PHON(n) && a.ph_lo <= (n) && (n) < a.ph_hi) {
#define PH_END(n) if ((n) + 1 < a.ph_hi) xcd_barrier(xb); }
    PH_BEGIN(0) phase0(a, lds); PH_END(0)
    PH_BEGIN(1)
        { pg8::Gemm g{(const bf16_t*)(ws + WS_B), (const bf16_t*)(ws + WS_WIN), MTOK, NPROJ, D};
          pg8::StaticOrder S; S.init(g.M, g.N, G, blockIdx.x);
          EpiRowBf16 E{(bf16_t*)(ws + WS_A), NPROJ, nullptr, 1.0f};
          pg8::gemm_phase<EpiRowBf16, pg8::StaticOrder, false>(lds, g, S, E, nullptr); }
        { pg8::Gemm g{(const bf16_t*)(ws + WS_C), (const bf16_t*)(ws + WS_WXKV), NB * MEMLEN, 2048, D};
          pg8::StaticOrder S; S.init(g.M, g.N, G, (blockIdx.x + G - (64 % G)) % G);
          EpiKV E{(bf16_t*)(ws + WS_KMEM), (bf16_t*)(ws + WS_VTMEM)};
          pg8::gemm_phase<EpiKV, pg8::StaticOrder, false>(lds, g, S, E, nullptr); }
    PH_END(1)
    PH_BEGIN(2) for (int t = blockIdx.x; t < 2048; t += G) { if (t < 1024) mlstm_local(a, lds, t); else swa_task(a, lds, t - 1024); } PH_END(2)
    PH_BEGIN(3) mlstm_scan(a); PH_END(3)
    PH_BEGIN(4) for (int t = blockIdx.x; t < 1024; t += G) mlstm_out(a, lds, t); PH_END(4)
    PH_BEGIN(5) { pg8::Gemm g{(const bf16_t*)(ws + WS_C), (const bf16_t*)(ws + WS_WOUT), MTOK, D, D};
          pg8::StaticOrder S; S.init(g.M, g.N, G, blockIdx.x);
          EpiResid E{a.out, a.in[I_X], (bf16_t*)(ws + WS_B), (float*)(ws + WS_SSQ)};
          pg8::gemm_phase<EpiResid, pg8::StaticOrder, false>(lds, g, S, E, nullptr); } PH_END(5)
    PH_BEGIN(6) { pg8::Gemm g{(const bf16_t*)(ws + WS_B), (const bf16_t*)(ws + WS_WXQ), MTOK, D, D};
          pg8::StaticOrder S; S.init(g.M, g.N, G, blockIdx.x);
          EpiRowBf16 E{(bf16_t*)(ws + WS_A), D, (const float*)(ws + WS_SSQ), 0.0625f};
          pg8::gemm_phase<EpiRowBf16, pg8::StaticOrder, false>(lds, g, S, E, nullptr); } PH_END(6)
    PH_BEGIN(7) for (int t = blockIdx.x; t < 512; t += G) xattn_task(a, lds, t); PH_END(7)
    PH_BEGIN(8) { pg8::Gemm g{(const bf16_t*)(ws + WS_A + 32 * MiB), (const bf16_t*)(ws + WS_WXO), MTOK, D, D};
          pg8::StaticOrder S; S.init(g.M, g.N, G, blockIdx.x);
          EpiResid E{a.out, a.out, (bf16_t*)(ws + WS_B), (float*)(ws + WS_SSQ)};
          pg8::gemm_phase<EpiResid, pg8::StaticOrder, false>(lds, g, S, E, nullptr); } PH_END(8)
    PH_BEGIN(9) { pg8::Gemm g{(const bf16_t*)(ws + WS_B), (const bf16_t*)(ws + WS_WPQ), MTOK, 2048, D};
          pg8::StaticOrder S; S.init(g.M, g.N, G, blockIdx.x);
          EpiRowBf16 E{(bf16_t*)(ws + WS_A), 2048, (const float*)(ws + WS_SSQ), 1.0f};
          pg8::gemm_phase<EpiRowBf16, pg8::StaticOrder, false>(lds, g, S, E, nullptr); } PH_END(9)
    PH_BEGIN(10) peer_phase(a, lds); PH_END(10)
#ifdef PROBE_STOP
    if (a.ph_lo == 11) dbg_final(a, PROBE_SCAN);
#endif
}

#ifndef MK_ONE_LAUNCH
#define MK_ONE_LAUNCH 0
#endif
extern "C" void kernel_launch(void* const* d_in, const int* in_sizes, int n_in, void* d_out, int out_size, void* d_ws, size_t ws_size, hipStream_t stream) {
    static int grid = 0;
    if (grid == 0) {
        if (n_in != 24 || out_size != MTOK * D || ws_size < WS_END) { fprintf(stderr, "kernel_launch: unexpected shapes (n_in %d out %d ws %zu)\n", n_in, out_size, ws_size); grid = -1; return; }
        int dev = 0, cus = 0;
        if (hipGetDevice(&dev) != hipSuccess || hipDeviceGetAttribute(&cus, hipDeviceAttributeMultiprocessorCount, dev) != hipSuccess) { grid = -1; return; }
        if (hipFuncSetAttribute((const void*)hybrid_fwd, hipFuncAttributeMaxDynamicSharedMemorySize, LDS_BYTES) != hipSuccess) { fprintf(stderr, "kernel_launch: hipFuncSetAttribute failed\n"); grid = -1; return; }
        int per_cu = 0;
        if (hipOccupancyMaxActiveBlocksPerMultiprocessor(&per_cu, (const void*)hybrid_fwd, NTHREADS, LDS_BYTES) != hipSuccess || per_cu < 1) { fprintf(stderr, "kernel_launch: occupancy query says %d\n", per_cu); }
        (void)hipGetLastError();
        grid = cus;
    }
    if (grid < 0) return;
    (void)hipMemsetAsync((char*)d_ws + WS_BAR, 0, XCD_BAR_WORDS * 4, stream);
    Args a{};
    for (int i = 0; i < 24; ++i) a.in[i] = (const float*)d_in[i];
    a.out = (float*)d_out; a.ws = (unsigned char*)d_ws;
#if MK_ONE_LAUNCH
    a.ph_lo = 0; a.ph_hi = NPHASES;
    hipLaunchKernelGGL(hybrid_fwd, dim3(grid), dim3(NTHREADS), LDS_BYTES, stream, a);
#else
#ifdef PROBE_STOP
    for (int ph = 0; ph <= PROBE_STOP; ++ph) {
        a.ph_lo = (ph == PROBE_STOP) ? 11 : ph; a.ph_hi = a.ph_lo + 1;
#else
    for (int ph = 0; ph < NPHASES; ++ph) {
        a.ph_lo = ph; a.ph_hi = ph + 1;
#endif
        hipLaunchKernelGGL(hybrid_fwd, dim3(grid), dim3(NTHREADS), LDS_BYTES, stream, a);
    }
#endif
}
```

```cpp
#include <hip/hip_runtime.h>
#include <cstdio>
#include <cstdint>
namespace pg8 {
#define PG8_LAS __attribute__((address_space(3)))
typedef unsigned short bf16_t;
typedef short bf16x8 __attribute__((ext_vector_type(8)));
typedef float f32x4 __attribute__((ext_vector_type(4)));
typedef unsigned u32x4 __attribute__((ext_vector_type(4)));
constexpr int BM = 256, BK = 64, HALF = 128, HTB = HALF * BK * 2  , STAGE_BYTES = 8 * HTB, NXCD = 8, WGM = 8;

__host__ __device__ __forceinline__ int lds_byte(int r, int c) { const int st = (r >> 4) * 2 + (c >> 5), rr = r & 15, cc = c & 31, ob = rr * 64 + cc * 2; return st * 1024 + (ob ^ (((ob >> 9) & 1) << 5)); }
__host__ __device__ __forceinline__ void stage_rc(int b, int& R, int& C) { const int st = b / 1024, sb = b % 1024, swz = sb ^ (((sb >> 9) & 1) << 5); R = (st >> 1) * 16 + swz / 64; C = (st & 1) * 32 + (swz % 64) / 2; }
__host__ __device__ __forceinline__ int perm32(int rho) { const int n = rho >> 4, i = rho & 15; return 8 * (i >> 2) + 4 * n + (i & 3); }

struct Unit { int pm, pn; };
struct Gemm { const bf16_t* A; const bf16_t* Bt; int M, N, K; int pm_split; size_t bt_split_bytes; };

struct StaticOrder {
    int nM, nN, nwg, G, c;
    __host__ __device__ void init(int M, int N, int G_, int c_) { nM = M / BM; nN = N / BM; nwg = nM * nN; G = G_; c = c_; }
    __host__ __device__ bool next(int i, Unit& u) const {
        const long L = (long)i * G + c; if (L >= nwg) return false;
        int wgid = (int)L; { const int q = nwg / NXCD, r = nwg % NXCD, xcd = wgid % NXCD, off = wgid / NXCD; wgid = (xcd < r ? xcd * (q + 1) : r * (q + 1) + (xcd - r) * q) + off; }
        const int nig = WGM * nN, gid = wgid / nig, fm = gid * WGM, gsz = (nM - fm) < WGM ? (nM - fm) : WGM;
        u.pm = fm + ((wgid % nig) % gsz); u.pn = (wgid % nig) / gsz; return true;
    }
    __device__ __forceinline__ void a_ready(const Unit&) const {}
    __device__ __forceinline__ void done(const Unit&) const {}
};
__device__ __forceinline__ unsigned cvt_pk_bf16(float lo, float hi) { unsigned r; asm volatile("v_cvt_pk_bf16_f32 %0, %1, %2" : "=v"(r) : "v"(lo), "v"(hi)); return r; }
typedef float f32x2 __attribute__((ext_vector_type(2)));
__device__ __forceinline__ f32x2 gelu_pk(f32x2 v) {
    const f32x2 av = __builtin_elementwise_abs(v), d = av * 0.2316418882f + 1.0f;
    f32x2 t; t.x = __builtin_amdgcn_rcpf(d.x); t.y = __builtin_amdgcn_rcpf(d.y);
    f32x2 q = t * 0.5307027145f + (-0.7265760135f); q = q * t + 0.7107068705f; q = q * t + (-0.142248368f); q = q * t + 0.127414796f; q = q * t;
    const f32x2 s = (v * v) * (-0.72134752044f);
    f32x2 e; e.x = __builtin_amdgcn_exp2f(s.x); e.y = __builtin_amdgcn_exp2f(s.y);
    const f32x2 m = v * (q * e), r = v - m;
    f32x2 o; o.x = v.x < 0.f ? m.x : r.x; o.y = v.y < 0.f ? m.y : r.y; return o;
}

template <class Epi, class Sched, bool STAMP = false>
__device__ __forceinline__ void gemm_phase(PG8_LAS unsigned char* lds, const Gemm g, const Sched& S, const Epi& E, unsigned long long* stamps) {
    const int tid = threadIdx.x, wid = __builtin_amdgcn_readfirstlane(tid >> 6), lane = tid & 63, wr = wid >> 2, wc = wid & 3, fr = lane & 15, fq = lane >> 4;
    const int K = g.K, nt = K / BK;
    int ts_lo = 0, ts_hi = 0, nts = 0; const unsigned long long rt_entry = STAMP ? (unsigned long long)wall_clock64() : 0ull;
#define PG8_STAMP() do { if (STAMP && wid == 0 && nts < 64) { const unsigned long long _c = (unsigned long long)clock64(); \
        ts_lo = (lane == nts) ? (int)(unsigned)_c : ts_lo; ts_hi = (lane == nts) ? (int)(unsigned)(_c >> 32) : ts_hi; ++nts; } } while (0)
    PG8_STAMP();
    unsigned voffA[2], voffB[2];
#pragma unroll
    for (int i = 0; i < 2; ++i) { int R, C; stage_rc(tid * 16 + i * 8192, R, C); const int Rb = Epi::PERM ? ((R & ~31) + perm32(R & 31)) : R;
        voffA[i] = (unsigned)(R * K + C) * 2u; voffB[i] = (unsigned)(Rb * K + C) * 2u; }
    const size_t kstep = (size_t)(BK * 2);
    const size_t hstep = (size_t)HALF * K * 2;
    const size_t tstep = 2 * hstep;
    const unsigned ldsw = (unsigned)wid * 1024u;
    const int aoff = lds_byte(wr * 64 + fr, fq * 8), boff = lds_byte(wc * 32 + fr, fq * 8);
#define PG8_SA(b, h) (((b) * 2 + (h)) * HTB)
#define PG8_SB(b, h) ((4 + (b) * 2 + (h)) * HTB)
#define PG8_STAGE(bufoff, gbase, voff) do { _Pragma("unroll") for (int _i = 0; _i < 2; ++_i) \
        __builtin_amdgcn_global_load_lds((const unsigned*)((const char*)(gbase) + (voff)[_i]), (PG8_LAS unsigned*)(lds + (bufoff) + ldsw + _i * 8192), 16, 0, 0); } while (0)
#define PG8_LDA(dst, b, h) do { _Pragma("unroll") for (int m = 0; m < 4; ++m) _Pragma("unroll") for (int k = 0; k < 2; ++k) dst[m][k] = *(const PG8_LAS bf16x8*)(lds + PG8_SA(b, h) + aoff + m * 2048 + k * 1024); } while (0)
#define PG8_LDB(dst, b, h) do { _Pragma("unroll") for (int n = 0; n < 2; ++n) _Pragma("unroll") for (int k = 0; k < 2; ++k) dst[n][k] = *(const PG8_LAS bf16x8*)(lds + PG8_SB(b, h) + boff + n * 2048 + k * 1024); } while (0)
#define PG8_MMA(ai, bj, At, Bt) do { __builtin_amdgcn_s_setprio(1); _Pragma("unroll") for (int m = 0; m < 4; ++m) _Pragma("unroll") for (int n = 0; n < 2; ++n) _Pragma("unroll") for (int k = 0; k < 2; ++k) \
        acc[ai][bj][m][n] = __builtin_amdgcn_mfma_f32_16x16x32_bf16(Bt[n][k], At[m][k], acc[ai][bj][m][n], 0, 0, 0); __builtin_amdgcn_s_setprio(0); } while (0)
#define PG8_WAIT_V(n) asm volatile("s_waitcnt vmcnt(" #n ")" ::: "memory")
#define PG8_WAIT_L(n) asm volatile("s_waitcnt lgkmcnt(" #n ")" ::: "memory")
#define PG8_BAR __builtin_amdgcn_s_barrier()
#define PG8_SCHED __builtin_amdgcn_sched_barrier(0)
    Unit cur, nxt; int ui = 0;
    if (!S.next(0, cur)) return;
    f32x4 acc[2][2][4][2];
#pragma unroll
    for (int a = 0; a < 2; ++a)
#pragma unroll
        for (int b = 0; b < 2; ++b)
#pragma unroll
            for (int m = 0; m < 4; ++m)
#pragma unroll
                for (int n = 0; n < 2; ++n) acc[a][b][m][n] = (f32x4){0.f, 0.f, 0.f, 0.f};
    bf16x8 At[4][2], B0[2][2], B1[2][2];
    const char* cA = (const char*)g.A + (size_t)cur.pm * tstep; const char* cB = (const char*)g.Bt + (size_t)cur.pn * tstep + ((g.pm_split > 0 && cur.pm >= g.pm_split) ? g.bt_split_bytes : (size_t)0);
    S.a_ready(cur);
    PG8_STAGE(PG8_SB(0, 0), cB, voffB); PG8_STAGE(PG8_SA(0, 0), cA, voffA); PG8_STAGE(PG8_SB(0, 1), cB + hstep, voffB); PG8_STAGE(PG8_SA(0, 1), cA + hstep, voffA);
    if (wr == 1) PG8_BAR;
    PG8_WAIT_V(4); PG8_BAR;
    PG8_STAGE(PG8_SB(1, 0), cB + kstep, voffB); PG8_STAGE(PG8_SA(1, 0), cA + kstep, voffA); PG8_STAGE(PG8_SB(1, 1), cB + hstep + kstep, voffB);
    PG8_WAIT_V(6); PG8_BAR;
    PG8_STAMP();
    for (;;) {
        const bool has_next = S.next(ui + 1, nxt);
        const char* nA = has_next ? (const char*)g.A + (size_t)nxt.pm * tstep : cA; const char* nB = has_next ? (const char*)g.Bt + (size_t)nxt.pn * tstep + ((g.pm_split > 0 && nxt.pm >= g.pm_split) ? g.bt_split_bytes : (size_t)0) : cB;
        for (int t = 0; t < nt; t += 2) {
            const bool last = (t == nt - 2);
            const char* a1 = cA + (size_t)(t + 1) * kstep;
            const char* a2 = last ? nA : cA + (size_t)(t + 2) * kstep; const char* b2 = last ? nB : cB + (size_t)(t + 2) * kstep;
            const char* a3 = a2 + kstep; const char* b3 = b2 + kstep;
            if (last && has_next) S.a_ready(nxt);
            PG8_LDB(B0, 0, 0); PG8_SCHED; PG8_LDA(At, 0, 0); PG8_STAGE(PG8_SA(1, 1), a1 + hstep, voffA);
            PG8_WAIT_L(8); PG8_BAR; PG8_WAIT_L(0); PG8_MMA(0, 0, At, B0); PG8_BAR; PG8_SCHED;
            PG8_LDB(B1, 0, 1); PG8_STAGE(PG8_SB(0, 0), b2, voffB);
            PG8_BAR; PG8_WAIT_L(0); PG8_MMA(0, 1, At, B1); PG8_BAR;
            PG8_LDA(At, 0, 1); PG8_STAGE(PG8_SA(0, 0), a2, voffA);
            PG8_BAR; PG8_WAIT_L(0); PG8_MMA(1, 0, At, B0); PG8_BAR; PG8_SCHED;
            PG8_STAGE(PG8_SB(0, 1), b2 + hstep, voffB);
            PG8_WAIT_V(6); PG8_BAR; PG8_MMA(1, 1, At, B1); PG8_BAR;
            PG8_LDB(B0, 1, 0); PG8_SCHED; PG8_LDA(At, 1, 0); PG8_STAGE(PG8_SA(0, 1), a2 + hstep, voffA);
            PG8_WAIT_L(8); PG8_BAR; PG8_WAIT_L(0); PG8_MMA(0, 0, At, B0); PG8_BAR; PG8_SCHED;
            PG8_LDB(B1, 1, 1); PG8_STAGE(PG8_SB(1, 0), b3, voffB);
            PG8_BAR; PG8_WAIT_L(0); PG8_MMA(0, 1, At, B1); PG8_BAR;
            PG8_LDA(At, 1, 1); PG8_STAGE(PG8_SA(1, 0), a3, voffA);
            PG8_BAR; PG8_WAIT_L(0); PG8_MMA(1, 0, At, B0); PG8_BAR; PG8_SCHED;
            PG8_STAGE(PG8_SB(1, 1), b3 + hstep, voffB);
            PG8_WAIT_V(6); PG8_BAR; PG8_MMA(1, 1, At, B1); PG8_BAR;
        }
        PG8_STAMP();
        if constexpr (!Epi::AFTER_DRAIN) { E(acc, cur, wr, wc, fr, fq); S.done(cur); }
        PG8_STAMP();
        if (!has_next) break;
#pragma unroll
        for (int a = 0; a < 2; ++a)
#pragma unroll
            for (int b = 0; b < 2; ++b)
#pragma unroll
                for (int m = 0; m < 4; ++m)
#pragma unroll
                    for (int n = 0; n < 2; ++n) acc[a][b][m][n] = (f32x4){0.f, 0.f, 0.f, 0.f};
        cur = nxt; cA = nA; cB = nB; ++ui;
    }
    PG8_WAIT_V(0);
    if (wr == 0) PG8_BAR;
    PG8_BAR;
    if constexpr (Epi::AFTER_DRAIN) { E.fused(acc, cur, wr, wc, fr, fq, lds, wid, lane); S.done(cur); }
    PG8_STAMP();
    if (STAMP && wid == 0) { stamps[lane] = lane < nts ? (((unsigned long long)(unsigned)ts_hi << 32) | (unsigned)ts_lo) : 0ull;
        if (lane == 62) stamps[62] = rt_entry; if (lane == 63) stamps[63] = (unsigned long long)wall_clock64(); }
#undef PG8_STAMP
#undef PG8_SA
#undef PG8_SB
#undef PG8_STAGE
#undef PG8_LDA
#undef PG8_LDB
#undef PG8_MMA
#undef PG8_WAIT_V
#undef PG8_WAIT_L
#undef PG8_BAR
#undef PG8_SCHED
}
}

#define LAS __attribute__((address_space(3)))
typedef unsigned short bf16_t;
typedef short bf16x8 __attribute__((ext_vector_type(8)));
typedef short bf16x4 __attribute__((ext_vector_type(4)));
typedef float f32x4 __attribute__((ext_vector_type(4)));
typedef unsigned u32x4 __attribute__((ext_vector_type(4)));
typedef unsigned u32x2 __attribute__((ext_vector_type(2)));

constexpr int D = 1024, NB = 2, SEQ = 8192, MTOK = NB * SEQ, MEMLEN = 256;
constexpr int NPROJ = 2304;
constexpr int C_MQ = 0, C_MK = 256, C_MV = 512, C_MO = 1024, C_AQ = 1536, C_AK = 2048, C_AV = 2176;
constexpr float EPS = 1e-6f;
constexpr int NTHREADS = 512, NWAVES = 8;
constexpr int LDS_BYTES = 144 * 1024;

constexpr size_t MiB = (size_t)1 << 20;
constexpr size_t WS_A = 0;
constexpr size_t WS_B = 72 * MiB;
constexpr size_t WS_C = 104 * MiB;
constexpr size_t WS_ED = 136 * MiB;
constexpr size_t WS_EU = 152 * MiB;
constexpr size_t WS_WIN = 200 * MiB;
constexpr size_t WS_WOUT = WS_WIN + 2304 * 1024 * 2;
constexpr size_t WS_WXQ = WS_WOUT + 2 * MiB;
constexpr size_t WS_WXKV = WS_WXQ + 2 * MiB;
constexpr size_t WS_WXO = WS_WXKV + 4 * MiB;
constexpr size_t WS_WPQ = WS_WXO + 2 * MiB;
constexpr size_t WS_G = 219 * MiB;
constexpr size_t WS_GATES = WS_G;
constexpr size_t WS_KMEM = WS_GATES + 512 * 1024;
constexpr size_t WS_VTMEM = WS_KMEM + MiB;
constexpr size_t WS_SSQ = WS_VTMEM + MiB;
constexpr size_t WS_DN = WS_SSQ + MiB;
constexpr size_t WS_DECAY = WS_DN + 256 * 1024;
constexpr size_t WS_SK = WS_DECAY + 4096;
constexpr size_t WS_ESC = WS_SK + 65536;
constexpr size_t WS_SELE = WS_A + 64 * MiB;
constexpr size_t WS_SELG = WS_C;
constexpr size_t WS_COEF = WS_C + 8 * MiB;
constexpr size_t WS_R2 = WS_C + 16 * MiB;
constexpr size_t WS_SSQ3 = WS_C + 17 * MiB;
constexpr size_t WS_PART = WS_A;
constexpr size_t WS_ST = 168 * MiB;
constexpr size_t WS_HQH = 168 * MiB;
constexpr size_t WS_HQL = 184 * MiB;
constexpr size_t WS_HS = WS_C + 18 * MiB;
constexpr size_t WS_CS = WS_C + 19 * MiB;
constexpr size_t WS_BAR = 223 * MiB;
constexpr size_t WS_BTO = 224 * MiB;
constexpr size_t WS_WGR = 228 * MiB;
constexpr size_t WS_END = 232 * MiB;

struct Args {
    const float* in[24];
    float* out;
    unsigned char* ws;
    int ph_lo, ph_hi;
};
enum { I_X = 0, I_MEM, I_GMIX, I_WIN, I_CONVW, I_CONVB, I_BI, I_BF, I_GMHEAD, I_SINKS, I_WOUT, I_GCROSS, I_GMEM, I_WXQ, I_WXK, I_WXV, I_WXO,
       I_GFFN, I_WPQ, I_SK1, I_SK2, I_EDOWN, I_EUP, I_GFINAL };

typedef __bf16 bf16x2_t __attribute__((ext_vector_type(2)));
typedef float f32x2_t __attribute__((ext_vector_type(2)));
__device__ __forceinline__ unsigned pk2(float lo, float hi) { f32x2_t v = {lo, hi}; bf16x2_t b = __builtin_convertvector(v, bf16x2_t); return __builtin_bit_cast(unsigned, b); }
__device__ __forceinline__ bf16_t f2bf(float f) { return (bf16_t)(pk2(f, 0.f) & 0xffffu); }
__device__ __forceinline__ float bf2f(unsigned b) { return __uint_as_float(b << 16); }
__device__ __forceinline__ float bflo(unsigned w) { return __uint_as_float(w << 16); }
__device__ __forceinline__ float bfhi(unsigned w) { return __uint_as_float(w & 0xffff0000u); }
__device__ __forceinline__ float wave_sum(float v) {
#pragma unroll
    for (int o = 1; o < 64; o <<= 1) v += __shfl_xor(v, o);
    return v;
}
__device__ __forceinline__ float sigmoidf_(float x) { return 1.f / (1.f + __expf(-x)); }
#define LDS_FENCE() asm volatile("s_waitcnt lgkmcnt(0)" ::: "memory")

__device__ __forceinline__ unsigned dppu(unsigned x, int ctrl_sel) {
    switch (ctrl_sel) {
        case 0: return (unsigned)__builtin_amdgcn_update_dpp(0, (int)x, 0xB1, 0xF, 0xF, true);
        case 1: return (unsigned)__builtin_amdgcn_update_dpp(0, (int)x, 0x4E, 0xF, 0xF, true);
        case 2: return (unsigned)__builtin_amdgcn_update_dpp(0, (int)x, 0x141, 0xF, 0xF, true);
        default: return (unsigned)__builtin_amdgcn_update_dpp(0, (int)x, 0x140, 0xF, 0xF, true);
    }
}
__device__ __forceinline__ unsigned row16_max_u32(unsigned x) {
    unsigned y;
    y = dppu(x, 0); x = x > y ? x : y;
    y = dppu(x, 1); x = x > y ? x : y;
    y = dppu(x, 2); x = x > y ? x : y;
    y = dppu(x, 3); x = x > y ? x : y;
    return x;
}
__device__ __forceinline__ float row16_sum_f32(float x) {
    x += __uint_as_float(dppu(__float_as_uint(x), 0));
    x += __uint_as_float(dppu(__float_as_uint(x), 1));
    x += __uint_as_float(dppu(__float_as_uint(x), 2));
    x += __uint_as_float(dppu(__float_as_uint(x), 3));
    return x;
}
__device__ __forceinline__ float row16_max_f32(float x) {
    x = fmaxf(x, __uint_as_float(dppu(__float_as_uint(x), 0)));
    x = fmaxf(x, __uint_as_float(dppu(__float_as_uint(x), 1)));
    x = fmaxf(x, __uint_as_float(dppu(__float_as_uint(x), 2)));
    x = fmaxf(x, __uint_as_float(dppu(__float_as_uint(x), 3)));
    return x;
}
__device__ __forceinline__ f32x4 mfma16(bf16x8 a, bf16x8 b, f32x4 c) { return __builtin_amdgcn_mfma_f32_16x16x32_bf16(a, b, c, 0, 0, 0); }

__device__ __forceinline__ float row_rscale(const float* ssq, int row) {
    float s = 0.f;
#pragma unroll
    for (int p = 0; p < 16; ++p) s += ssq[(size_t)p * MTOK + row];
    return rsqrtf(s * (1.f / D) + EPS);
}
struct EpiRowBf16 {
    static constexpr bool PERM = true, AFTER_DRAIN = false;
    bf16_t* O; int ldc; const float* ssq; float mul;
    __device__ __forceinline__ void operator()(const f32x4 (&acc)[2][2][4][2], const pg8::Unit& u, int wr, int wc, int fr, int fq) const {
        const int row0 = u.pm * 256 + wr * 64 + fr, col0 = u.pn * 256 + wc * 32 + 8 * fq;
#pragma unroll
        for (int ai = 0; ai < 2; ++ai)
#pragma unroll
            for (int m = 0; m < 4; ++m) {
                const int row = row0 + ai * 128 + m * 16;
                const float sc = ssq ? row_rscale(ssq, row) * mul : mul;
                bf16_t* rowp = O + (size_t)row * ldc + col0;
#pragma unroll
                for (int bj = 0; bj < 2; ++bj) {
                    const f32x4 v0 = acc[ai][bj][m][0] * sc, v1 = acc[ai][bj][m][1] * sc;
                    u32x4 w; w.x = pk2(v0[0], v0[1]); w.y = pk2(v0[2], v0[3]); w.z = pk2(v1[0], v1[1]); w.w = pk2(v1[2], v1[3]);
                    *(u32x4*)(rowp + bj * 128) = w;
                }
            }
    }
};
template <bool RES_BF16>
struct EpiResid {
    static constexpr bool PERM = true, AFTER_DRAIN = false;
    const void* R; bf16_t* Hb; float* ssq;
    __device__ __forceinline__ void operator()(const f32x4 (&acc)[2][2][4][2], const pg8::Unit& u, int wr, int wc, int fr, int fq) const {
        const int row0 = u.pm * 256 + wr * 64 + fr, col0 = u.pn * 256 + wc * 32 + 8 * fq;
#pragma unroll
        for (int ai = 0; ai < 2; ++ai)
#pragma unroll
            for (int m = 0; m < 4; ++m) {
                const int row = row0 + ai * 128 + m * 16;
                const size_t off = (size_t)row * D + col0;
                float ss = 0.f;
#pragma unroll
                for (int bj = 0; bj < 2; ++bj) {
                    f32x4 r0, r1;
                    if (RES_BF16) { const u32x4 rb = *(const u32x4*)((const bf16_t*)R + off + bj * 128);
                        r0 = (f32x4){bflo(rb.x), bfhi(rb.x), bflo(rb.y), bfhi(rb.y)}; r1 = (f32x4){bflo(rb.z), bfhi(rb.z), bflo(rb.w), bfhi(rb.w)}; }
                    else { r0 = *(const f32x4*)((const float*)R + off + bj * 128); r1 = *(const f32x4*)((const float*)R + off + bj * 128 + 4); }
                    const f32x4 v0 = acc[ai][bj][m][0] + r0, v1 = acc[ai][bj][m][1] + r1;
                    u32x4 w; w.x = pk2(v0[0], v0[1]); w.y = pk2(v0[2], v0[3]); w.z = pk2(v1[0], v1[1]); w.w = pk2(v1[2], v1[3]);
                    *(u32x4*)(Hb + off + bj * 128) = w;
                    ss += v0[0] * v0[0] + v0[1] * v0[1] + v0[2] * v0[2] + v0[3] * v0[3] + v1[0] * v1[0] + v1[1] * v1[1] + v1[2] * v1[2] + v1[3] * v1[3];
                }
                ss += __shfl_xor(ss, 16); ss += __shfl_xor(ss, 32);
                if (fq == 0) ssq[(size_t)(u.pn * 4 + wc) * MTOK + row] = ss;
            }
    }
};
struct EpiKV {
    static constexpr bool PERM = true, AFTER_DRAIN = false;
    bf16_t* Kh; bf16_t* Vh;
    __device__ __forceinline__ void operator()(const f32x4 (&acc)[2][2][4][2], const pg8::Unit& u, int wr, int wc, int fr, int fq) const {
        const int row0 = u.pm * 256 + wr * 64 + fr, col0 = u.pn * 256 + wc * 32 + 8 * fq;
#pragma unroll
        for (int ai = 0; ai < 2; ++ai)
#pragma unroll
            for (int m = 0; m < 4; ++m) {
                const int row = row0 + ai * 128 + m * 16;
#pragma unroll
                for (int bj = 0; bj < 2; ++bj) {
                    const f32x4 v0 = acc[ai][bj][m][0], v1 = acc[ai][bj][m][1];
                    const int c = col0 + bj * 128, cc = c & 1023;
                    u32x4 w; w.x = pk2(v0[0], v0[1]); w.y = pk2(v0[2], v0[3]); w.z = pk2(v1[0], v1[1]); w.w = pk2(v1[2], v1[3]);
                    *(u32x4*)((c < 1024 ? Kh : Vh) + ((size_t)((row >> 8) * 4 + (cc >> 8)) * 256 + (row & 255)) * 256 + (cc & 255)) = w;
                }
            }
    }
};
struct EpiSoftmax {
    static constexpr bool PERM = true, AFTER_DRAIN = true;
    bf16_t* O; const float* ssq;
    __device__ __forceinline__ void operator()(const f32x4 (&)[2][2][4][2], const pg8::Unit&, int, int, int, int) const {}
    __device__ __forceinline__ void fused(const f32x4 (&acc)[2][2][4][2], const pg8::Unit& u, int wr, int wc, int fr, int fq, LAS unsigned char* lds, int wid, int lane) const {
        LAS float* red = (LAS float*)lds;
        const int row0 = u.pm * 256 + wr * 64 + fr, col0 = u.pn * 256 + wc * 32 + 8 * fq;
        float sc[2][4];
#pragma unroll
        for (int ai = 0; ai < 2; ++ai)
#pragma unroll
            for (int m = 0; m < 4; ++m) {
                sc[ai][m] = row_rscale(ssq, row0 + ai * 128 + m * 16);
                float v = -INFINITY;
#pragma unroll
                for (int bj = 0; bj < 2; ++bj)
#pragma unroll
                    for (int n = 0; n < 2; ++n)
#pragma unroll
                        for (int j = 0; j < 4; ++j) v = fmaxf(v, acc[ai][bj][m][n][j] * sc[ai][m]);
                v = fmaxf(v, __shfl_xor(v, 16)); v = fmaxf(v, __shfl_xor(v, 32));
                if (fq == 0) red[wc * 256 + ai * 128 + wr * 64 + m * 16 + fr] = v;
            }
        __syncthreads();
        float rsum[2][4], rmax[2][4];
#pragma unroll
        for (int ai = 0; ai < 2; ++ai)
#pragma unroll
            for (int m = 0; m < 4; ++m) {
                const int rl = ai * 128 + wr * 64 + m * 16 + fr;
                rmax[ai][m] = fmaxf(fmaxf(red[rl], red[256 + rl]), fmaxf(red[512 + rl], red[768 + rl]));
                float s = 0.f;
#pragma unroll
                for (int bj = 0; bj < 2; ++bj)
#pragma unroll
                    for (int n = 0; n < 2; ++n)
#pragma unroll
                        for (int j = 0; j < 4; ++j) s += __expf(acc[ai][bj][m][n][j] * sc[ai][m] - rmax[ai][m]);
                s += __shfl_xor(s, 16); s += __shfl_xor(s, 32);
                if (fq == 0) red[1024 + wc * 256 + rl] = s;
            }
        __syncthreads();
#pragma unroll
        for (int ai = 0; ai < 2; ++ai)
#pragma unroll
            for (int m = 0; m < 4; ++m) {
                const int rl = ai * 128 + wr * 64 + m * 16 + fr;
                const float inv = 1.f / ((red[1024 + rl] + red[1280 + rl]) + (red[1536 + rl] + red[1792 + rl]));
                rsum[ai][m] = inv;
                bf16_t* rowp = O + (size_t)(row0 + ai * 128 + m * 16) * D + col0;
#pragma unroll
                for (int bj = 0; bj < 2; ++bj) {
                    float e[2][4];
#pragma unroll
                    for (int n = 0; n < 2; ++n)
#pragma unroll
                        for (int j = 0; j < 4; ++j) e[n][j] = __expf(acc[ai][bj][m][n][j] * sc[ai][m] - rmax[ai][m]) * inv;
                    u32x4 w; w.x = pk2(e[0][0], e[0][1]); w.y = pk2(e[0][2], e[0][3]); w.z = pk2(e[1][0], e[1][1]); w.w = pk2(e[1][2], e[1][3]);
                    *(u32x4*)(rowp + bj * 128) = w;
                }
            }
        __syncthreads();
    }
};

__device__ __forceinline__ void p0_transpose_item(const float* W, int ldw, int col0, int K, bf16_t* WT, int row0, const float* g, LAS float* scr, int item, int nblk, int lane) {
    const int kb = item / nblk, nb = item % nblk, k0 = 64 * kb, n0 = 32 * nb;
    float tv[32];
#pragma unroll
    for (int i = 0; i < 32; ++i) tv[i] = W[(size_t)(k0 + 2 * i + (lane >> 5)) * ldw + col0 + n0 + (lane & 31)];
#pragma unroll
    for (int i = 0; i < 32; ++i) {
        const int kk = 2 * i + (lane >> 5);
        float v = tv[i];
        if (g) v *= g[k0 + kk];
        scr[kk * 33 + (lane & 31)] = v;
    }
    LDS_FENCE();
    const int c = lane & 7;
#pragma unroll
    for (int j = 0; j < 4; ++j) {
        const int n = (lane >> 3) + 8 * j; const LAS float* s = scr + (8 * c) * 33 + n;
        u32x4 o; o.x = pk2(s[0 * 33], s[1 * 33]); o.y = pk2(s[2 * 33], s[3 * 33]); o.z = pk2(s[4 * 33], s[5 * 33]); o.w = pk2(s[6 * 33], s[7 * 33]);
        *(u32x4*)(WT + (size_t)(row0 + n0 + n) * K + k0 + 8 * c) = o;
    }
    LDS_FENCE();
}
__device__ __forceinline__ void rms_row_load(const float* xrow, int lane, f32x4 (&v)[4]) {
    const f32x4* xr = (const f32x4*)xrow + lane;
#pragma unroll
    for (int j = 0; j < 4; ++j) v[j] = xr[64 * j];
}
__device__ __forceinline__ void rms_row_finish(const float* g, bf16_t* orow, int lane, f32x4 (&v)[4]) {
    float s = 0.f;
#pragma unroll
    for (int j = 0; j < 4; ++j) s += (v[j][0] * v[j][0] + v[j][1] * v[j][1]) + (v[j][2] * v[j][2] + v[j][3] * v[j][3]);
    const float r = rsqrtf(wave_sum(s) * (1.f / D) + EPS);
    unsigned long long* o8 = (unsigned long long*)orow + lane;
#pragma unroll
    for (int j = 0; j < 4; ++j) {
        const f32x4 gv = ((const f32x4*)g)[lane + 64 * j];
        v[j] = v[j] * r * gv;
        o8[64 * j] = (unsigned long long)pk2(v[j][0], v[j][1]) | ((unsigned long long)pk2(v[j][2], v[j][3]) << 32);
    }
}
__device__ __forceinline__ void p0_late_transposes(const Args& a, LAS unsigned char* lds) {
    const int tid = threadIdx.x, lane = tid & 63, wave = tid >> 6;
    if (wave < 5) return;
    const int G = gridDim.x, gw = blockIdx.x * 3 + (wave - 5), NGW = G * 3;
    unsigned char* ws = a.ws;
    LAS float* scr = (LAS float*)(lds + wave * 8704);
    constexpr int I_SQ = 16 * 32, I_HD = 4 * 32;
    constexpr int NITEMS = I_SQ + 4 * I_HD;
    for (int it = gw; it < NITEMS; it += NGW) {
        int r = it;
        if (r < I_SQ) { p0_transpose_item(a.in[I_WOUT], D, 0, D, (bf16_t*)(ws + WS_WOUT), 0, nullptr, scr, r, 32, lane); continue; } r -= I_SQ;
        { const int h = r / I_HD; p0_transpose_item(a.in[I_WXO] + (size_t)h * 256 * D, D, 0, 256, (bf16_t*)(ws + WS_WXO) + (size_t)h * 1024 * 256, 0, nullptr, scr, r % I_HD, 32, lane); }
    }
    {
        const float* wp = a.in[I_WPQ]; const float* gf = a.in[I_GFFN];
        bf16_t* wgr = (bf16_t*)(ws + WS_WGR);
        for (int i = (blockIdx.x * 3 + (wave - 5)) * 64 + lane; i < 1024 * 256; i += G * 3 * 64) {
            const int k = i >> 8, c8 = (i & 255) * 8;
            const float gk = gf[k];
            const f32x4 v0 = *(const f32x4*)(wp + (size_t)k * 2048 + c8) * gk, v1 = *(const f32x4*)(wp + (size_t)k * 2048 + c8 + 4) * gk;
            u32x4 w; w.x = pk2(v0[0], v0[1]); w.y = pk2(v0[2], v0[3]); w.z = pk2(v1[0], v1[1]); w.w = pk2(v1[2], v1[3]);
            *(u32x4*)(wgr + (size_t)k * 2048 + c8) = w;
        }
    }
    const float* wq = a.in[I_WXQ]; const float* gc = a.in[I_GCROSS];
    bf16_t* wqr = (bf16_t*)(ws + WS_WXQ);
    for (int i = (blockIdx.x * 3 + (wave - 5)) * 64 + lane; i < 1024 * 128; i += G * 3 * 64) {
        const int k = i >> 7, c8 = (i & 127) * 8, h = c8 >> 8, dh = c8 & 255;
        const float gk = gc[k] * 0.0625f;
        const f32x4 v0 = *(const f32x4*)(wq + (size_t)k * D + c8) * gk, v1 = *(const f32x4*)(wq + (size_t)k * D + c8 + 4) * gk;
        u32x4 w; w.x = pk2(v0[0], v0[1]); w.y = pk2(v0[2], v0[3]); w.z = pk2(v1[0], v1[1]); w.w = pk2(v1[2], v1[3]);
        *(u32x4*)(wqr + ((size_t)h * 1024 + k) * 256 + dh) = w;
    }
}
__device__ __forceinline__ void p0_experts(const Args& a, int part, int npart) {
    const int tid = threadIdx.x, lane = tid & 63, wave = tid >> 6;
    const int gw = part * NWAVES + wave, NGW = npart * NWAVES;
    unsigned char* ws = a.ws;
    {
        const float* gf = a.in[I_GFFN];
        float* esc = (float*)(ws + WS_ESC);
        f32x4 gv[4];
#pragma unroll
        for (int j = 0; j < 4; ++j) gv[j] = *(const f32x4*)(gf + 4 * lane + 256 * j);
        for (int r0 = 4 * gw; r0 < 2 * 16384; r0 += 4 * NGW) {
            f32x4 v[4][4];
#pragma unroll
            for (int q = 0; q < 4; ++q) {
                const int r = r0 + q; const bool up = r >= 16384; const int e = up ? r - 16384 : r;
                const float* src = (up ? a.in[I_EUP] : a.in[I_EDOWN]) + (size_t)e * D + 4 * lane;
#pragma unroll
                for (int j = 0; j < 4; ++j) v[q][j] = __builtin_nontemporal_load((const f32x4*)(src + 256 * j));
            }
#pragma unroll
            for (int q = 0; q < 4; ++q) {
                const int r = r0 + q; const bool up = r >= 16384; const int e = up ? r - 16384 : r;
                float am = 0.f;
#pragma unroll
                for (int j = 0; j < 4; ++j) { if (!up) v[q][j] = v[q][j] * gv[j];
                    am = fmaxf(am, fmaxf(fmaxf(fabsf(v[q][j][0]), fabsf(v[q][j][1])), fmaxf(fabsf(v[q][j][2]), fabsf(v[q][j][3])))); }
                am = row16_max_f32(am); am = fmaxf(am, __shfl_xor(am, 16)); am = fmaxf(am, __shfl_xor(am, 32));
                const float sc = am > 0.f ? am * (up ? (1.f / 224.f) : (1.f / 127.f)) : 1.f, inv = 1.f / sc;
                unsigned char* dstp = ws + (up ? WS_EU : WS_ED) + (size_t)(lane >> 5) * (16384 * 128) + (size_t)e * 128 + 4 * (lane & 31);
                const size_t jstep = (size_t)2 * 16384 * 128;
#pragma unroll
                for (int j = 0; j < 4; ++j) {
                    unsigned w;
                    if (up) { int t = 0; t = __builtin_amdgcn_cvt_pk_fp8_f32(v[q][j][0] * inv, v[q][j][1] * inv, t, false); t = __builtin_amdgcn_cvt_pk_fp8_f32(v[q][j][2] * inv, v[q][j][3] * inv, t, true); w = (unsigned)t; }
                    else { const int q0 = (int)rintf(v[q][j][0] * inv), q1 = (int)rintf(v[q][j][1] * inv), q2 = (int)rintf(v[q][j][2] * inv), q3 = (int)rintf(v[q][j][3] * inv);
                           w = (unsigned)(q0 & 255) | ((unsigned)(q1 & 255) << 8) | ((unsigned)(q2 & 255) << 16) | ((unsigned)q3 << 24); }
                    *(unsigned*)(dstp + jstep * j) = w;
                }
                if (lane == 0) esc[r] = sc;
            }
        }
    }
}
__device__ __forceinline__ void phase0(const Args& a, LAS unsigned char* lds) {
    const int tid = threadIdx.x, lane = tid & 63, wave = tid >> 6;
    const int G = gridDim.x, gw = blockIdx.x * NWAVES + wave, NGW = G * NWAVES;
    unsigned char* ws = a.ws;
    LAS float* scr = (LAS float*)(lds + wave * 8704);
    {
        constexpr int I_W1 = 16 * 48, I_W2 = 16 * 24, I_SQ = 16 * 32;
        constexpr int NITEMS = I_W1 + I_W2 + 2 * I_SQ;
        for (int it = gw; it < NITEMS; it += NGW) {
            int r = it;
            if (r < I_W1) { p0_transpose_item(a.in[I_WIN], 2312, 0, D, (bf16_t*)(ws + WS_WIN), 0, nullptr, scr, r, 48, lane); continue; } r -= I_W1;
            if (r < I_W2) { p0_transpose_item(a.in[I_WIN], 2312, 1544, D, (bf16_t*)(ws + WS_WIN), 1536, nullptr, scr, r, 24, lane); continue; } r -= I_W2;
            if (r < I_SQ) { p0_transpose_item(a.in[I_WXK], D, 0, D, (bf16_t*)(ws + WS_WXKV), 0, nullptr, scr, r, 32, lane); continue; } r -= I_SQ;
            p0_transpose_item(a.in[I_WXV], D, 0, D, (bf16_t*)(ws + WS_WXKV), 1024, nullptr, scr, r, 32, lane);
        }
    }
    {
        const size_t T = (size_t)G * NTHREADS, gt = (size_t)blockIdx.x * NTHREADS + tid;
        for (size_t i = gt; i < 2 * 16384 / 8; i += T) {
            const bool s2 = i >= 2048; const size_t j = s2 ? i - 2048 : i;
            const float* src = (s2 ? a.in[I_SK2] : a.in[I_SK1]) + j * 8;
            const f32x4 v0 = *(const f32x4*)src, v1 = *(const f32x4*)(src + 4);
            u32x4 w; w.x = pk2(v0[0], v0[1]); w.y = pk2(v0[2], v0[3]); w.z = pk2(v1[0], v1[1]); w.w = pk2(v1[2], v1[3]);
            *(u32x4*)((bf16_t*)(ws + WS_SK) + (s2 ? 16384 : 0) + j * 8) = w;
        }
    }
    {
        const float* win = a.in[I_WIN];
        float* gates = (float*)(ws + WS_GATES);
        const float* bi = a.in[I_BI]; const float* bfg = a.in[I_BF];
        LAS f32x4* wg = (LAS f32x4*)(lds + 8 * 8704);
        __syncthreads();
        for (int i = tid; i < 2048; i += NTHREADS) {
            const int ln = i & 63, e = (i >> 6) & 3, j = (i >> 8) & 3, half = i >> 10;
            wg[i] = *(const f32x4*)(win + (size_t)(4 * ln + 256 * j + e) * 2312 + 1536 + 4 * half);
        }
        __syncthreads();
        for (int rowp = 2 * gw; rowp < MTOK; rowp += 2 * NGW) {
          f32x4 vv[2][4];
          rms_row_load(a.in[I_X] + (size_t)rowp * D, lane, vv[0]); rms_row_load(a.in[I_X] + (size_t)(rowp + 1) * D, lane, vv[1]);
#pragma unroll
          for (int q = 0; q < 2; ++q) {
            const int row = rowp + q;
            f32x4 (&v)[4] = vv[q];
            rms_row_finish(a.in[I_GMIX], (bf16_t*)(ws + WS_B) + (size_t)row * D, lane, v);
            f32x4 g0 = {0.f, 0.f, 0.f, 0.f}, g1 = {0.f, 0.f, 0.f, 0.f};
#pragma unroll
            for (int j = 0; j < 4; ++j)
#pragma unroll
                for (int e = 0; e < 4; ++e) { const float xv = v[j][e]; g0 += xv * wg[(j * 4 + e) * 64 + lane]; g1 += xv * wg[1024 + (j * 4 + e) * 64 + lane]; }
            const bool b5 = lane & 32, b4 = lane & 16, b3 = lane & 8;
            f32x4 k4, s4;
#pragma unroll
            for (int i = 0; i < 4; ++i) { k4[i] = b5 ? g1[i] : g0[i]; s4[i] = b5 ? g0[i] : g1[i]; }
#pragma unroll
            for (int i = 0; i < 4; ++i) k4[i] += __shfl_xor(s4[i], 32);
            float k2a = b4 ? k4[2] : k4[0], k2b = b4 ? k4[3] : k4[1];
            k2a += __shfl_xor(b4 ? k4[0] : k4[2], 16); k2b += __shfl_xor(b4 ? k4[1] : k4[3], 16);
            float k1 = (b3 ? k2b : k2a) + __shfl_xor(b3 ? k2a : k2b, 8);
            k1 += __uint_as_float(dppu(__float_as_uint(k1), 0)); k1 += __uint_as_float(dppu(__float_as_uint(k1), 1)); k1 += __uint_as_float(dppu(__float_as_uint(k1), 2));
            if ((lane & 7) == 0) {
                const int c = lane >> 3;
                float val = k1;
                if (c < 4) val += bi[c];
                else { const float f = val + bfg[c - 4]; val = fminf(f, 0.f) - log1pf(__expf(-fabsf(f))); }
                gates[(size_t)row * 8 + c] = val;
            }
          }
        }
    }
    for (int row = gw; row < NB * MEMLEN; row += NGW) {
        f32x4 v[4];
        rms_row_load(a.in[I_MEM] + (size_t)row * D, lane, v);
        rms_row_finish(a.in[I_GMEM], (bf16_t*)(ws + WS_C) + (size_t)row * D, lane, v);
    }
}

constexpr int LQ = 72;
__device__ __forceinline__ void conv8_load(const bf16_t* src, int tok_in_seq, u32x4 (&xv)[4]) {
#pragma unroll
    for (int j = 0; j < 4; ++j) { const int d = (tok_in_seq - 3 + j >= 0) ? j - 3 : 0; xv[j] = *(const u32x4*)(src + (ptrdiff_t)d * NPROJ); }
}
__device__ __forceinline__ void conv8_finish(const u32x4 (&xv)[4], int tok_in_seq, const float* cw, const float* cb, int ch, float (&y)[8]) {
#pragma unroll
    for (int e = 0; e < 8; ++e) y[e] = cb[ch + e];
#pragma unroll
    for (int j = 0; j < 4; ++j) {
        const float m = (tok_in_seq - 3 + j >= 0) ? 1.f : 0.f;
        const f32x4 w0 = *(const f32x4*)(cw + j * 512 + ch) * m, w1 = *(const f32x4*)(cw + j * 512 + ch + 4) * m;
        y[0] += w0[0] * bflo(xv[j].x); y[1] += w0[1] * bfhi(xv[j].x); y[2] += w0[2] * bflo(xv[j].y); y[3] += w0[3] * bfhi(xv[j].y);
        y[4] += w1[0] * bflo(xv[j].z); y[5] += w1[1] * bfhi(xv[j].z); y[6] += w1[2] * bflo(xv[j].w); y[7] += w1[3] * bfhi(xv[j].w);
    }
#pragma unroll
    for (int e = 0; e < 8; ++e) y[e] = y[e] * sigmoidf_(y[e]);
}
__device__ __forceinline__ void conv8(const bf16_t* src, int tok_in_seq, const float* cw, const float* cb, int ch, float (&y)[8]) {
    u32x4 xv[4]; conv8_load(src, tok_in_seq, xv); conv8_finish(xv, tok_in_seq, cw, cb, ch, y);
}
__device__ __forceinline__ float chunk_cumsum(float lf, int lane) {
    float b = lf;
#pragma unroll
    for (int o = 1; o < 64; o <<= 1) { const float t = __shfl_up(b, o); if (lane >= o) b += t; }
    return b;
}

__device__ __forceinline__ void mlstm_local(const Args& a, LAS unsigned char* lds, int task) {
    const int tid = threadIdx.x, lane = tid & 63, wave = tid >> 6;
    const int b = task >> 9, h = (task >> 7) & 3, c = task & 127;
    const int row0 = b * SEQ + c * 64;
    const bf16_t* proj = (const bf16_t*)(a.ws + WS_A);
    const float* gates = (const float*)(a.ws + WS_GATES);
    LAS bf16_t* VTw = (LAS bf16_t*)lds;
    LAS bf16_t* KT = (LAS bf16_t*)(lds + 144 * LQ * 2);
    LAS float* wS = (LAS float*)(lds + 144 * LQ * 2 + 64 * LQ * 2);
    if (wave == 0) {
        const float ig = gates[(size_t)(row0 + lane) * 8 + h], lf = gates[(size_t)(row0 + lane) * 8 + 4 + h];
        const float bs = chunk_cumsum(lf, lane);
        const float bL = __shfl(bs, 63);
        wS[lane] = __expf(bL - bs + ig);
        if (lane == 63) ((float*)(a.ws + WS_DECAY))[task] = __expf(bL);
    }
    {
        const int s = tid >> 3, cg = (tid & 7) * 8;
        float y[8];
        conv8(proj + (size_t)(row0 + s) * NPROJ + C_MK + h * 64 + cg, c * 64 + s, a.in[I_CONVW], a.in[I_CONVB], 256 + h * 64 + cg, y);
#pragma unroll
        for (int e = 0; e < 8; ++e) KT[(cg + e) * LQ + s] = f2bf(y[e]);
    }
    __syncthreads();
    {
        const int s = tid >> 3, vg = (tid & 7) * 16;
        const float w = wS[s];
        const u32x4 x0 = *(const u32x4*)(proj + (size_t)(row0 + s) * NPROJ + C_MV + h * 128 + vg), x1 = *(const u32x4*)(proj + (size_t)(row0 + s) * NPROJ + C_MV + h * 128 + vg + 8);
        const unsigned xs[8] = {x0.x, x0.y, x0.z, x0.w, x1.x, x1.y, x1.z, x1.w};
#pragma unroll
        for (int e = 0; e < 8; ++e) { VTw[(vg + 2 * e) * LQ + s] = f2bf(w * bflo(xs[e])); VTw[(vg + 2 * e + 1) * LQ + s] = f2bf(w * bfhi(xs[e])); }
        if ((tid & 7) == 0) VTw[128 * LQ + s] = f2bf(w);
        for (int i = tid; i < 15 * 64; i += NTHREADS) VTw[(129 + (i >> 6)) * LQ + (i & 63)] = 0;
    }
    __syncthreads();
    float* dC = (float*)(a.ws + WS_B) + (size_t)task * 8192;
    float* dn = (float*)(a.ws + WS_DN) + (size_t)task * 64;
    for (int T = wave; T < 36; T += 8) {
        const int mt = T >> 2, nt = T & 3;
        f32x4 acc = {0.f, 0.f, 0.f, 0.f};
#pragma unroll
        for (int ks = 0; ks < 2; ++ks) {
            const bf16x8 av = *(const LAS bf16x8*)(VTw + (mt * 16 + (lane & 15)) * LQ + ks * 32 + 8 * (lane >> 4));
            const bf16x8 bv = *(const LAS bf16x8*)(KT + (nt * 16 + (lane & 15)) * LQ + ks * 32 + 8 * (lane >> 4));
            acc = mfma16(av, bv, acc);
        }
        const int col = nt * 16 + (lane & 15);
        if (mt < 8) {
#pragma unroll
            for (int r = 0; r < 4; ++r) dC[(mt * 16 + (lane >> 4) * 4 + r) * 64 + col] = acc[r];
        } else if ((lane >> 4) == 0) dn[col] = acc[0];
    }
    __syncthreads();
}

__device__ __forceinline__ void mlstm_scan(const Args& a) {
    const size_t T = (size_t)gridDim.x * NTHREADS;
    const float* decay = (const float*)(a.ws + WS_DECAY);
    for (size_t chain = ((size_t)(threadIdx.x >> 6) * gridDim.x + blockIdx.x) * 64 + (threadIdx.x & 63); chain < 8 * 8256; chain += T) {
        const int bh = (int)(chain / 8256), e = (int)(chain % 8256);
        float* p; size_t stride; bf16_t* pst = nullptr;
        if (e < 8192) { p = (float*)(a.ws + WS_B) + (size_t)bh * 128 * 8192 + e; stride = 8192; pst = (bf16_t*)(a.ws + WS_ST) + (size_t)bh * 128 * 8192 + e; }
        else { p = (float*)(a.ws + WS_DN) + (size_t)bh * 128 * 64 + (e - 8192); stride = 64; }
        float C = 0.f;
        for (int c0 = 0; c0 < 128; c0 += 32) {
            float t[32], dk[32];
#pragma unroll
            for (int j = 0; j < 32; ++j) { t[j] = p[(size_t)(c0 + j) * stride]; dk[j] = decay[bh * 128 + c0 + j]; }
#pragma unroll
            for (int j = 0; j < 32; ++j) {
                if (pst) pst[(size_t)(c0 + j) * 8192] = f2bf(C); else p[(size_t)(c0 + j) * stride] = C;
                C = dk[j] * C + t[j];
            }
        }
    }
}

__device__ __forceinline__ void mlstm_out(const Args& a, LAS unsigned char* lds, int task) {
    const int tid = threadIdx.x, lane = tid & 63, wave = tid >> 6;
    const int b = task >> 9, h = (task >> 7) & 3, c = task & 127;
    const int row0 = b * SEQ + c * 64;
    const bf16_t* proj = (const bf16_t*)(a.ws + WS_A);
    const float* gates = (const float*)(a.ws + WS_GATES);
    LAS bf16_t* Qs = (LAS bf16_t*)lds;
    LAS bf16_t* Ks = Qs + 64 * LQ;
    LAS bf16_t* Qp = Ks + 64 * LQ;
    LAS bf16_t* Ps = Qp + 64 * LQ;
    LAS bf16_t* VT = Ps + 64 * LQ;
    LAS bf16_t* Cs = VT + 144 * LQ;
    LAS float* bS = (LAS float*)(Cs + 144 * LQ);
    LAS float* iS = bS + 64;
    LAS float* denS = iS + 64;
    LAS float* ssqS = denS + 64;
    const float ig_l = gates[(size_t)(row0 + lane) * 8 + h], lf_l = gates[(size_t)(row0 + lane) * 8 + 4 + h];
    const float b_l = chunk_cumsum(lf_l, lane);
    if (wave == 0) { bS[lane] = b_l; iS[lane] = ig_l; }
    const float eb_s = __expf(__shfl(b_l, tid >> 3));
    u32x4 qtap[4];
    conv8_load(proj + (size_t)(row0 + (tid >> 3)) * NPROJ + C_MQ + h * 64 + (tid & 7) * 8, c * 64 + (tid >> 3), qtap);
    bf16_t mo_pre[4][4];
#pragma unroll
    for (int r = 0; r < 4; ++r)
#pragma unroll
        for (int i = 0; i < 4; ++i)
            mo_pre[r][i] = proj[(size_t)(row0 + (wave & 3) * 16 + (lane >> 4) * 4 + r) * NPROJ + C_MO + h * 128 + ((wave >> 2) * 4 + i) * 16 + (lane & 15)];
    {
        const int s = tid >> 3, cg = (tid & 7) * 8;
        float y[8];
        conv8(proj + (size_t)(row0 + s) * NPROJ + C_MK + h * 64 + cg, c * 64 + s, a.in[I_CONVW], a.in[I_CONVB], 256 + h * 64 + cg, y);
        u32x4 w; w.x = pk2(y[0], y[1]); w.y = pk2(y[2], y[3]); w.z = pk2(y[4], y[5]); w.w = pk2(y[6], y[7]);
        *(LAS u32x4*)(Ks + s * LQ + cg) = w;
        const int vg = (tid & 7) * 16;
        const u32x4 x0 = *(const u32x4*)(proj + (size_t)(row0 + s) * NPROJ + C_MV + h * 128 + vg), x1 = *(const u32x4*)(proj + (size_t)(row0 + s) * NPROJ + C_MV + h * 128 + vg + 8);
        const unsigned xs[8] = {x0.x, x0.y, x0.z, x0.w, x1.x, x1.y, x1.z, x1.w};
#pragma unroll
        for (int e = 0; e < 8; ++e) { VT[(vg + 2 * e) * LQ + s] = (bf16_t)(xs[e] & 0xffffu); VT[(vg + 2 * e + 1) * LQ + s] = (bf16_t)(xs[e] >> 16); }
        if ((tid & 7) == 0) VT[128 * LQ + s] = 0x3F80;
        for (int i = tid; i < 15 * 64; i += NTHREADS) { VT[(129 + (i >> 6)) * LQ + (i & 63)] = 0; Cs[(129 + (i >> 6)) * LQ + (i & 63)] = 0; }
        const bf16_t* st = (const bf16_t*)(a.ws + WS_ST) + (size_t)task * 8192;
        const int v = tid >> 2, k0 = (tid & 3) * 16;
        *(LAS u32x4*)(Cs + v * LQ + k0) = *(const u32x4*)(st + v * 64 + k0);
        *(LAS u32x4*)(Cs + v * LQ + k0 + 8) = *(const u32x4*)(st + v * 64 + k0 + 8);
        if (tid < 64) Cs[128 * LQ + tid] = f2bf(((const float*)(a.ws + WS_DN))[(size_t)task * 64 + tid]);
    }
    {
        const int s = tid >> 3, cg = (tid & 7) * 8;
        float y[8];
        conv8_finish(qtap, c * 64 + s, a.in[I_CONVW], a.in[I_CONVB], h * 64 + cg, y);
        const float eb = eb_s;
#pragma unroll
        for (int e = 0; e < 8; ++e) y[e] *= 0.125f;
        u32x4 w; w.x = pk2(y[0], y[1]); w.y = pk2(y[2], y[3]); w.z = pk2(y[4], y[5]); w.w = pk2(y[6], y[7]);
        *(LAS u32x4*)(Qs + s * LQ + cg) = w;
        w.x = pk2(y[0] * eb, y[1] * eb); w.y = pk2(y[2] * eb, y[3] * eb); w.z = pk2(y[4] * eb, y[5] * eb); w.w = pk2(y[6] * eb, y[7] * eb);
        *(LAS u32x4*)(Qp + s * LQ + cg) = w;
    }
    __syncthreads();
    {
        const int mt = wave >> 1;
#pragma unroll
        for (int i = 0; i < 2; ++i) {
            const int nt = (wave & 1) * 2 + i;
            f32x4 acc = {0.f, 0.f, 0.f, 0.f};
#pragma unroll
            for (int ks = 0; ks < 2; ++ks) {
                const bf16x8 av = *(const LAS bf16x8*)(Qs + (mt * 16 + (lane & 15)) * LQ + ks * 32 + 8 * (lane >> 4));
                const bf16x8 bv = *(const LAS bf16x8*)(Ks + (nt * 16 + (lane & 15)) * LQ + ks * 32 + 8 * (lane >> 4));
                acc = mfma16(av, bv, acc);
            }
            const int s = nt * 16 + (lane & 15);
            const float bs = bS[s], is = iS[s];
#pragma unroll
            for (int r = 0; r < 4; ++r) {
                const int t = mt * 16 + (lane >> 4) * 4 + r;
                const float p = (s <= t) ? acc[r] * __expf(bS[t] - bs + is) : 0.f;
                Ps[t * LQ + s] = f2bf(p);
            }
        }
    }
    __syncthreads();
    const int mt = wave & 3, ng = wave >> 2;
    f32x4 acc[5];
#pragma unroll
    for (int i = 0; i < 5; ++i) acc[i] = (f32x4){0.f, 0.f, 0.f, 0.f};
#pragma unroll
    for (int ks = 0; ks < 4; ++ks) {
        const LAS bf16_t* Ab = (ks < 2) ? Ps : Qp; const LAS bf16_t* Bb = (ks < 2) ? VT : Cs;
        const int ko = (ks & 1) * 32 + 8 * (lane >> 4);
        const bf16x8 av = *(const LAS bf16x8*)(Ab + (mt * 16 + (lane & 15)) * LQ + ko);
#pragma unroll
        for (int i = 0; i < 4; ++i) {
            const bf16x8 bv = *(const LAS bf16x8*)(Bb + ((ng * 4 + i) * 16 + (lane & 15)) * LQ + ko);
            acc[i] = mfma16(av, bv, acc[i]);
        }
        {
            const bf16x8 bv = *(const LAS bf16x8*)(Bb + (128 + (lane & 15)) * LQ + ko);
            acc[4] = mfma16(av, bv, acc[4]);
        }
    }
    float rinv[4];
#pragma unroll
    for (int r = 0; r < 4; ++r) {
        const float den = __uint_as_float((unsigned)__builtin_amdgcn_ds_bpermute((lane & 48) * 4, (int)__float_as_uint(acc[4][r])));
        rinv[r] = 1.f / fmaxf(fabsf(den), 1.f);
        float ss = 0.f;
#pragma unroll
        for (int i = 0; i < 4; ++i) { acc[i][r] *= rinv[r]; ss += acc[i][r] * acc[i][r]; }
        ss = row16_sum_f32(ss);
        if ((lane & 15) == 0) ssqS[ng * 64 + mt * 16 + (lane >> 4) * 4 + r] = ss;
    }
    __syncthreads();
    bf16_t* mix = (bf16_t*)(a.ws + WS_C);
    const float* gmh = a.in[I_GMHEAD];
#pragma unroll
    for (int r = 0; r < 4; ++r) {
        const int t = mt * 16 + (lane >> 4) * 4 + r;
        const float rn = rsqrtf((ssqS[t] + ssqS[64 + t]) * (1.f / 128.f) + EPS);
#pragma unroll
        for (int i = 0; i < 4; ++i) {
            const int v = (ng * 4 + i) * 16 + (lane & 15);
            const float mo = bf2f(mo_pre[r][i]);
            mix[(size_t)(row0 + t) * D + h * 128 + v] = f2bf(acc[i][r] * rn * gmh[h * 128 + v] * sigmoidf_(mo));
        }
    }
    __syncthreads();
}

constexpr int LV = 264;
__device__ __forceinline__ void swa_task(const Args& a, LAS unsigned char* lds, int task) {
    const int tid = threadIdx.x, lane = tid & 63, wave = tid >> 6;
    const int b = task >> 7, kvh = (task >> 6) & 1, blk = task & 63, qh = kvh * 4 + (wave >> 1);
    const int rowq0 = b * SEQ + blk * 128;
    const bf16_t* proj = (const bf16_t*)(a.ws + WS_A);
    LAS bf16_t* Ksm = (LAS bf16_t*)lds;
    LAS bf16_t* VTs = Ksm + 256 * LQ;
    {
        const int j = tid >> 1, half = tid & 1;
        const bool ex = (blk > 0) || (j >= 128);
        u32x4 kv[4], vv[4];
#pragma unroll
        for (int i = 0; i < 4; ++i) { kv[i] = (u32x4){0u, 0u, 0u, 0u}; vv[i] = (u32x4){0u, 0u, 0u, 0u}; }
        if (ex) {
            const bf16_t* kp = proj + (size_t)(rowq0 - 128 + j) * NPROJ + C_AK + kvh * 64 + half * 32;
            const bf16_t* vp = proj + (size_t)(rowq0 - 128 + j) * NPROJ + C_AV + kvh * 64 + half * 32;
#pragma unroll
            for (int i = 0; i < 4; ++i) { kv[i] = *(const u32x4*)(kp + 8 * i); vv[i] = *(const u32x4*)(vp + 8 * i); }
        }
#pragma unroll
        for (int i = 0; i < 4; ++i) {
            *(LAS u32x4*)(Ksm + j * LQ + half * 32 + 8 * i) = kv[i];
            const unsigned xs[4] = {vv[i].x, vv[i].y, vv[i].z, vv[i].w};
#pragma unroll
            for (int e = 0; e < 4; ++e) { VTs[(half * 32 + 8 * i + 2 * e) * LV + j] = (bf16_t)(xs[e] & 0xffffu); VTs[(half * 32 + 8 * i + 2 * e + 1) * LV + j] = (bf16_t)(xs[e] >> 16); }
        }
    }
    __syncthreads();
#pragma unroll 1
    for (int qk = 0; qk < 4; ++qk) {
    const int qtile = (wave & 1) * 4 + qk;
    const int qi = 16 * qtile + (lane & 15);
    bf16x8 qf[2];
#pragma unroll
    for (int ks = 0; ks < 2; ++ks) qf[ks] = *(const bf16x8*)(proj + (size_t)(rowq0 + qi) * NPROJ + C_AQ + qh * 64 + ks * 32 + 8 * (lane >> 4));
    f32x4 sc[10];
    const float sink = a.in[I_SINKS][qh];
    float mx = sink;
#pragma unroll
    for (int t = 0; t < 9; ++t) {
        const int kt = qtile + t;
        f32x4 acc = {0.f, 0.f, 0.f, 0.f};
#pragma unroll
        for (int ks = 0; ks < 2; ++ks) {
            const bf16x8 kf = *(const LAS bf16x8*)(Ksm + (kt * 16 + (lane & 15)) * LQ + ks * 32 + 8 * (lane >> 4));
            acc = mfma16(kf, qf[ks], acc);
        }
#pragma unroll
        for (int r = 0; r < 4; ++r) {
            const int j = kt * 16 + (lane >> 4) * 4 + r;
            const bool valid = (j >= qi + 1) && (j <= qi + 128) && (blk > 0 || j >= 128);
            acc[r] = valid ? acc[r] * 0.125f : -INFINITY;
            mx = fmaxf(mx, acc[r]);
        }
        sc[t] = acc;
    }
    mx = fmaxf(mx, __shfl_xor(mx, 16)); mx = fmaxf(mx, __shfl_xor(mx, 32));
    float sum = 0.f;
#pragma unroll
    for (int t = 0; t < 9; ++t)
#pragma unroll
        for (int r = 0; r < 4; ++r) { const float p = __expf(sc[t][r] - mx); sc[t][r] = p; sum += p; }
    sum += __shfl_xor(sum, 16); sum += __shfl_xor(sum, 32);
    const float inv = 1.f / (sum + __expf(sink - mx));
    sc[9] = (f32x4){0.f, 0.f, 0.f, 0.f};
    bf16x8 pf[5];
#pragma unroll
    for (int p = 0; p < 5; ++p) {
        const f32x4 x0 = sc[2 * p] * inv, x1 = sc[2 * p + 1] * inv;
        u32x4 w; w.x = pk2(x0[0], x0[1]); w.y = pk2(x0[2], x0[3]); w.z = pk2(x1[0], x1[1]); w.w = pk2(x1[2], x1[3]);
        pf[p] = __builtin_bit_cast(bf16x8, w);
    }
    bf16_t* mix = (bf16_t*)(a.ws + WS_C);
#pragma unroll
    for (int dt = 0; dt < 4; ++dt) {
        f32x4 acc = {0.f, 0.f, 0.f, 0.f};
#pragma unroll
        for (int p = 0; p < 5; ++p) {
            const int k0 = qtile + 2 * p, k1 = (k0 + 1 > 15) ? 15 : k0 + 1;
            const LAS bf16_t* vr = VTs + (dt * 16 + (lane & 15)) * LV + 4 * (lane >> 4);
            const u32x2 lo = *(const LAS u32x2*)(vr + k0 * 16), hi = *(const LAS u32x2*)(vr + k1 * 16);
            const u32x4 w = {lo.x, lo.y, hi.x, hi.y};
            acc = mfma16(__builtin_bit_cast(bf16x8, w), pf[p], acc);
        }
        u32x2 o; o.x = pk2(acc[0], acc[1]); o.y = pk2(acc[2], acc[3]);
        *(u32x2*)(mix + (size_t)(rowq0 + qi) * D + 512 + qh * 64 + dt * 16 + 4 * (lane >> 4)) = o;
    }
    }
    __syncthreads();
}


#ifndef PEER_HQ_LO
#define PEER_HQ_LO 0
#endif
constexpr int LSK = 136;
__device__ __forceinline__ unsigned f2sort(float f) { const unsigned u = __float_as_uint(f); return u ^ ((unsigned)((int)u >> 31) | 0x80000000u); }
__device__ __forceinline__ float sort2f(unsigned s) { return __uint_as_float((s & 0x80000000u) ? (s ^ 0x80000000u) : ~s); }

#define CE_(i, j) { const unsigned hi_ = key[i][r] > key[j][r] ? key[i][r] : key[j][r], lo_ = key[i][r] > key[j][r] ? key[j][r] : key[i][r]; key[i][r] = hi_; key[j][r] = lo_; }
template <int NT>
__device__ __forceinline__ void top16(unsigned (&key)[NT][4], unsigned (&top)[4], int l15) {
    static_assert(NT == 8, "8 keys per lane");
#pragma unroll
    for (int r = 0; r < 4; ++r) {
        CE_(0, 1) CE_(2, 3) CE_(4, 5) CE_(6, 7)
        CE_(0, 2) CE_(1, 3) CE_(4, 6) CE_(5, 7)
        CE_(1, 2) CE_(5, 6)
        CE_(0, 4) CE_(1, 5) CE_(2, 6) CE_(3, 7)
        CE_(2, 4) CE_(3, 5)
        CE_(1, 2) CE_(3, 4) CE_(5, 6)
        top[r] = 0u;
    }
    for (int it = 0; it < 16; ++it) {
        unsigned m[4];
#pragma unroll
        for (int r = 0; r < 4; ++r) m[r] = key[0][r];
#pragma unroll
        for (int st = 0; st < 4; ++st)
#pragma unroll
            for (int r = 0; r < 4; ++r) { const unsigned y = dppu(m[r], st); m[r] = m[r] > y ? m[r] : y; }
        const bool rec = (l15 == it);
#pragma unroll
        for (int r = 0; r < 4; ++r) {
            top[r] = rec ? m[r] : top[r];
            const bool own = key[0][r] == m[r];
#pragma unroll
            for (int t = 0; t < 7; ++t) key[t][r] = own ? key[t + 1][r] : key[t][r];
            key[7][r] = own ? 0u : key[7][r];
        }
    }
}
#undef CE_
__device__ __forceinline__ float gelu_erf(float x) { return 0.5f * x * (1.f + erff(x * 0.70710678118654752f)); }

__device__ __forceinline__ void peer_hq_row(const Args& a, int row, int lane) {
    {
        const bf16_t* hrow = (const bf16_t*)(a.ws + WS_B) + (size_t)row * D + 16 * lane;
        const u32x4 hb0 = *(const u32x4*)hrow, hb1 = *(const u32x4*)(hrow + 8);
        f32x4 v[4]; float am = 0.f;
        v[0] = (f32x4){bflo(hb0.x), bfhi(hb0.x), bflo(hb0.y), bfhi(hb0.y)}; v[1] = (f32x4){bflo(hb0.z), bfhi(hb0.z), bflo(hb0.w), bfhi(hb0.w)};
        v[2] = (f32x4){bflo(hb1.x), bfhi(hb1.x), bflo(hb1.y), bfhi(hb1.y)}; v[3] = (f32x4){bflo(hb1.z), bfhi(hb1.z), bflo(hb1.w), bfhi(hb1.w)};
#pragma unroll
        for (int j = 0; j < 4; ++j) am = fmaxf(am, fmaxf(fmaxf(fabsf(v[j][0]), fabsf(v[j][1])), fmaxf(fabsf(v[j][2]), fabsf(v[j][3]))));
        am = fmaxf(am, __uint_as_float(dppu(__float_as_uint(am), 0))); am = fmaxf(am, __uint_as_float(dppu(__float_as_uint(am), 1))); am = fmaxf(am, __uint_as_float(dppu(__float_as_uint(am), 2)));
        const float s1 = am > 0.f ? am * (1.f / 127.f) : 1.f, i1 = 1.f / s1, i2 = 254.f * i1;
        u32x4 wh, wl;
#pragma unroll
        for (int j = 0; j < 4; ++j) {
            unsigned ph = 0, pl = 0;
#pragma unroll
            for (int e = 0; e < 4; ++e) {
                const float qh = rintf(v[j][e] * i1);
                const float ql = rintf((v[j][e] - qh * s1) * i2);
                ph |= ((unsigned)((int)qh & 255)) << (8 * e); pl |= ((unsigned)((int)ql & 255)) << (8 * e);
            }
            wh[j] = ph; wl[j] = pl;
        }
        *(u32x4*)(a.ws + WS_HQH + (size_t)row * D + 16 * lane) = wh;
        if (PEER_HQ_LO) *(u32x4*)(a.ws + WS_HQL + (size_t)row * D + 16 * lane) = wl;
        if ((lane & 7) == 0) ((float*)(a.ws + WS_HS))[(size_t)row * 8 + (lane >> 3)] = s1;
    }
}
__device__ __forceinline__ void peer_score_unit(const Args& a, LAS unsigned char* lds, int pm, int hsel) {
    const int tid = threadIdx.x, lane = tid & 63, wave = tid >> 6, l15 = lane & 15, lq = lane >> 4;
    const bf16_t* pq = (const bf16_t*)(a.ws + WS_A);
    LAS u32x2* SEL = (LAS u32x2*)lds;
    const int T0 = pm * 256;
    {
#pragma unroll 1
        for (int hh = 0; hh < 2; ++hh) {
            const int h = hsel, tt = wave + 8 * hh;
            unsigned tc[2][4];
#pragma unroll
            for (int c = 0; c < 2; ++c) {
                unsigned key[8][4];
#pragma unroll
                for (int r = 0; r < 4; ++r) {
                    const u32x4 sv = *(const u32x4*)(pq + (size_t)(T0 + tt * 16 + lq * 4 + r) * 2048 + h * 256 + c * 128 + 8 * l15);
                    const unsigned sw[4] = {sv.x, sv.y, sv.z, sv.w};
#pragma unroll
                    for (int j = 0; j < 4; ++j) {
                        key[2 * j][r] = (f2sort(bflo(sw[j])) & ~127u) | (unsigned)(8 * l15 + 2 * j);
                        key[2 * j + 1][r] = (f2sort(bfhi(sw[j])) & ~127u) | (unsigned)(8 * l15 + 2 * j + 1);
                    }
                }
                top16<8>(key, tc[c], l15);
            }
            const int gb = lane & 48;
            int ci[4], cj[4]; bool ok[4];
            ci[0] = 0; cj[0] = l15; ok[0] = true;
            ci[1] = l15; cj[1] = 0; ok[1] = l15 >= 1;
            ci[2] = l15 < 7 ? 1 : (l15 < 11 ? 2 : (l15 < 14 ? 3 : 4)); cj[2] = l15 < 7 ? l15 + 1 : (l15 < 11 ? l15 - 6 : (l15 < 14 ? l15 - 10 : l15 - 13)); ok[2] = true;
            ci[3] = l15 < 3 ? 5 + l15 : 0; cj[3] = 1; ok[3] = l15 < 3;
            unsigned ck[4][4]; int ce[4][4];
#pragma unroll
            for (int r = 0; r < 4; ++r) {
                const unsigned t1 = tc[0][r], t2 = tc[1][r];
                const float v1 = sort2f(t1 & ~127u), v2 = sort2f(t2 & ~127u);
                const int i1 = (int)(t1 & 127u), i2 = (int)(t2 & 127u);
#pragma unroll
                for (int sl = 0; sl < 4; ++sl) {
                    const float a1 = __uint_as_float((unsigned)__builtin_amdgcn_ds_bpermute((gb + ci[sl]) * 4, (int)__float_as_uint(v1)));
                    const float a2 = __uint_as_float((unsigned)__builtin_amdgcn_ds_bpermute((gb + cj[sl]) * 4, (int)__float_as_uint(v2)));
                    const int e1 = __builtin_amdgcn_ds_bpermute((gb + ci[sl]) * 4, i1);
                    const int e2 = __builtin_amdgcn_ds_bpermute((gb + cj[sl]) * 4, i2);
                    ce[sl][r] = e1 * 128 + e2;
                    ck[sl][r] = ok[sl] ? ((f2sort(a1 + a2) & ~63u) | (unsigned)(l15 * 4 + sl)) : 0u;
                }
#define CE4_(i, j) { const unsigned hi_ = ck[i][r] > ck[j][r] ? ck[i][r] : ck[j][r], lo_ = ck[i][r] > ck[j][r] ? ck[j][r] : ck[i][r]; ck[i][r] = hi_; ck[j][r] = lo_; }
                CE4_(0, 1) CE4_(2, 3) CE4_(0, 2) CE4_(1, 3) CE4_(1, 2)
#undef CE4_
            }
            unsigned topk[4] = {0u, 0u, 0u, 0u};
            for (int it = 0; it < 16; ++it) {
                unsigned m[4];
#pragma unroll
                for (int r = 0; r < 4; ++r) m[r] = ck[0][r];
#pragma unroll
                for (int st = 0; st < 4; ++st)
#pragma unroll
                    for (int r = 0; r < 4; ++r) { const unsigned y = dppu(m[r], st); m[r] = m[r] > y ? m[r] : y; }
                const bool rec = (l15 == it);
#pragma unroll
                for (int r = 0; r < 4; ++r) {
                    topk[r] = rec ? m[r] : topk[r];
                    const bool own = ck[0][r] == m[r];
                    ck[0][r] = own ? ck[1][r] : ck[0][r]; ck[1][r] = own ? ck[2][r] : ck[1][r]; ck[2][r] = own ? ck[3][r] : ck[2][r]; ck[3][r] = own ? 0u : ck[3][r];
                }
            }
#pragma unroll
            for (int r = 0; r < 4; ++r) {
                const int own = (int)((topk[r] >> 2) & 15u), slot = (int)(topk[r] & 3u);
                int eid = 0;
#pragma unroll
                for (int sl = 0; sl < 4; ++sl) { const int t = __builtin_amdgcn_ds_bpermute((gb + own) * 4, ce[sl][r]); eid = (slot == sl) ? t : eid; }
                const float ts = sort2f(topk[r] & ~63u);
                const float tmax = row16_max_f32(ts);
                const float p = __expf(ts - tmax);
                const float g = p / row16_sum_f32(p);
                { u32x2 o; o.x = (unsigned)eid; o.y = __float_as_uint(g); SEL[(tt * 16 + lq * 4 + r) * 16 + l15] = o; }
            }
        }
    }
    __syncthreads();
    {
        unsigned* sele = (unsigned*)(a.ws + WS_SELE); float* selg = (float*)(a.ws + WS_SELG);
        for (int i = tid; i < 256 * 16; i += NTHREADS) { const u32x2 o = SEL[i]; const size_t gi = (size_t)(T0 + (i >> 4)) * 128 + hsel * 16 + (i & 15); sele[gi] = o.x; selg[gi] = __uint_as_float(o.y); }
    }
    const int r0 = T0 + 32 * hsel;
    if (tid < 32) ((float*)(a.ws + WS_R2))[r0 + tid] = row_rscale((const float*)(a.ws + WS_SSQ), r0 + tid);
    for (int tk = 0; tk < 4; ++tk) peer_hq_row(a, r0 + wave * 4 + tk, lane);
    __syncthreads();
}
struct PeerSplit { int p0, pstep, trank, tn; };
__device__ __forceinline__ PeerSplit peer_split() {
    PeerSplit s; const int G = gridDim.x;
    if ((G & 7) == 0) { s.p0 = blockIdx.x & 7; s.pstep = 8; s.trank = blockIdx.x >> 3; s.tn = G >> 3; }
    else { s.p0 = 0; s.pstep = 1; s.trank = blockIdx.x; s.tn = G; }
    return s;
}
__device__ __forceinline__ void peer_down(const Args& a) {
    const int lane = threadIdx.x & 63, wave = threadIdx.x >> 6;
    const PeerSplit sp = peer_split();
    const unsigned* sele = (const unsigned*)(a.ws + WS_SELE);
    const float* hs = (const float*)(a.ws + WS_HS);
    const int t0 = sp.trank * NWAVES + wave, tstep = sp.tn * NWAVES;
    for (int p = sp.p0; p < 8; p += sp.pstep) {
        const unsigned char* EDs = a.ws + WS_ED + (size_t)p * (16384 * 128) + 16 * (lane & 7);
        float* part = (float*)(a.ws + WS_PART) + (size_t)p * MTOK * 128;
        const unsigned char* hqh = a.ws + WS_HQH + 128 * p + 16 * (lane & 7);
        const unsigned char* hql = a.ws + WS_HQL + 128 * p + 16 * (lane & 7);
        unsigned e0n = 0, e1n = 0; u32x4 h0n = {0u, 0u, 0u, 0u}, h1n = {0u, 0u, 0u, 0u}; float s1n = 0.f;
        if (t0 < MTOK) { e0n = sele[(size_t)t0 * 128 + lane]; e1n = sele[(size_t)t0 * 128 + 64 + lane]; h0n = *(const u32x4*)(hqh + (size_t)t0 * D); if (PEER_HQ_LO) h1n = *(const u32x4*)(hql + (size_t)t0 * D); s1n = hs[(size_t)t0 * 8 + p]; }
        for (int t = t0; t < MTOK; t += tstep) {
            const unsigned e0 = e0n, e1 = e1n; const u32x4 hh = h0n, hl = h1n; const float s1 = s1n, s2 = s1n * (1.f / 254.f);
            const int tn = t + tstep;
            if (tn < MTOK) { e0n = sele[(size_t)tn * 128 + lane]; e1n = sele[(size_t)tn * 128 + 64 + lane]; h0n = *(const u32x4*)(hqh + (size_t)tn * D); if (PEER_HQ_LO) h1n = *(const u32x4*)(hql + (size_t)tn * D); s1n = hs[(size_t)tn * 8 + p]; }
            float m0 = 0.f, m1 = 0.f;
            u32x4 x[16];
#pragma unroll
            for (int i = 0; i < 16; ++i) {
                const int srcl = (8 * (i & 7) + (lane >> 3)) * 4;
                const unsigned e = (unsigned)__builtin_amdgcn_ds_bpermute(srcl, (int)(i < 8 ? e0 : e1));
                x[i] = *(const u32x4*)(EDs + (size_t)e * 128);
            }
#pragma unroll
            for (int i = 0; i < 16; ++i) {
                int ah = 0, al = 0;
#pragma unroll
                for (int j = 0; j < 4; ++j) { ah = __builtin_amdgcn_sdot4((int)x[i][j], (int)hh[j], ah, false); if (PEER_HQ_LO) al = __builtin_amdgcn_sdot4((int)x[i][j], (int)hl[j], al, false); }
                float d = PEER_HQ_LO ? (float)ah * s1 + (float)al * s2 : (float)ah * s1;
                d += __uint_as_float(dppu(__float_as_uint(d), 0)); d += __uint_as_float(dppu(__float_as_uint(d), 1)); d += __uint_as_float(dppu(__float_as_uint(d), 2));
                if (i < 8) m0 = ((lane & 7) == i) ? d : m0; else m1 = ((lane & 7) == i - 8) ? d : m1;
            }
            part[(size_t)t * 128 + 8 * (lane & 7) + (lane >> 3)] = m0;
            part[(size_t)t * 128 + 64 + 8 * (lane & 7) + (lane >> 3)] = m1;
        }
    }
}
__device__ __forceinline__ void peer_coef(const Args& a) {
    const int lane = threadIdx.x & 63, wave = threadIdx.x >> 6;
    const unsigned* sele = (const unsigned*)(a.ws + WS_SELE); const float* selg = (const float*)(a.ws + WS_SELG);
    const float* part = (const float*)(a.ws + WS_PART);
    const float* esc = (const float*)(a.ws + WS_ESC);
    const float* r2g = (const float*)(a.ws + WS_R2);
    float* coef = (float*)(a.ws + WS_COEF);
    for (int t = blockIdx.x * NWAVES + wave; t < MTOK; t += gridDim.x * NWAVES) {
        const float r2 = r2g[t];
#pragma unroll
        for (int half = 0; half < 2; ++half) {
            const size_t i = (size_t)t * 128 + half * 64 + lane;
            float s = 0.f;
#pragma unroll
            for (int p = 0; p < 8; ++p) s += part[(size_t)p * MTOK * 128 + i];
            const unsigned e = sele[i];
            const float c = selg[i] * gelu_erf(s * r2 * esc[e]) * esc[16384 + e];
            coef[i] = c;
        }
    }
}
__device__ __forceinline__ void peer_up(const Args& a) {
    const int lane = threadIdx.x & 63, wave = threadIdx.x >> 6;
    const PeerSplit sp = peer_split();
    const unsigned* sele = (const unsigned*)(a.ws + WS_SELE);
    const float* coef = (const float*)(a.ws + WS_COEF);
    const int t0 = sp.trank * NWAVES + wave, tstep = sp.tn * NWAVES;
    for (int p = sp.p0; p < 8; p += sp.pstep) {
        const unsigned char* EUs = a.ws + WS_EU + (size_t)p * (16384 * 128) + 16 * (lane & 7);
        const bf16_t* hbase = (const bf16_t*)(a.ws + WS_B) + 128 * p + 16 * (lane & 7) + 2 * (lane >> 3);
        float* h3base = (float*)(a.ws + WS_PART) + 128 * p + 16 * (lane & 7) + 2 * (lane >> 3);
        unsigned e0n = 0, e1n = 0; float c0n = 0.f, c1n = 0.f; unsigned h2n = 0u;
        if (t0 < MTOK) { e0n = sele[(size_t)t0 * 128 + lane]; e1n = sele[(size_t)t0 * 128 + 64 + lane]; c0n = coef[(size_t)t0 * 128 + lane]; c1n = coef[(size_t)t0 * 128 + 64 + lane]; h2n = *(const unsigned*)(hbase + (size_t)t0 * D); }
        for (int t = t0; t < MTOK; t += tstep) {
            const unsigned e0 = e0n, e1 = e1n; const float c0 = c0n, c1 = c1n; const f32x2_t h2 = {bflo(h2n), bfhi(h2n)};
            const int tn = t + tstep;
            if (tn < MTOK) { e0n = sele[(size_t)tn * 128 + lane]; e1n = sele[(size_t)tn * 128 + 64 + lane]; c0n = coef[(size_t)tn * 128 + lane]; c1n = coef[(size_t)tn * 128 + 64 + lane]; h2n = *(const unsigned*)(hbase + (size_t)tn * D); }
            f32x2_t acc[8];
#pragma unroll
            for (int j = 0; j < 8; ++j) acc[j] = (f32x2_t){0.f, 0.f};
            u32x4 x[16]; float cfs[16];
#pragma unroll
            for (int i = 0; i < 16; ++i) {
                const int srcl = (8 * (i & 7) + (lane >> 3)) * 4;
                const unsigned e = (unsigned)__builtin_amdgcn_ds_bpermute(srcl, (int)(i < 8 ? e0 : e1));
                cfs[i] = __uint_as_float((unsigned)__builtin_amdgcn_ds_bpermute(srcl, (int)__float_as_uint(i < 8 ? c0 : c1)));
                x[i] = *(const u32x4*)(EUs + (size_t)e * 128);
            }
#pragma unroll
            for (int i = 0; i < 16; ++i) {
                const f32x2_t cf2 = {cfs[i], cfs[i]};
#pragma unroll
                for (int j = 0; j < 4; ++j) {
                    acc[2 * j] = __builtin_elementwise_fma(__builtin_amdgcn_cvt_pk_f32_fp8((int)x[i][j], false), cf2, acc[2 * j]);
                    acc[2 * j + 1] = __builtin_elementwise_fma(__builtin_amdgcn_cvt_pk_f32_fp8((int)x[i][j], true), cf2, acc[2 * j + 1]);
                }
            }
            const bool b5 = lane & 32, b4 = lane & 16, b3 = lane & 8;
            f32x2_t k4[4], k2[2], k1;
#pragma unroll
            for (int j = 0; j < 4; ++j) {
                const f32x2_t keep = b5 ? acc[4 + j] : acc[j], send = b5 ? acc[j] : acc[4 + j];
                k4[j] = (f32x2_t){keep[0] + __shfl_xor(send[0], 32), keep[1] + __shfl_xor(send[1], 32)};
            }
#pragma unroll
            for (int j = 0; j < 2; ++j) {
                const f32x2_t keep = b4 ? k4[2 + j] : k4[j], send = b4 ? k4[j] : k4[2 + j];
                k2[j] = (f32x2_t){keep[0] + __shfl_xor(send[0], 16), keep[1] + __shfl_xor(send[1], 16)};
            }
            {
                const f32x2_t keep = b3 ? k2[1] : k2[0], send = b3 ? k2[0] : k2[1];
                k1 = (f32x2_t){keep[0] + __shfl_xor(send[0], 8), keep[1] + __shfl_xor(send[1], 8)};
            }
            const f32x2_t h3 = h2 + k1;
            *(f32x2_t*)(h3base + (size_t)t * D) = h3;
        }
    }
}
__device__ __forceinline__ void peer_final(const Args& a) {
    const int lane = threadIdx.x & 63, wave = threadIdx.x >> 6;
    const float* gf = a.in[I_GFINAL];
    for (int t = blockIdx.x * NWAVES + wave; t < MTOK; t += gridDim.x * NWAVES) {
        const float* hrow = (const float*)(a.ws + WS_PART) + (size_t)t * D + 4 * lane;
        float* orow = a.out + (size_t)t * D + 4 * lane;
        f32x4 v[4]; float s = 0.f;
#pragma unroll
        for (int j = 0; j < 4; ++j) { v[j] = *(const f32x4*)(hrow + 256 * j); s += v[j][0] * v[j][0] + v[j][1] * v[j][1] + v[j][2] * v[j][2] + v[j][3] * v[j][3]; }
        const float r3 = rsqrtf(wave_sum(s) * (1.f / D) + EPS);
#pragma unroll
        for (int j = 0; j < 4; ++j) *(f32x4*)(orow + 256 * j) = v[j] * r3 * *(const f32x4*)(gf + 4 * lane + 256 * j);
    }
}
__device__ __forceinline__ void peer_fold_task(const Args& a, int task) {
    const int lane = threadIdx.x & 63, wave = threadIdx.x >> 6, l15 = lane & 15, lq = lane >> 4;
    const int hc = task >> 2, c = hc & 1, k0 = (task & 3) * 256 + wave * 32;
    const bf16_t* wgr = (const bf16_t*)(a.ws + WS_WGR);
    const bf16_t* sk = (const bf16_t*)(a.ws + WS_SK) + (size_t)c * 128 * 128;
    bf16_t* btp = (bf16_t*)(a.ws + WS_WPQ);
    f32x4 acc[2][8];
#pragma unroll
    for (int mt = 0; mt < 2; ++mt)
#pragma unroll
        for (int nt = 0; nt < 8; ++nt) acc[mt][nt] = (f32x4){0.f, 0.f, 0.f, 0.f};
#pragma unroll
    for (int ks = 0; ks < 4; ++ks) {
        bf16x8 af[2];
#pragma unroll
        for (int mt = 0; mt < 2; ++mt) af[mt] = *(const bf16x8*)(wgr + (size_t)(k0 + mt * 16 + l15) * 2048 + hc * 128 + ks * 32 + 8 * lq);
#pragma unroll
        for (int nt = 0; nt < 8; ++nt) {
            const bf16x8 bv = *(const bf16x8*)(sk + (size_t)(nt * 16 + l15) * 128 + ks * 32 + 8 * lq);
#pragma unroll
            for (int mt = 0; mt < 2; ++mt) acc[mt][nt] = mfma16(af[mt], bv, acc[mt][nt]);
        }
    }
#pragma unroll
    for (int mt = 0; mt < 2; ++mt)
#pragma unroll
        for (int nt = 0; nt < 8; ++nt) {
            u32x2 o; o.x = pk2(acc[mt][nt][0], acc[mt][nt][1]); o.y = pk2(acc[mt][nt][2], acc[mt][nt][3]);
            *(u32x2*)(btp + (size_t)(hc * 128 + nt * 16 + l15) * 1024 + k0 + mt * 16 + 4 * lq) = o;
        }
}

#define XB_TMO      128
#define XB_XCNT(j)  (256  + 64 * (j))
#define XB_XSUB(j)  (1280 + 64 * (j))
#define XB_XGEN(j)  (2304 + 64 * (j))
#define XB_TOP      3328
#define XB_TOPGEN   3392
#define XCD_BAR_WORDS 3456
#define XB_SPIN_CAP (1u << 22)
__device__ __forceinline__ unsigned xb_ld(unsigned* p)              { return __hip_atomic_load(p, __ATOMIC_RELAXED, __HIP_MEMORY_SCOPE_AGENT); }
__device__ __forceinline__ unsigned xb_add(unsigned* p, unsigned v) { return __hip_atomic_fetch_add(p, v, __ATOMIC_RELAXED, __HIP_MEMORY_SCOPE_AGENT); }
__device__ __forceinline__ unsigned xb_xcc_id() { return (unsigned)__builtin_amdgcn_s_getreg((3 << 11) | 20) & 0xFu; }
#define XB_SPIN(cond, bar) do { unsigned _sp = 0; while (cond) { __builtin_amdgcn_s_sleep(1); \
    if ((++_sp & 255u) == 0u) { if (xb_ld(&(bar)[XB_TMO])) break; if (_sp > XB_SPIN_CAP) { atomicAdd(&(bar)[XB_TMO], 1u); break; } } } } while (0)
struct XcdBarrier { unsigned* bar; unsigned x; volatile LAS unsigned* st; };
__device__ __forceinline__ XcdBarrier xcd_barrier_post(unsigned* bar, volatile LAS unsigned* st) {
    XcdBarrier b; b.bar = bar; b.x = xb_xcc_id(); b.st = st;
    if (threadIdx.x == 0) (void)xb_add(&bar[XB_XCNT(b.x)], 1u);
    return b;
}
__device__ __forceinline__ void xcd_barrier_complete(unsigned* bar, unsigned x, unsigned& nloc, unsigned& nx) {
    const unsigned G = gridDim.x * gridDim.y * gridDim.z;
    unsigned sum, cnt, mine, sp = 0u;
    for (;;) {
        sum = 0u; cnt = 0u; mine = 0u;
#pragma unroll
        for (unsigned j = 0; j < 16; ++j) { const unsigned c = xb_ld(&bar[XB_XCNT(j)]); sum += c; cnt += (c > 0u) ? 1u : 0u; mine = (j == x) ? c : mine; }
        if (sum == G) break;
        __builtin_amdgcn_s_sleep(1);
        if ((++sp & 255u) == 0u) { if (xb_ld(&bar[XB_TMO])) break; if (sp > XB_SPIN_CAP) { atomicAdd(&bar[XB_TMO], 1u); break; } }
    }
    nloc = mine > 0u ? mine : 1u; nx = cnt > 0u ? cnt : 1u;
}
__device__ __forceinline__ void xcd_barrier(const XcdBarrier& b) {
    asm volatile("s_waitcnt vmcnt(0)" ::: "memory");
    __syncthreads();
    if (threadIdx.x == 0) {
        unsigned* bar = b.bar;
        __builtin_amdgcn_s_waitcnt(0);
        unsigned nloc = b.st[0], nx = b.st[1];
        if (nloc == 0u) { xcd_barrier_complete(bar, b.x, nloc, nx); b.st[0] = nloc; b.st[1] = nx; }
        const unsigned old = xb_add(&bar[XB_XSUB(b.x)], 1u);
        const unsigned gen = old / nloc;
        if (old + 1u == (gen + 1u) * nloc) {
            __builtin_amdgcn_fence(__ATOMIC_RELEASE, "agent");
            asm volatile("s_waitcnt vmcnt(0)" ::: "memory");
            const unsigned og = xb_add(&bar[XB_TOP], 1u);
            const unsigned tg = og / nx;
            if (og + 1u == (tg + 1u) * nx) xb_add(&bar[XB_TOPGEN], 1u);
            else XB_SPIN(xb_ld(&bar[XB_TOPGEN]) == tg, bar);
            __builtin_amdgcn_fence(__ATOMIC_ACQUIRE, "agent");
            xb_add(&bar[XB_XGEN(b.x)], 1u);
            asm volatile("s_waitcnt vmcnt(0)" ::: "memory");
        } else {
            XB_SPIN(xb_ld(&bar[XB_XGEN(b.x)]) == gen, bar);
            __builtin_amdgcn_fence(__ATOMIC_ACQUIRE, "agent");
            asm volatile("s_waitcnt vmcnt(0)" ::: "memory");
        }
    }
    __syncthreads();
}


#ifndef FUSE_SCORE
#define FUSE_SCORE 1
#endif
constexpr int NPHASES = 15;
__global__ __launch_bounds__(NTHREADS, 2) void hybrid_fwd(Args a) {
    extern __shared__ __attribute__((aligned(16))) unsigned char smem[];
    LAS unsigned char* lds = (LAS unsigned char*)smem;
    volatile LAS unsigned* xbw = (volatile LAS unsigned*)(lds + LDS_BYTES - 16);
    unsigned char* ws = a.ws;
    const int G = gridDim.x;
    if (threadIdx.x == 0) { xbw[0] = 0u; xbw[1] = 0u; xbw[2] = 0u; xbw[3] = 0u; }
    __syncthreads();
    XcdBarrier xb; xb.bar = (unsigned*)(ws + WS_BAR); xb.x = 0; xb.st = xbw;
    const bool multi = (a.ph_hi - a.ph_lo) > 1;
    if (multi) xb = xcd_barrier_post((unsigned*)(ws + WS_BAR), xbw);
#define PHON(n) 1
#define PH_BEGIN(n) if (PHON(n) && a.ph_lo <= (n) && (n) < a.ph_hi) { auto body_ = [&]() __attribute__((always_inline)) {
#define PH_END(n) }; body_(); if ((n) + 1 < a.ph_hi) xcd_barrier(xb); }
    PH_BEGIN(0) phase0(a, lds); PH_END(0)
    PH_BEGIN(1)
        { pg8::Gemm g{(const bf16_t*)(ws + WS_B), (const bf16_t*)(ws + WS_WIN), MTOK, NPROJ, D};
          pg8::StaticOrder S; S.init(g.M, g.N, G, blockIdx.x);
          EpiRowBf16 E{(bf16_t*)(ws + WS_A), NPROJ, nullptr, 1.0f};
          pg8::gemm_phase<EpiRowBf16, pg8::StaticOrder, false>(lds, g, S, E, nullptr); }
        { pg8::Gemm g{(const bf16_t*)(ws + WS_C), (const bf16_t*)(ws + WS_WXKV), NB * MEMLEN, 2048, D};
          pg8::StaticOrder S; S.init(g.M, g.N, G, (blockIdx.x + G - (64 % G)) % G);
          EpiKV E{(bf16_t*)(ws + WS_KMEM), (bf16_t*)(ws + WS_VTMEM)};
          pg8::gemm_phase<EpiKV, pg8::StaticOrder, false>(lds, g, S, E, nullptr); }
        { const int lo = (G > 160) ? 80 : 0;
          if ((int)blockIdx.x >= lo) p0_experts(a, blockIdx.x - lo, G - lo); }
    PH_END(1)
    PH_BEGIN(2) for (int t = blockIdx.x; t < 1280; t += G) { if (t < 1024) mlstm_local(a, lds, t); else swa_task(a, lds, t - 1024); } PH_END(2)
    PH_BEGIN(3) p0_late_transposes(a, lds); mlstm_scan(a); PH_END(3)
    PH_BEGIN(4)
        {
            for (int fu = blockIdx.x; fu < 128; fu += G) {
                if (fu < 64) {
                    const int j = fu >> 2, bh = j & 7, b = bh >> 2, h = bh & 3;
                    const bf16_t* Kh = (const bf16_t*)(ws + WS_KMEM) + (size_t)bh * 65536; const bf16_t* Vh = (const bf16_t*)(ws + WS_VTMEM) + (size_t)bh * 65536;
                    const bf16_t* WqR = (const bf16_t*)(ws + WS_WXQ) + (size_t)h * 1024 * 256; const bf16_t* WoR = (const bf16_t*)(ws + WS_WXO) + (size_t)h * 1024 * 256;
                    pg8::Gemm g{}; EpiRowBf16 E{nullptr, 1024, nullptr, 1.0f};
                    if (j < 8) { g.A = Kh; g.Bt = WqR; g.M = 256; g.N = 1024; g.K = 256; E.O = (bf16_t*)(ws + WS_WXKV) + ((size_t)b * 1024 + h * 256) * 1024; }
                    else { g.A = WoR; g.Bt = Vh; g.M = 1024; g.N = 256; g.K = 256; E.O = (bf16_t*)(ws + WS_BTO) + (size_t)b * 1024 * 1024 + h * 256; }
                    pg8::StaticOrder S; S.init(g.M, g.N, 4, fu & 3);
                    pg8::gemm_phase<EpiRowBf16, pg8::StaticOrder, false>(lds, g, S, E, nullptr);
                } else peer_fold_task(a, fu - 64);
                __syncthreads();
            }
            __syncthreads();
        }
        for (int t = blockIdx.x; t < 1024; t += G) mlstm_out(a, lds, t);
    PH_END(4)
    PH_BEGIN(5) { pg8::Gemm g{(const bf16_t*)(ws + WS_C), (const bf16_t*)(ws + WS_WOUT), MTOK, D, D};
          pg8::StaticOrder S; S.init(g.M, g.N, G, blockIdx.x);
          EpiResid<false> E{a.in[I_X], (bf16_t*)(ws + WS_B), (float*)(ws + WS_SSQ)};
          pg8::gemm_phase<EpiResid<false>, pg8::StaticOrder, false>(lds, g, S, E, nullptr); } PH_END(5)
    PH_BEGIN(6) { pg8::Gemm g{(const bf16_t*)(ws + WS_B), (const bf16_t*)(ws + WS_WXKV), MTOK, D, D, 32, (size_t)1024 * 1024 * 2};
          EpiSoftmax E{(bf16_t*)(ws + WS_A), (const float*)(ws + WS_SSQ)};
          for (int L = blockIdx.x; L < (MTOK / 256) * (D / 256); L += G) {
              pg8::StaticOrder S; S.init(g.M, g.N, (MTOK / 256) * (D / 256), L);
              pg8::gemm_phase<EpiSoftmax, pg8::StaticOrder, false>(lds, g, S, E, nullptr);
          } } PH_END(6)
    PH_BEGIN(8) { pg8::Gemm g{(const bf16_t*)(ws + WS_A), (const bf16_t*)(ws + WS_BTO), MTOK, D, D, 32, (size_t)1024 * 1024 * 2};
          pg8::StaticOrder S; S.init(g.M, g.N, G, blockIdx.x);
          EpiResid<true> E{(const void*)(ws + WS_B), (bf16_t*)(ws + WS_B), (float*)(ws + WS_SSQ)};
          pg8::gemm_phase<EpiResid<true>, pg8::StaticOrder, false>(lds, g, S, E, nullptr); } PH_END(8)
    PH_BEGIN(9) { pg8::Gemm g{(const bf16_t*)(ws + WS_B), (const bf16_t*)(ws + WS_WPQ), MTOK, 2048, D};
          pg8::StaticOrder S; S.init(g.M, g.N, G, blockIdx.x);
          EpiRowBf16 E{(bf16_t*)(ws + WS_A), 2048, (const float*)(ws + WS_SSQ), 1.0f};
          pg8::gemm_phase<EpiRowBf16, pg8::StaticOrder, false>(lds, g, S, E, nullptr);
#if FUSE_SCORE
          asm volatile("s_waitcnt vmcnt(0)" ::: "memory"); __syncthreads();
          pg8::Unit u;
          for (int i = 0; S.next(i, u); ++i) peer_score_unit(a, lds, u.pm, u.pn);
#endif
          } PH_END(9)

    PH_BEGIN(11) peer_down(a); PH_END(11)
    PH_BEGIN(12) peer_coef(a); PH_END(12)
    PH_BEGIN(13) peer_up(a); PH_END(13)
    PH_BEGIN(14) peer_final(a); PH_END(14)
}

#ifndef MK_ONE_LAUNCH
#define MK_ONE_LAUNCH 1
#endif
extern "C" void kernel_launch(void* const* d_in, const int* in_sizes, int n_in, void* d_out, int out_size, void* d_ws, size_t ws_size, hipStream_t stream) {
    static int grid = 0;
    if (grid == 0) {
        if (n_in != 24 || out_size != MTOK * D || ws_size < WS_END) { fprintf(stderr, "kernel_launch: unexpected shapes (n_in %d out %d ws %zu)\n", n_in, out_size, ws_size); grid = -1; return; }
        int dev = 0, cus = 0;
        if (hipGetDevice(&dev) != hipSuccess || hipDeviceGetAttribute(&cus, hipDeviceAttributeMultiprocessorCount, dev) != hipSuccess) { grid = -1; return; }
        if (hipFuncSetAttribute((const void*)hybrid_fwd, hipFuncAttributeMaxDynamicSharedMemorySize, LDS_BYTES) != hipSuccess) { fprintf(stderr, "kernel_launch: hipFuncSetAttribute failed\n"); grid = -1; return; }
        int per_cu = 0;
        if (hipOccupancyMaxActiveBlocksPerMultiprocessor(&per_cu, (const void*)hybrid_fwd, NTHREADS, LDS_BYTES) != hipSuccess || per_cu < 1) { fprintf(stderr, "kernel_launch: occupancy query says %d\n", per_cu); }
        (void)hipGetLastError();
        grid = cus;
    }
    if (grid < 0) return;
    (void)hipMemsetAsync((char*)d_ws + WS_BAR, 0, XCD_BAR_WORDS * 4, stream);
    Args a{};
    for (int i = 0; i < 24; ++i) a.in[i] = (const float*)d_in[i];
    a.out = (float*)d_out; a.ws = (unsigned char*)d_ws;
#if MK_ONE_LAUNCH
    a.ph_lo = 0; a.ph_hi = NPHASES;
    hipLaunchKernelGGL(hybrid_fwd, dim3(grid), dim3(NTHREADS), LDS_BYTES, stream, a);
#else
    for (int ph = 0; ph < NPHASES; ++ph) {
        a.ph_lo = ph; a.ph_hi = ph + 1;
        hipLaunchKernelGGL(hybrid_fwd, dim3(grid), dim3(NTHREADS), LDS_BYTES, stream, a);
    }
#endif
}
```

```cpp
#include <hip/hip_runtime.h>
#include <cstdio>
#include <cstdint>
namespace pg8 {
#define PG8_LAS __attribute__((address_space(3)))
typedef unsigned short bf16_t;
typedef short bf16x8 __attribute__((ext_vector_type(8)));
typedef float f32x4 __attribute__((ext_vector_type(4)));
typedef unsigned u32x4 __attribute__((ext_vector_type(4)));
constexpr int BM = 256, BK = 64, HALF = 128, HTB = HALF * BK * 2  , STAGE_BYTES = 8 * HTB, NXCD = 8, WGM = 8;

__host__ __device__ __forceinline__ int lds_byte(int r, int c) { const int st = (r >> 4) * 2 + (c >> 5), rr = r & 15, cc = c & 31, ob = rr * 64 + cc * 2; return st * 1024 + (ob ^ (((ob >> 9) & 1) << 5)); }
__host__ __device__ __forceinline__ void stage_rc(int b, int& R, int& C) { const int st = b / 1024, sb = b % 1024, swz = sb ^ (((sb >> 9) & 1) << 5); R = (st >> 1) * 16 + swz / 64; C = (st & 1) * 32 + (swz % 64) / 2; }
__host__ __device__ __forceinline__ int perm32(int rho) { const int n = rho >> 4, i = rho & 15; return 8 * (i >> 2) + 4 * n + (i & 3); }

struct Unit { int pm, pn; };
struct Gemm { const bf16_t* A; const bf16_t* Bt; int M, N, K; int pm_split; size_t bt_split_bytes; };

struct StaticOrder {
    int nM, nN, nwg, G, c;
    __host__ __device__ void init(int M, int N, int G_, int c_) { nM = M / BM; nN = N / BM; nwg = nM * nN; G = G_; c = c_; }
    __host__ __device__ bool next(int i, Unit& u) const {
        const long L = (long)i * G + c; if (L >= nwg) return false;
        int wgid = (int)L; { const int q = nwg / NXCD, r = nwg % NXCD, xcd = wgid % NXCD, off = wgid / NXCD; wgid = (xcd < r ? xcd * (q + 1) : r * (q + 1) + (xcd - r) * q) + off; }
        const int nig = WGM * nN, gid = wgid / nig, fm = gid * WGM, gsz = (nM - fm) < WGM ? (nM - fm) : WGM;
        u.pm = fm + ((wgid % nig) % gsz); u.pn = (wgid % nig) / gsz; return true;
    }
    __device__ __forceinline__ void a_ready(const Unit&) const {}
    __device__ __forceinline__ void done(const Unit&) const {}
};
__device__ __forceinline__ unsigned cvt_pk_bf16(float lo, float hi) { unsigned r; asm volatile("v_cvt_pk_bf16_f32 %0, %1, %2" : "=v"(r) : "v"(lo), "v"(hi)); return r; }
typedef float f32x2 __attribute__((ext_vector_type(2)));
__device__ __forceinline__ f32x2 gelu_pk(f32x2 v) {
    const f32x2 av = __builtin_elementwise_abs(v), d = av * 0.2316418882f + 1.0f;
    f32x2 t; t.x = __builtin_amdgcn_rcpf(d.x); t.y = __builtin_amdgcn_rcpf(d.y);
    f32x2 q = t * 0.5307027145f + (-0.7265760135f); q = q * t + 0.7107068705f; q = q * t + (-0.142248368f); q = q * t + 0.127414796f; q = q * t;
    const f32x2 s = (v * v) * (-0.72134752044f);
    f32x2 e; e.x = __builtin_amdgcn_exp2f(s.x); e.y = __builtin_amdgcn_exp2f(s.y);
    const f32x2 m = v * (q * e), r = v - m;
    f32x2 o; o.x = v.x < 0.f ? m.x : r.x; o.y = v.y < 0.f ? m.y : r.y; return o;
}

template <class Epi, class Sched, bool STAMP = false>
__device__ __forceinline__ void gemm_phase(PG8_LAS unsigned char* lds, const Gemm g, const Sched& S, const Epi& E, unsigned long long* stamps) {
    const int tid = threadIdx.x, wid = __builtin_amdgcn_readfirstlane(tid >> 6), lane = tid & 63, wr = wid >> 2, wc = wid & 3, fr = lane & 15, fq = lane >> 4;
    const int K = g.K, nt = K / BK;
    int ts_lo = 0, ts_hi = 0, nts = 0; const unsigned long long rt_entry = STAMP ? (unsigned long long)wall_clock64() : 0ull;
#define PG8_STAMP() do { if (STAMP && wid == 0 && nts < 64) { const unsigned long long _c = (unsigned long long)clock64(); \
        ts_lo = (lane == nts) ? (int)(unsigned)_c : ts_lo; ts_hi = (lane == nts) ? (int)(unsigned)(_c >> 32) : ts_hi; ++nts; } } while (0)
    PG8_STAMP();
    unsigned voffA[2], voffB[2];
#pragma unroll
    for (int i = 0; i < 2; ++i) { int R, C; stage_rc(tid * 16 + i * 8192, R, C); const int Rb = Epi::PERM ? ((R & ~31) + perm32(R & 31)) : R;
        voffA[i] = (unsigned)(R * K + C) * 2u; voffB[i] = (unsigned)(Rb * K + C) * 2u; }
    const size_t kstep = (size_t)(BK * 2);
    const size_t hstep = (size_t)HALF * K * 2;
    const size_t tstep = 2 * hstep;
    const unsigned ldsw = (unsigned)wid * 1024u;
    const int aoff = lds_byte(wr * 64 + fr, fq * 8), boff = lds_byte(wc * 32 + fr, fq * 8);
#define PG8_SA(b, h) (((b) * 2 + (h)) * HTB)
#define PG8_SB(b, h) ((4 + (b) * 2 + (h)) * HTB)
#define PG8_STAGE(bufoff, gbase, voff) do { _Pragma("unroll") for (int _i = 0; _i < 2; ++_i) \
        __builtin_amdgcn_global_load_lds((const unsigned*)((const char*)(gbase) + (voff)[_i]), (PG8_LAS unsigned*)(lds + (bufoff) + ldsw + _i * 8192), 16, 0, 0); } while (0)
#define PG8_LDA(dst, b, h) do { _Pragma("unroll") for (int m = 0; m < 4; ++m) _Pragma("unroll") for (int k = 0; k < 2; ++k) dst[m][k] = *(const PG8_LAS bf16x8*)(lds + PG8_SA(b, h) + aoff + m * 2048 + k * 1024); } while (0)
#define PG8_LDB(dst, b, h) do { _Pragma("unroll") for (int n = 0; n < 2; ++n) _Pragma("unroll") for (int k = 0; k < 2; ++k) dst[n][k] = *(const PG8_LAS bf16x8*)(lds + PG8_SB(b, h) + boff + n * 2048 + k * 1024); } while (0)
#define PG8_MMA(ai, bj, At, Bt) do { __builtin_amdgcn_s_setprio(1); _Pragma("unroll") for (int m = 0; m < 4; ++m) _Pragma("unroll") for (int n = 0; n < 2; ++n) _Pragma("unroll") for (int k = 0; k < 2; ++k) \
        acc[ai][bj][m][n] = __builtin_amdgcn_mfma_f32_16x16x32_bf16(Bt[n][k], At[m][k], acc[ai][bj][m][n], 0, 0, 0); __builtin_amdgcn_s_setprio(0); } while (0)
#define PG8_WAIT_V(n) asm volatile("s_waitcnt vmcnt(" #n ")" ::: "memory")
#define PG8_WAIT_L(n) asm volatile("s_waitcnt lgkmcnt(" #n ")" ::: "memory")
#define PG8_BAR __builtin_amdgcn_s_barrier()
#define PG8_SCHED __builtin_amdgcn_sched_barrier(0)
    Unit cur, nxt; int ui = 0;
    if (!S.next(0, cur)) return;
    f32x4 acc[2][2][4][2];
#pragma unroll
    for (int a = 0; a < 2; ++a)
#pragma unroll
        for (int b = 0; b < 2; ++b)
#pragma unroll
            for (int m = 0; m < 4; ++m)
#pragma unroll
                for (int n = 0; n < 2; ++n) acc[a][b][m][n] = (f32x4){0.f, 0.f, 0.f, 0.f};
    bf16x8 At[4][2], B0[2][2], B1[2][2];
    const char* cA = (const char*)g.A + (size_t)cur.pm * tstep; const char* cB = (const char*)g.Bt + (size_t)cur.pn * tstep + ((g.pm_split > 0 && cur.pm >= g.pm_split) ? g.bt_split_bytes : (size_t)0);
    S.a_ready(cur);
    PG8_STAGE(PG8_SB(0, 0), cB, voffB); PG8_STAGE(PG8_SA(0, 0), cA, voffA); PG8_STAGE(PG8_SB(0, 1), cB + hstep, voffB); PG8_STAGE(PG8_SA(0, 1), cA + hstep, voffA);
    if (wr == 1) PG8_BAR;
    PG8_WAIT_V(4); PG8_BAR;
    PG8_STAGE(PG8_SB(1, 0), cB + kstep, voffB); PG8_STAGE(PG8_SA(1, 0), cA + kstep, voffA); PG8_STAGE(PG8_SB(1, 1), cB + hstep + kstep, voffB);
    PG8_WAIT_V(6); PG8_BAR;
    PG8_STAMP();
    for (;;) {
        const bool has_next = S.next(ui + 1, nxt);
        const char* nA = has_next ? (const char*)g.A + (size_t)nxt.pm * tstep : cA; const char* nB = has_next ? (const char*)g.Bt + (size_t)nxt.pn * tstep + ((g.pm_split > 0 && nxt.pm >= g.pm_split) ? g.bt_split_bytes : (size_t)0) : cB;
        for (int t = 0; t < nt; t += 2) {
            const bool last = (t == nt - 2);
            const char* a1 = cA + (size_t)(t + 1) * kstep;
            const char* a2 = last ? nA : cA + (size_t)(t + 2) * kstep; const char* b2 = last ? nB : cB + (size_t)(t + 2) * kstep;
            const char* a3 = a2 + kstep; const char* b3 = b2 + kstep;
            if (last && has_next) S.a_ready(nxt);
            PG8_LDB(B0, 0, 0); PG8_SCHED; PG8_LDA(At, 0, 0); PG8_STAGE(PG8_SA(1, 1), a1 + hstep, voffA);
            PG8_WAIT_L(8); PG8_BAR; PG8_WAIT_L(0); PG8_MMA(0, 0, At, B0); PG8_BAR; PG8_SCHED;
            PG8_LDB(B1, 0, 1); PG8_STAGE(PG8_SB(0, 0), b2, voffB);
            PG8_BAR; PG8_WAIT_L(0); PG8_MMA(0, 1, At, B1); PG8_BAR;
            PG8_LDA(At, 0, 1); PG8_STAGE(PG8_SA(0, 0), a2, voffA);
            PG8_BAR; PG8_WAIT_L(0); PG8_MMA(1, 0, At, B0); PG8_BAR; PG8_SCHED;
            PG8_STAGE(PG8_SB(0, 1), b2 + hstep, voffB);
            PG8_WAIT_V(6); PG8_BAR; PG8_MMA(1, 1, At, B1); PG8_BAR;
            PG8_LDB(B0, 1, 0); PG8_SCHED; PG8_LDA(At, 1, 0); PG8_STAGE(PG8_SA(0, 1), a2 + hstep, voffA);
            PG8_WAIT_L(8); PG8_BAR; PG8_WAIT_L(0); PG8_MMA(0, 0, At, B0); PG8_BAR; PG8_SCHED;
            PG8_LDB(B1, 1, 1); PG8_STAGE(PG8_SB(1, 0), b3, voffB);
            PG8_BAR; PG8_WAIT_L(0); PG8_MMA(0, 1, At, B1); PG8_BAR;
            PG8_LDA(At, 1, 1); PG8_STAGE(PG8_SA(1, 0), a3, voffA);
            PG8_BAR; PG8_WAIT_L(0); PG8_MMA(1, 0, At, B0); PG8_BAR; PG8_SCHED;
            PG8_STAGE(PG8_SB(1, 1), b3 + hstep, voffB);
            PG8_WAIT_V(6); PG8_BAR; PG8_MMA(1, 1, At, B1); PG8_BAR;
        }
        PG8_STAMP();
        if constexpr (!Epi::AFTER_DRAIN) { E(acc, cur, wr, wc, fr, fq); S.done(cur); }
        PG8_STAMP();
        if (!has_next) break;
#pragma unroll
        for (int a = 0; a < 2; ++a)
#pragma unroll
            for (int b = 0; b < 2; ++b)
#pragma unroll
                for (int m = 0; m < 4; ++m)
#pragma unroll
                    for (int n = 0; n < 2; ++n) acc[a][b][m][n] = (f32x4){0.f, 0.f, 0.f, 0.f};
        cur = nxt; cA = nA; cB = nB; ++ui;
    }
    PG8_WAIT_V(0);
    if (wr == 0) PG8_BAR;
    PG8_BAR;
    if constexpr (Epi::AFTER_DRAIN) { E.fused(acc, cur, wr, wc, fr, fq, lds, wid, lane); S.done(cur); }
    PG8_STAMP();
    if (STAMP && wid == 0) { stamps[lane] = lane < nts ? (((unsigned long long)(unsigned)ts_hi << 32) | (unsigned)ts_lo) : 0ull;
        if (lane == 62) stamps[62] = rt_entry; if (lane == 63) stamps[63] = (unsigned long long)wall_clock64(); }
#undef PG8_STAMP
#undef PG8_SA
#undef PG8_SB
#undef PG8_STAGE
#undef PG8_LDA
#undef PG8_LDB
#undef PG8_MMA
#undef PG8_WAIT_V
#undef PG8_WAIT_L
#undef PG8_BAR
#undef PG8_SCHED
}
}

#define LAS __attribute__((address_space(3)))
typedef unsigned short bf16_t;
typedef short bf16x8 __attribute__((ext_vector_type(8)));
typedef short bf16x4 __attribute__((ext_vector_type(4)));
typedef float f32x4 __attribute__((ext_vector_type(4)));
typedef unsigned u32x4 __attribute__((ext_vector_type(4)));
typedef unsigned u32x2 __attribute__((ext_vector_type(2)));

constexpr int D = 1024, NB = 2, SEQ = 8192, MTOK = NB * SEQ, MEMLEN = 256;
constexpr int NPROJ = 2304;
constexpr int C_MQ = 0, C_MK = 256, C_MV = 512, C_MO = 1024, C_AQ = 1536, C_AK = 2048, C_AV = 2176;
constexpr float EPS = 1e-6f;
constexpr int NTHREADS = 512, NWAVES = 8;
constexpr int LDS_BYTES = 144 * 1024;

constexpr size_t MiB = (size_t)1 << 20;
constexpr size_t WS_A = 0;
constexpr size_t WS_B = 72 * MiB;
constexpr size_t WS_C = 104 * MiB;
constexpr size_t WS_ED = 136 * MiB;
constexpr size_t WS_EU = 152 * MiB;
constexpr size_t WS_WIN = 200 * MiB;
constexpr size_t WS_WOUT = WS_WIN + 2304 * 1024 * 2;
constexpr size_t WS_WXQ = WS_WOUT + 2 * MiB;
constexpr size_t WS_WXKV = WS_WXQ + 2 * MiB;
constexpr size_t WS_WXO = WS_WXKV + 4 * MiB;
constexpr size_t WS_WPQ = WS_WXO + 2 * MiB;
constexpr size_t WS_G = 219 * MiB;
constexpr size_t WS_GATES = WS_G;
constexpr size_t WS_KMEM = WS_GATES + 512 * 1024;
constexpr size_t WS_VTMEM = WS_KMEM + MiB;
constexpr size_t WS_SSQ = WS_VTMEM + MiB;
constexpr size_t WS_DN = WS_SSQ + MiB;
constexpr size_t WS_DECAY = WS_DN + 256 * 1024;
constexpr size_t WS_SK = WS_DECAY + 4096;
constexpr size_t WS_ESC = WS_SK + 65536;
constexpr size_t WS_SELE = WS_A + 64 * MiB;
constexpr size_t WS_SELG = WS_C;
constexpr size_t WS_COEF = WS_C + 8 * MiB;
constexpr size_t WS_R2 = WS_C + 16 * MiB;
constexpr size_t WS_SSQ3 = WS_C + 17 * MiB;
constexpr size_t WS_PART = WS_A;
constexpr size_t WS_ST = 168 * MiB;
constexpr size_t WS_HQH = 168 * MiB;
constexpr size_t WS_HQL = 184 * MiB;
constexpr size_t WS_HS = WS_C + 18 * MiB;
constexpr size_t WS_CS = WS_C + 19 * MiB;
constexpr size_t WS_BAR = 223 * MiB;
constexpr size_t WS_BTO = 224 * MiB;
constexpr size_t WS_WGR = 228 * MiB;
constexpr size_t WS_END = 232 * MiB;

struct Args {
    const float* in[24];
    float* out;
    unsigned char* ws;
    int ph_lo, ph_hi;
};
enum { I_X = 0, I_MEM, I_GMIX, I_WIN, I_CONVW, I_CONVB, I_BI, I_BF, I_GMHEAD, I_SINKS, I_WOUT, I_GCROSS, I_GMEM, I_WXQ, I_WXK, I_WXV, I_WXO,
       I_GFFN, I_WPQ, I_SK1, I_SK2, I_EDOWN, I_EUP, I_GFINAL };

typedef __bf16 bf16x2_t __attribute__((ext_vector_type(2)));
typedef float f32x2_t __attribute__((ext_vector_type(2)));
__device__ __forceinline__ unsigned pk2(float lo, float hi) { f32x2_t v = {lo, hi}; bf16x2_t b = __builtin_convertvector(v, bf16x2_t); return __builtin_bit_cast(unsigned, b); }
__device__ __forceinline__ bf16_t f2bf(float f) { return (bf16_t)(pk2(f, 0.f) & 0xffffu); }
__device__ __forceinline__ float bf2f(unsigned b) { return __uint_as_float(b << 16); }
__device__ __forceinline__ float bflo(unsigned w) { return __uint_as_float(w << 16); }
__device__ __forceinline__ float bfhi(unsigned w) { return __uint_as_float(w & 0xffff0000u); }
__device__ __forceinline__ float wave_sum(float v) {
#pragma unroll
    for (int o = 1; o < 64; o <<= 1) v += __shfl_xor(v, o);
    return v;
}
__device__ __forceinline__ float sigmoidf_(float x) { return 1.f / (1.f + __expf(-x)); }
#define LDS_FENCE() asm volatile("s_waitcnt lgkmcnt(0)" ::: "memory")

__device__ __forceinline__ unsigned dppu(unsigned x, int ctrl_sel) {
    switch (ctrl_sel) {
        case 0: return (unsigned)__builtin_amdgcn_update_dpp(0, (int)x, 0xB1, 0xF, 0xF, true);
        case 1: return (unsigned)__builtin_amdgcn_update_dpp(0, (int)x, 0x4E, 0xF, 0xF, true);
        case 2: return (unsigned)__builtin_amdgcn_update_dpp(0, (int)x, 0x141, 0xF, 0xF, true);
        default: return (unsigned)__builtin_amdgcn_update_dpp(0, (int)x, 0x140, 0xF, 0xF, true);
    }
}
__device__ __forceinline__ unsigned row16_max_u32(unsigned x) {
    unsigned y;
    y = dppu(x, 0); x = x > y ? x : y;
    y = dppu(x, 1); x = x > y ? x : y;
    y = dppu(x, 2); x = x > y ? x : y;
    y = dppu(x, 3); x = x > y ? x : y;
    return x;
}
__device__ __forceinline__ float row16_sum_f32(float x) {
    x += __uint_as_float(dppu(__float_as_uint(x), 0));
    x += __uint_as_float(dppu(__float_as_uint(x), 1));
    x += __uint_as_float(dppu(__float_as_uint(x), 2));
    x += __uint_as_float(dppu(__float_as_uint(x), 3));
    return x;
}
__device__ __forceinline__ float row16_max_f32(float x) {
    x = fmaxf(x, __uint_as_float(dppu(__float_as_uint(x), 0)));
    x = fmaxf(x, __uint_as_float(dppu(__float_as_uint(x), 1)));
    x = fmaxf(x, __uint_as_float(dppu(__float_as_uint(x), 2)));
    x = fmaxf(x, __uint_as_float(dppu(__float_as_uint(x), 3)));
    return x;
}
__device__ __forceinline__ f32x4 mfma16(bf16x8 a, bf16x8 b, f32x4 c) { return __builtin_amdgcn_mfma_f32_16x16x32_bf16(a, b, c, 0, 0, 0); }

__device__ __forceinline__ float row_rscale(const float* ssq, int row) {
    float s = 0.f;
#pragma unroll
    for (int p = 0; p < 16; ++p) s += ssq[(size_t)p * MTOK + row];
    return rsqrtf(s * (1.f / D) + EPS);
}
struct EpiRowBf16 {
    static constexpr bool PERM = true, AFTER_DRAIN = false;
    bf16_t* O; int ldc; const float* ssq; float mul;
    __device__ __forceinline__ void operator()(const f32x4 (&acc)[2][2][4][2], const pg8::Unit& u, int wr, int wc, int fr, int fq) const {
        const int row0 = u.pm * 256 + wr * 64 + fr, col0 = u.pn * 256 + wc * 32 + 8 * fq;
#pragma unroll
        for (int ai = 0; ai < 2; ++ai)
#pragma unroll
            for (int m = 0; m < 4; ++m) {
                const int row = row0 + ai * 128 + m * 16;
                const float sc = ssq ? row_rscale(ssq, row) * mul : mul;
                bf16_t* rowp = O + (size_t)row * ldc + col0;
#pragma unroll
                for (int bj = 0; bj < 2; ++bj) {
                    const f32x4 v0 = acc[ai][bj][m][0] * sc, v1 = acc[ai][bj][m][1] * sc;
                    u32x4 w; w.x = pk2(v0[0], v0[1]); w.y = pk2(v0[2], v0[3]); w.z = pk2(v1[0], v1[1]); w.w = pk2(v1[2], v1[3]);
                    *(u32x4*)(rowp + bj * 128) = w;
                }
            }
    }
};
template <bool RES_BF16>
struct EpiResid {
    static constexpr bool PERM = true, AFTER_DRAIN = false;
    const void* R; bf16_t* Hb; float* ssq;
    __device__ __forceinline__ void operator()(const f32x4 (&acc)[2][2][4][2], const pg8::Unit& u, int wr, int wc, int fr, int fq) const {
        const int row0 = u.pm * 256 + wr * 64 + fr, col0 = u.pn * 256 + wc * 32 + 8 * fq;
#pragma unroll
        for (int ai = 0; ai < 2; ++ai)
#pragma unroll
            for (int m = 0; m < 4; ++m) {
                const int row = row0 + ai * 128 + m * 16;
                const size_t off = (size_t)row * D + col0;
                float ss = 0.f;
#pragma unroll
                for (int bj = 0; bj < 2; ++bj) {
                    f32x4 r0, r1;
                    if (RES_BF16) { const u32x4 rb = *(const u32x4*)((const bf16_t*)R + off + bj * 128);
                        r0 = (f32x4){bflo(rb.x), bfhi(rb.x), bflo(rb.y), bfhi(rb.y)}; r1 = (f32x4){bflo(rb.z), bfhi(rb.z), bflo(rb.w), bfhi(rb.w)}; }
                    else { r0 = *(const f32x4*)((const float*)R + off + bj * 128); r1 = *(const f32x4*)((const float*)R + off + bj * 128 + 4); }
                    const f32x4 v0 = acc[ai][bj][m][0] + r0, v1 = acc[ai][bj][m][1] + r1;
                    u32x4 w; w.x = pk2(v0[0], v0[1]); w.y = pk2(v0[2], v0[3]); w.z = pk2(v1[0], v1[1]); w.w = pk2(v1[2], v1[3]);
                    *(u32x4*)(Hb + off + bj * 128) = w;
                    ss += v0[0] * v0[0] + v0[1] * v0[1] + v0[2] * v0[2] + v0[3] * v0[3] + v1[0] * v1[0] + v1[1] * v1[1] + v1[2] * v1[2] + v1[3] * v1[3];
                }
                ss += __shfl_xor(ss, 16); ss += __shfl_xor(ss, 32);
                if (fq == 0) ssq[(size_t)(u.pn * 4 + wc) * MTOK + row] = ss;
            }
    }
};
struct EpiKV {
    static constexpr bool PERM = true, AFTER_DRAIN = false;
    bf16_t* Kh; bf16_t* Vh;
    __device__ __forceinline__ void operator()(const f32x4 (&acc)[2][2][4][2], const pg8::Unit& u, int wr, int wc, int fr, int fq) const {
        const int row0 = u.pm * 256 + wr * 64 + fr, col0 = u.pn * 256 + wc * 32 + 8 * fq;
#pragma unroll
        for (int ai = 0; ai < 2; ++ai)
#pragma unroll
            for (int m = 0; m < 4; ++m) {
                const int row = row0 + ai * 128 + m * 16;
#pragma unroll
                for (int bj = 0; bj < 2; ++bj) {
                    const f32x4 v0 = acc[ai][bj][m][0], v1 = acc[ai][bj][m][1];
                    const int c = col0 + bj * 128, cc = c & 1023;
                    u32x4 w; w.x = pk2(v0[0], v0[1]); w.y = pk2(v0[2], v0[3]); w.z = pk2(v1[0], v1[1]); w.w = pk2(v1[2], v1[3]);
                    *(u32x4*)((c < 1024 ? Kh : Vh) + ((size_t)((row >> 8) * 4 + (cc >> 8)) * 256 + (row & 255)) * 256 + (cc & 255)) = w;
                }
            }
    }
};
struct EpiSoftmax {
    static constexpr bool PERM = true, AFTER_DRAIN = true;
    bf16_t* O; const float* ssq;
    __device__ __forceinline__ void operator()(const f32x4 (&)[2][2][4][2], const pg8::Unit&, int, int, int, int) const {}
    __device__ __forceinline__ void fused(const f32x4 (&acc)[2][2][4][2], const pg8::Unit& u, int wr, int wc, int fr, int fq, LAS unsigned char* lds, int wid, int lane) const {
        LAS float* red = (LAS float*)lds;
        const int row0 = u.pm * 256 + wr * 64 + fr, col0 = u.pn * 256 + wc * 32 + 8 * fq;
        float sc[2][4];
#pragma unroll
        for (int ai = 0; ai < 2; ++ai)
#pragma unroll
            for (int m = 0; m < 4; ++m) {
                sc[ai][m] = row_rscale(ssq, row0 + ai * 128 + m * 16);
                float v = -INFINITY;
#pragma unroll
                for (int bj = 0; bj < 2; ++bj)
#pragma unroll
                    for (int n = 0; n < 2; ++n)
#pragma unroll
                        for (int j = 0; j < 4; ++j) v = fmaxf(v, acc[ai][bj][m][n][j] * sc[ai][m]);
                v = fmaxf(v, __shfl_xor(v, 16)); v = fmaxf(v, __shfl_xor(v, 32));
                if (fq == 0) red[wc * 256 + ai * 128 + wr * 64 + m * 16 + fr] = v;
            }
        __syncthreads();
        float rsum[2][4], rmax[2][4];
#pragma unroll
        for (int ai = 0; ai < 2; ++ai)
#pragma unroll
            for (int m = 0; m < 4; ++m) {
                const int rl = ai * 128 + wr * 64 + m * 16 + fr;
                rmax[ai][m] = fmaxf(fmaxf(red[rl], red[256 + rl]), fmaxf(red[512 + rl], red[768 + rl]));
                float s = 0.f;
#pragma unroll
                for (int bj = 0; bj < 2; ++bj)
#pragma unroll
                    for (int n = 0; n < 2; ++n)
#pragma unroll
                        for (int j = 0; j < 4; ++j) s += __expf(acc[ai][bj][m][n][j] * sc[ai][m] - rmax[ai][m]);
                s += __shfl_xor(s, 16); s += __shfl_xor(s, 32);
                if (fq == 0) red[1024 + wc * 256 + rl] = s;
            }
        __syncthreads();
#pragma unroll
        for (int ai = 0; ai < 2; ++ai)
#pragma unroll
            for (int m = 0; m < 4; ++m) {
                const int rl = ai * 128 + wr * 64 + m * 16 + fr;
                const float inv = 1.f / ((red[1024 + rl] + red[1280 + rl]) + (red[1536 + rl] + red[1792 + rl]));
                rsum[ai][m] = inv;
                bf16_t* rowp = O + (size_t)(row0 + ai * 128 + m * 16) * D + col0;
#pragma unroll
                for (int bj = 0; bj < 2; ++bj) {
                    float e[2][4];
#pragma unroll
                    for (int n = 0; n < 2; ++n)
#pragma unroll
                        for (int j = 0; j < 4; ++j) e[n][j] = __expf(acc[ai][bj][m][n][j] * sc[ai][m] - rmax[ai][m]) * inv;
                    u32x4 w; w.x = pk2(e[0][0], e[0][1]); w.y = pk2(e[0][2], e[0][3]); w.z = pk2(e[1][0], e[1][1]); w.w = pk2(e[1][2], e[1][3]);
                    *(u32x4*)(rowp + bj * 128) = w;
                }
            }
        __syncthreads();
    }
};

__device__ __forceinline__ void p0_transpose_item(const float* W, int ldw, int col0, int K, bf16_t* WT, int row0, const float* g, LAS float* scr, int item, int nblk, int lane) {
    const int kb = item / nblk, nb = item % nblk, k0 = 64 * kb, n0 = 32 * nb;
    float tv[32];
#pragma unroll
    for (int i = 0; i < 32; ++i) tv[i] = W[(size_t)(k0 + 2 * i + (lane >> 5)) * ldw + col0 + n0 + (lane & 31)];
#pragma unroll
    for (int i = 0; i < 32; ++i) {
        const int kk = 2 * i + (lane >> 5);
        float v = tv[i];
        if (g) v *= g[k0 + kk];
        scr[kk * 33 + (lane & 31)] = v;
    }
    LDS_FENCE();
    const int c = lane & 7;
#pragma unroll
    for (int j = 0; j < 4; ++j) {
        const int n = (lane >> 3) + 8 * j; const LAS float* s = scr + (8 * c) * 33 + n;
        u32x4 o; o.x = pk2(s[0 * 33], s[1 * 33]); o.y = pk2(s[2 * 33], s[3 * 33]); o.z = pk2(s[4 * 33], s[5 * 33]); o.w = pk2(s[6 * 33], s[7 * 33]);
        *(u32x4*)(WT + (size_t)(row0 + n0 + n) * K + k0 + 8 * c) = o;
    }
    LDS_FENCE();
}
__device__ __forceinline__ void rms_row_load(const float* xrow, int lane, f32x4 (&v)[4]) {
    const f32x4* xr = (const f32x4*)xrow + lane;
#pragma unroll
    for (int j = 0; j < 4; ++j) v[j] = xr[64 * j];
}
__device__ __forceinline__ void rms_row_finish(const float* g, bf16_t* orow, int lane, f32x4 (&v)[4]) {
    float s = 0.f;
#pragma unroll
    for (int j = 0; j < 4; ++j) s += (v[j][0] * v[j][0] + v[j][1] * v[j][1]) + (v[j][2] * v[j][2] + v[j][3] * v[j][3]);
    const float r = rsqrtf(wave_sum(s) * (1.f / D) + EPS);
    unsigned long long* o8 = (unsigned long long*)orow + lane;
#pragma unroll
    for (int j = 0; j < 4; ++j) {
        const f32x4 gv = ((const f32x4*)g)[lane + 64 * j];
        v[j] = v[j] * r * gv;
        o8[64 * j] = (unsigned long long)pk2(v[j][0], v[j][1]) | ((unsigned long long)pk2(v[j][2], v[j][3]) << 32);
    }
}
__device__ __forceinline__ void p0_late_transposes(const Args& a, LAS unsigned char* lds) {
    const int tid = threadIdx.x, lane = tid & 63, wave = tid >> 6;
    if (wave < 5) return;
    const int G = gridDim.x, gw = blockIdx.x * 3 + (wave - 5), NGW = G * 3;
    unsigned char* ws = a.ws;
    LAS float* scr = (LAS float*)(lds + wave * 8704);
    constexpr int I_SQ = 16 * 32, I_HD = 4 * 32;
    constexpr int NITEMS = I_SQ + 4 * I_HD;
    for (int it = gw; it < NITEMS; it += NGW) {
        int r = it;
        if (r < I_SQ) { p0_transpose_item(a.in[I_WOUT], D, 0, D, (bf16_t*)(ws + WS_WOUT), 0, nullptr, scr, r, 32, lane); continue; } r -= I_SQ;
        { const int h = r / I_HD; p0_transpose_item(a.in[I_WXO] + (size_t)h * 256 * D, D, 0, 256, (bf16_t*)(ws + WS_WXO) + (size_t)h * 1024 * 256, 0, nullptr, scr, r % I_HD, 32, lane); }
    }
    {
        const float* wp = a.in[I_WPQ]; const float* gf = a.in[I_GFFN];
        bf16_t* wgr = (bf16_t*)(ws + WS_WGR);
        for (int i = (blockIdx.x * 3 + (wave - 5)) * 64 + lane; i < 1024 * 256; i += G * 3 * 64) {
            const int k = i >> 8, c8 = (i & 255) * 8;
            const float gk = gf[k];
            const f32x4 v0 = *(const f32x4*)(wp + (size_t)k * 2048 + c8) * gk, v1 = *(const f32x4*)(wp + (size_t)k * 2048 + c8 + 4) * gk;
            u32x4 w; w.x = pk2(v0[0], v0[1]); w.y = pk2(v0[2], v0[3]); w.z = pk2(v1[0], v1[1]); w.w = pk2(v1[2], v1[3]);
            *(u32x4*)(wgr + (size_t)k * 2048 + c8) = w;
        }
    }
    const float* wq = a.in[I_WXQ]; const float* gc = a.in[I_GCROSS];
    bf16_t* wqr = (bf16_t*)(ws + WS_WXQ);
    for (int i = (blockIdx.x * 3 + (wave - 5)) * 64 + lane; i < 1024 * 128; i += G * 3 * 64) {
        const int k = i >> 7, c8 = (i & 127) * 8, h = c8 >> 8, dh = c8 & 255;
        const float gk = gc[k] * 0.0625f;
        const f32x4 v0 = *(const f32x4*)(wq + (size_t)k * D + c8) * gk, v1 = *(const f32x4*)(wq + (size_t)k * D + c8 + 4) * gk;
        u32x4 w; w.x = pk2(v0[0], v0[1]); w.y = pk2(v0[2], v0[3]); w.z = pk2(v1[0], v1[1]); w.w = pk2(v1[2], v1[3]);
        *(u32x4*)(wqr + ((size_t)h * 1024 + k) * 256 + dh) = w;
    }
}
__device__ __forceinline__ void p0_experts(const Args& a, int part, int npart) {
    const int tid = threadIdx.x, lane = tid & 63, wave = tid >> 6;
    const int gw = part * NWAVES + wave, NGW = npart * NWAVES;
    unsigned char* ws = a.ws;
    {
        const float* gf = a.in[I_GFFN];
        float* esc = (float*)(ws + WS_ESC);
        f32x4 gv[4];
#pragma unroll
        for (int j = 0; j < 4; ++j) gv[j] = *(const f32x4*)(gf + 4 * lane + 256 * j);
        for (int r0 = 4 * gw; r0 < 2 * 16384; r0 += 4 * NGW) {
            f32x4 v[4][4];
#pragma unroll
            for (int q = 0; q < 4; ++q) {
                const int r = r0 + q; const bool up = r >= 16384; const int e = up ? r - 16384 : r;
                const float* src = (up ? a.in[I_EUP] : a.in[I_EDOWN]) + (size_t)e * D + 4 * lane;
#pragma unroll
                for (int j = 0; j < 4; ++j) v[q][j] = __builtin_nontemporal_load((const f32x4*)(src + 256 * j));
            }
#pragma unroll
            for (int q = 0; q < 4; ++q) {
                const int r = r0 + q; const bool up = r >= 16384; const int e = up ? r - 16384 : r;
                float am = 0.f;
#pragma unroll
                for (int j = 0; j < 4; ++j) { if (!up) v[q][j] = v[q][j] * gv[j];
                    am = fmaxf(am, fmaxf(fmaxf(fabsf(v[q][j][0]), fabsf(v[q][j][1])), fmaxf(fabsf(v[q][j][2]), fabsf(v[q][j][3])))); }
                am = row16_max_f32(am); am = fmaxf(am, __shfl_xor(am, 16)); am = fmaxf(am, __shfl_xor(am, 32));
                const float sc = am > 0.f ? am * (1.f / 127.f) : 1.f, inv = 1.f / sc;
                unsigned char* dstp = ws + (up ? WS_EU : WS_ED) + (size_t)(lane >> 5) * (16384 * 128) + (size_t)e * 128 + 4 * (lane & 31);
                const size_t jstep = (size_t)2 * 16384 * 128;
#pragma unroll
                for (int j = 0; j < 4; ++j) {
                    const int q0 = (int)rintf(v[q][j][0] * inv), q1 = (int)rintf(v[q][j][1] * inv), q2 = (int)rintf(v[q][j][2] * inv), q3 = (int)rintf(v[q][j][3] * inv);
                    *(unsigned*)(dstp + jstep * j) = (unsigned)(q0 & 255) | ((unsigned)(q1 & 255) << 8) | ((unsigned)(q2 & 255) << 16) | ((unsigned)q3 << 24);
                }
                if (lane == 0) esc[r] = sc;
            }
        }
    }
}
__device__ __forceinline__ void phase0(const Args& a, LAS unsigned char* lds) {
    const int tid = threadIdx.x, lane = tid & 63, wave = tid >> 6;
    const int G = gridDim.x, gw = blockIdx.x * NWAVES + wave, NGW = G * NWAVES;
    unsigned char* ws = a.ws;
    LAS float* scr = (LAS float*)(lds + wave * 8704);
    {
        constexpr int I_W1 = 16 * 48, I_W2 = 16 * 24, I_SQ = 16 * 32;
        constexpr int NITEMS = I_W1 + I_W2 + 2 * I_SQ;
        for (int it = gw; it < NITEMS; it += NGW) {
            int r = it;
            if (r < I_W1) { p0_transpose_item(a.in[I_WIN], 2312, 0, D, (bf16_t*)(ws + WS_WIN), 0, nullptr, scr, r, 48, lane); continue; } r -= I_W1;
            if (r < I_W2) { p0_transpose_item(a.in[I_WIN], 2312, 1544, D, (bf16_t*)(ws + WS_WIN), 1536, nullptr, scr, r, 24, lane); continue; } r -= I_W2;
            if (r < I_SQ) { p0_transpose_item(a.in[I_WXK], D, 0, D, (bf16_t*)(ws + WS_WXKV), 0, nullptr, scr, r, 32, lane); continue; } r -= I_SQ;
            p0_transpose_item(a.in[I_WXV], D, 0, D, (bf16_t*)(ws + WS_WXKV), 1024, nullptr, scr, r, 32, lane);
        }
    }
    {
        const size_t T = (size_t)G * NTHREADS, gt = (size_t)blockIdx.x * NTHREADS + tid;
        for (size_t i = gt; i < 2 * 16384 / 8; i += T) {
            const bool s2 = i >= 2048; const size_t j = s2 ? i - 2048 : i;
            const float* src = (s2 ? a.in[I_SK2] : a.in[I_SK1]) + j * 8;
            const f32x4 v0 = *(const f32x4*)src, v1 = *(const f32x4*)(src + 4);
            u32x4 w; w.x = pk2(v0[0], v0[1]); w.y = pk2(v0[2], v0[3]); w.z = pk2(v1[0], v1[1]); w.w = pk2(v1[2], v1[3]);
            *(u32x4*)((bf16_t*)(ws + WS_SK) + (s2 ? 16384 : 0) + j * 8) = w;
        }
    }
    {
        const float* win = a.in[I_WIN];
        float* gates = (float*)(ws + WS_GATES);
        const float* bi = a.in[I_BI]; const float* bfg = a.in[I_BF];
        LAS f32x4* wg = (LAS f32x4*)(lds + 8 * 8704);
        __syncthreads();
        for (int i = tid; i < 2048; i += NTHREADS) {
            const int ln = i & 63, e = (i >> 6) & 3, j = (i >> 8) & 3, half = i >> 10;
            wg[i] = *(const f32x4*)(win + (size_t)(4 * ln + 256 * j + e) * 2312 + 1536 + 4 * half);
        }
        __syncthreads();
        for (int rowp = 2 * gw; rowp < MTOK; rowp += 2 * NGW) {
          f32x4 vv[2][4];
          rms_row_load(a.in[I_X] + (size_t)rowp * D, lane, vv[0]); rms_row_load(a.in[I_X] + (size_t)(rowp + 1) * D, lane, vv[1]);
#pragma unroll
          for (int q = 0; q < 2; ++q) {
            const int row = rowp + q;
            f32x4 (&v)[4] = vv[q];
            rms_row_finish(a.in[I_GMIX], (bf16_t*)(ws + WS_B) + (size_t)row * D, lane, v);
            f32x4 g0 = {0.f, 0.f, 0.f, 0.f}, g1 = {0.f, 0.f, 0.f, 0.f};
#pragma unroll
            for (int j = 0; j < 4; ++j)
#pragma unroll
                for (int e = 0; e < 4; ++e) { const float xv = v[j][e]; g0 += xv * wg[(j * 4 + e) * 64 + lane]; g1 += xv * wg[1024 + (j * 4 + e) * 64 + lane]; }
            const bool b5 = lane & 32, b4 = lane & 16, b3 = lane & 8;
            f32x4 k4, s4;
#pragma unroll
            for (int i = 0; i < 4; ++i) { k4[i] = b5 ? g1[i] : g0[i]; s4[i] = b5 ? g0[i] : g1[i]; }
#pragma unroll
            for (int i = 0; i < 4; ++i) k4[i] += __shfl_xor(s4[i], 32);
            float k2a = b4 ? k4[2] : k4[0], k2b = b4 ? k4[3] : k4[1];
            k2a += __shfl_xor(b4 ? k4[0] : k4[2], 16); k2b += __shfl_xor(b4 ? k4[1] : k4[3], 16);
            float k1 = (b3 ? k2b : k2a) + __shfl_xor(b3 ? k2a : k2b, 8);
            k1 += __uint_as_float(dppu(__float_as_uint(k1), 0)); k1 += __uint_as_float(dppu(__float_as_uint(k1), 1)); k1 += __uint_as_float(dppu(__float_as_uint(k1), 2));
            if ((lane & 7) == 0) {
                const int c = lane >> 3;
                float val = k1;
                if (c < 4) val += bi[c];
                else { const float f = val + bfg[c - 4]; val = fminf(f, 0.f) - log1pf(__expf(-fabsf(f))); }
                gates[(size_t)row * 8 + c] = val;
            }
          }
        }
    }
    for (int row = gw; row < NB * MEMLEN; row += NGW) {
        f32x4 v[4];
        rms_row_load(a.in[I_MEM] + (size_t)row * D, lane, v);
        rms_row_finish(a.in[I_GMEM], (bf16_t*)(ws + WS_C) + (size_t)row * D, lane, v);
    }
}

constexpr int LQ = 72;
__device__ __forceinline__ void conv8_load(const bf16_t* src, int tok_in_seq, u32x4 (&xv)[4]) {
#pragma unroll
    for (int j = 0; j < 4; ++j) { const int d = (tok_in_seq - 3 + j >= 0) ? j - 3 : 0; xv[j] = *(const u32x4*)(src + (ptrdiff_t)d * NPROJ); }
}
__device__ __forceinline__ void conv8_finish(const u32x4 (&xv)[4], int tok_in_seq, const float* cw, const float* cb, int ch, float (&y)[8]) {
#pragma unroll
    for (int e = 0; e < 8; ++e) y[e] = cb[ch + e];
#pragma unroll
    for (int j = 0; j < 4; ++j) {
        const float m = (tok_in_seq - 3 + j >= 0) ? 1.f : 0.f;
        const f32x4 w0 = *(const f32x4*)(cw + j * 512 + ch) * m, w1 = *(const f32x4*)(cw + j * 512 + ch + 4) * m;
        y[0] += w0[0] * bflo(xv[j].x); y[1] += w0[1] * bfhi(xv[j].x); y[2] += w0[2] * bflo(xv[j].y); y[3] += w0[3] * bfhi(xv[j].y);
        y[4] += w1[0] * bflo(xv[j].z); y[5] += w1[1] * bfhi(xv[j].z); y[6] += w1[2] * bflo(xv[j].w); y[7] += w1[3] * bfhi(xv[j].w);
    }
#pragma unroll
    for (int e = 0; e < 8; ++e) y[e] = y[e] * sigmoidf_(y[e]);
}
__device__ __forceinline__ void conv8(const bf16_t* src, int tok_in_seq, const float* cw, const float* cb, int ch, float (&y)[8]) {
    u32x4 xv[4]; conv8_load(src, tok_in_seq, xv); conv8_finish(xv, tok_in_seq, cw, cb, ch, y);
}
__device__ __forceinline__ float chunk_cumsum(float lf, int lane) {
    float b = lf;
#pragma unroll
    for (int o = 1; o < 64; o <<= 1) { const float t = __shfl_up(b, o); if (lane >= o) b += t; }
    return b;
}

__device__ __forceinline__ void mlstm_local(const Args& a, LAS unsigned char* lds, int task) {
    const int tid = threadIdx.x, lane = tid & 63, wave = tid >> 6;
    const int b = task >> 9, h = (task >> 7) & 3, c = task & 127;
    const int row0 = b * SEQ + c * 64;
    const bf16_t* proj = (const bf16_t*)(a.ws + WS_A);
    const float* gates = (const float*)(a.ws + WS_GATES);
    LAS bf16_t* VTw = (LAS bf16_t*)lds;
    LAS bf16_t* KT = (LAS bf16_t*)(lds + 144 * LQ * 2);
    LAS float* wS = (LAS float*)(lds + 144 * LQ * 2 + 64 * LQ * 2);
    if (wave == 0) {
        const float ig = gates[(size_t)(row0 + lane) * 8 + h], lf = gates[(size_t)(row0 + lane) * 8 + 4 + h];
        const float bs = chunk_cumsum(lf, lane);
        const float bL = __shfl(bs, 63);
        wS[lane] = __expf(bL - bs + ig);
        if (lane == 63) ((float*)(a.ws + WS_DECAY))[task] = __expf(bL);
    }
    {
        const int s = tid >> 3, cg = (tid & 7) * 8;
        float y[8];
        conv8(proj + (size_t)(row0 + s) * NPROJ + C_MK + h * 64 + cg, c * 64 + s, a.in[I_CONVW], a.in[I_CONVB], 256 + h * 64 + cg, y);
#pragma unroll
        for (int e = 0; e < 8; ++e) KT[(cg + e) * LQ + s] = f2bf(y[e]);
    }
    __syncthreads();
    {
        const int s = tid >> 3, vg = (tid & 7) * 16;
        const float w = wS[s];
        const u32x4 x0 = *(const u32x4*)(proj + (size_t)(row0 + s) * NPROJ + C_MV + h * 128 + vg), x1 = *(const u32x4*)(proj + (size_t)(row0 + s) * NPROJ + C_MV + h * 128 + vg + 8);
        const unsigned xs[8] = {x0.x, x0.y, x0.z, x0.w, x1.x, x1.y, x1.z, x1.w};
#pragma unroll
        for (int e = 0; e < 8; ++e) { VTw[(vg + 2 * e) * LQ + s] = f2bf(w * bflo(xs[e])); VTw[(vg + 2 * e + 1) * LQ + s] = f2bf(w * bfhi(xs[e])); }
        if ((tid & 7) == 0) VTw[128 * LQ + s] = f2bf(w);
        for (int i = tid; i < 15 * 64; i += NTHREADS) VTw[(129 + (i >> 6)) * LQ + (i & 63)] = 0;
    }
    __syncthreads();
    float* dC = (float*)(a.ws + WS_B) + (size_t)task * 8192;
    float* dn = (float*)(a.ws + WS_DN) + (size_t)task * 64;
    for (int T = wave; T < 36; T += 8) {
        const int mt = T >> 2, nt = T & 3;
        f32x4 acc = {0.f, 0.f, 0.f, 0.f};
#pragma unroll
        for (int ks = 0; ks < 2; ++ks) {
            const bf16x8 av = *(const LAS bf16x8*)(VTw + (mt * 16 + (lane & 15)) * LQ + ks * 32 + 8 * (lane >> 4));
            const bf16x8 bv = *(const LAS bf16x8*)(KT + (nt * 16 + (lane & 15)) * LQ + ks * 32 + 8 * (lane >> 4));
            acc = mfma16(av, bv, acc);
        }
        const int col = nt * 16 + (lane & 15);
        if (mt < 8) {
#pragma unroll
            for (int r = 0; r < 4; ++r) dC[(mt * 16 + (lane >> 4) * 4 + r) * 64 + col] = acc[r];
        } else if ((lane >> 4) == 0) dn[col] = acc[0];
    }
    __syncthreads();
}

__device__ __forceinline__ void mlstm_scan(const Args& a) {
    const size_t T = (size_t)gridDim.x * NTHREADS;
    const float* decay = (const float*)(a.ws + WS_DECAY);
    for (size_t chain = ((size_t)(threadIdx.x >> 6) * gridDim.x + blockIdx.x) * 64 + (threadIdx.x & 63); chain < 8 * 8256; chain += T) {
        const int bh = (int)(chain / 8256), e = (int)(chain % 8256);
        float* p; size_t stride; bf16_t* pst = nullptr;
        if (e < 8192) { p = (float*)(a.ws + WS_B) + (size_t)bh * 128 * 8192 + e; stride = 8192; pst = (bf16_t*)(a.ws + WS_ST) + (size_t)bh * 128 * 8192 + e; }
        else { p = (float*)(a.ws + WS_DN) + (size_t)bh * 128 * 64 + (e - 8192); stride = 64; }
        float C = 0.f;
        for (int c0 = 0; c0 < 128; c0 += 32) {
            float t[32], dk[32];
#pragma unroll
            for (int j = 0; j < 32; ++j) { t[j] = p[(size_t)(c0 + j) * stride]; dk[j] = decay[bh * 128 + c0 + j]; }
#pragma unroll
            for (int j = 0; j < 32; ++j) {
                if (pst) pst[(size_t)(c0 + j) * 8192] = f2bf(C); else p[(size_t)(c0 + j) * stride] = C;
                C = dk[j] * C + t[j];
            }
        }
    }
}

__device__ __forceinline__ void mlstm_out(const Args& a, LAS unsigned char* lds, int task) {
    const int tid = threadIdx.x, lane = tid & 63, wave = tid >> 6;
    const int b = task >> 9, h = (task >> 7) & 3, c = task & 127;
    const int row0 = b * SEQ + c * 64;
    const bf16_t* proj = (const bf16_t*)(a.ws + WS_A);
    const float* gates = (const float*)(a.ws + WS_GATES);
    LAS bf16_t* Qs = (LAS bf16_t*)lds;
    LAS bf16_t* Ks = Qs + 64 * LQ;
    LAS bf16_t* Qp = Ks + 64 * LQ;
    LAS bf16_t* Ps = Qp + 64 * LQ;
    LAS bf16_t* VT = Ps + 64 * LQ;
    LAS bf16_t* Cs = VT + 144 * LQ;
    LAS float* bS = (LAS float*)(Cs + 144 * LQ);
    LAS float* iS = bS + 64;
    LAS float* denS = iS + 64;
    LAS float* ssqS = denS + 64;
    const float ig_l = gates[(size_t)(row0 + lane) * 8 + h], lf_l = gates[(size_t)(row0 + lane) * 8 + 4 + h];
    const float b_l = chunk_cumsum(lf_l, lane);
    if (wave == 0) { bS[lane] = b_l; iS[lane] = ig_l; }
    const float eb_s = __expf(__shfl(b_l, tid >> 3));
    u32x4 qtap[4];
    conv8_load(proj + (size_t)(row0 + (tid >> 3)) * NPROJ + C_MQ + h * 64 + (tid & 7) * 8, c * 64 + (tid >> 3), qtap);
    bf16_t mo_pre[4][4];
#pragma unroll
    for (int r = 0; r < 4; ++r)
#pragma unroll
        for (int i = 0; i < 4; ++i)
            mo_pre[r][i] = proj[(size_t)(row0 + (wave & 3) * 16 + (lane >> 4) * 4 + r) * NPROJ + C_MO + h * 128 + ((wave >> 2) * 4 + i) * 16 + (lane & 15)];
    {
        const int s = tid >> 3, cg = (tid & 7) * 8;
        float y[8];
        conv8(proj + (size_t)(row0 + s) * NPROJ + C_MK + h * 64 + cg, c * 64 + s, a.in[I_CONVW], a.in[I_CONVB], 256 + h * 64 + cg, y);
        u32x4 w; w.x = pk2(y[0], y[1]); w.y = pk2(y[2], y[3]); w.z = pk2(y[4], y[5]); w.w = pk2(y[6], y[7]);
        *(LAS u32x4*)(Ks + s * LQ + cg) = w;
        const int vg = (tid & 7) * 16;
        const u32x4 x0 = *(const u32x4*)(proj + (size_t)(row0 + s) * NPROJ + C_MV + h * 128 + vg), x1 = *(const u32x4*)(proj + (size_t)(row0 + s) * NPROJ + C_MV + h * 128 + vg + 8);
        const unsigned xs[8] = {x0.x, x0.y, x0.z, x0.w, x1.x, x1.y, x1.z, x1.w};
#pragma unroll
        for (int e = 0; e < 8; ++e) { VT[(vg + 2 * e) * LQ + s] = (bf16_t)(xs[e] & 0xffffu); VT[(vg + 2 * e + 1) * LQ + s] = (bf16_t)(xs[e] >> 16); }
        if ((tid & 7) == 0) VT[128 * LQ + s] = 0x3F80;
        for (int i = tid; i < 15 * 64; i += NTHREADS) { VT[(129 + (i >> 6)) * LQ + (i & 63)] = 0; Cs[(129 + (i >> 6)) * LQ + (i & 63)] = 0; }
        const bf16_t* st = (const bf16_t*)(a.ws + WS_ST) + (size_t)task * 8192;
        const int v = tid >> 2, k0 = (tid & 3) * 16;
        *(LAS u32x4*)(Cs + v * LQ + k0) = *(const u32x4*)(st + v * 64 + k0);
        *(LAS u32x4*)(Cs + v * LQ + k0 + 8) = *(const u32x4*)(st + v * 64 + k0 + 8);
        if (tid < 64) Cs[128 * LQ + tid] = f2bf(((const float*)(a.ws + WS_DN))[(size_t)task * 64 + tid]);
    }
    {
        const int s = tid >> 3, cg = (tid & 7) * 8;
        float y[8];
        conv8_finish(qtap, c * 64 + s, a.in[I_CONVW], a.in[I_CONVB], h * 64 + cg, y);
        const float eb = eb_s;
#pragma unroll
        for (int e = 0; e < 8; ++e) y[e] *= 0.125f;
        u32x4 w; w.x = pk2(y[0], y[1]); w.y = pk2(y[2], y[3]); w.z = pk2(y[4], y[5]); w.w = pk2(y[6], y[7]);
        *(LAS u32x4*)(Qs + s * LQ + cg) = w;
        w.x = pk2(y[0] * eb, y[1] * eb); w.y = pk2(y[2] * eb, y[3] * eb); w.z = pk2(y[4] * eb, y[5] * eb); w.w = pk2(y[6] * eb, y[7] * eb);
        *(LAS u32x4*)(Qp + s * LQ + cg) = w;
    }
    __syncthreads();
    {
        const int mt = wave >> 1;
#pragma unroll
        for (int i = 0; i < 2; ++i) {
            const int nt = (wave & 1) * 2 + i;
            f32x4 acc = {0.f, 0.f, 0.f, 0.f};
#pragma unroll
            for (int ks = 0; ks < 2; ++ks) {
                const bf16x8 av = *(const LAS bf16x8*)(Qs + (mt * 16 + (lane & 15)) * LQ + ks * 32 + 8 * (lane >> 4));
                const bf16x8 bv = *(const LAS bf16x8*)(Ks + (nt * 16 + (lane & 15)) * LQ + ks * 32 + 8 * (lane >> 4));
                acc = mfma16(av, bv, acc);
            }
            const int s = nt * 16 + (lane & 15);
            const float bs = bS[s], is = iS[s];
#pragma unroll
            for (int r = 0; r < 4; ++r) {
                const int t = mt * 16 + (lane >> 4) * 4 + r;
                const float p = (s <= t) ? acc[r] * __expf(bS[t] - bs + is) : 0.f;
                Ps[t * LQ + s] = f2bf(p);
            }
        }
    }
    __syncthreads();
    const int mt = wave & 3, ng = wave >> 2;
    f32x4 acc[5];
#pragma unroll
    for (int i = 0; i < 5; ++i) acc[i] = (f32x4){0.f, 0.f, 0.f, 0.f};
#pragma unroll
    for (int ks = 0; ks < 4; ++ks) {
        const LAS bf16_t* Ab = (ks < 2) ? Ps : Qp; const LAS bf16_t* Bb = (ks < 2) ? VT : Cs;
        const int ko = (ks & 1) * 32 + 8 * (lane >> 4);
        const bf16x8 av = *(const LAS bf16x8*)(Ab + (mt * 16 + (lane & 15)) * LQ + ko);
#pragma unroll
        for (int i = 0; i < 4; ++i) {
            const bf16x8 bv = *(const LAS bf16x8*)(Bb + ((ng * 4 + i) * 16 + (lane & 15)) * LQ + ko);
            acc[i] = mfma16(av, bv, acc[i]);
        }
        {
            const bf16x8 bv = *(const LAS bf16x8*)(Bb + (128 + (lane & 15)) * LQ + ko);
            acc[4] = mfma16(av, bv, acc[4]);
        }
    }
    float rinv[4];
#pragma unroll
    for (int r = 0; r < 4; ++r) {
        const float den = __uint_as_float((unsigned)__builtin_amdgcn_ds_bpermute((lane & 48) * 4, (int)__float_as_uint(acc[4][r])));
        rinv[r] = 1.f / fmaxf(fabsf(den), 1.f);
        float ss = 0.f;
#pragma unroll
        for (int i = 0; i < 4; ++i) { acc[i][r] *= rinv[r]; ss += acc[i][r] * acc[i][r]; }
        ss = row16_sum_f32(ss);
        if ((lane & 15) == 0) ssqS[ng * 64 + mt * 16 + (lane >> 4) * 4 + r] = ss;
    }
    __syncthreads();
    bf16_t* mix = (bf16_t*)(a.ws + WS_C);
    const float* gmh = a.in[I_GMHEAD];
#pragma unroll
    for (int r = 0; r < 4; ++r) {
        const int t = mt * 16 + (lane >> 4) * 4 + r;
        const float rn = rsqrtf((ssqS[t] + ssqS[64 + t]) * (1.f / 128.f) + EPS);
#pragma unroll
        for (int i = 0; i < 4; ++i) {
            const int v = (ng * 4 + i) * 16 + (lane & 15);
            const float mo = bf2f(mo_pre[r][i]);
            mix[(size_t)(row0 + t) * D + h * 128 + v] = f2bf(acc[i][r] * rn * gmh[h * 128 + v] * sigmoidf_(mo));
        }
    }
    __syncthreads();
}

constexpr int LV = 264;
__device__ __forceinline__ void swa_task(const Args& a, LAS unsigned char* lds, int task) {
    const int tid = threadIdx.x, lane = tid & 63, wave = tid >> 6;
    const int b = task >> 7, kvh = (task >> 6) & 1, blk = task & 63, qh = kvh * 4 + (wave >> 1);
    const int rowq0 = b * SEQ + blk * 128;
    const bf16_t* proj = (const bf16_t*)(a.ws + WS_A);
    LAS bf16_t* Ksm = (LAS bf16_t*)lds;
    LAS bf16_t* VTs = Ksm + 256 * LQ;
    {
        const int j = tid >> 1, half = tid & 1;
        const bool ex = (blk > 0) || (j >= 128);
        u32x4 kv[4], vv[4];
#pragma unroll
        for (int i = 0; i < 4; ++i) { kv[i] = (u32x4){0u, 0u, 0u, 0u}; vv[i] = (u32x4){0u, 0u, 0u, 0u}; }
        if (ex) {
            const bf16_t* kp = proj + (size_t)(rowq0 - 128 + j) * NPROJ + C_AK + kvh * 64 + half * 32;
            const bf16_t* vp = proj + (size_t)(rowq0 - 128 + j) * NPROJ + C_AV + kvh * 64 + half * 32;
#pragma unroll
            for (int i = 0; i < 4; ++i) { kv[i] = *(const u32x4*)(kp + 8 * i); vv[i] = *(const u32x4*)(vp + 8 * i); }
        }
#pragma unroll
        for (int i = 0; i < 4; ++i) {
            *(LAS u32x4*)(Ksm + j * LQ + half * 32 + 8 * i) = kv[i];
            const unsigned xs[4] = {vv[i].x, vv[i].y, vv[i].z, vv[i].w};
#pragma unroll
            for (int e = 0; e < 4; ++e) { VTs[(half * 32 + 8 * i + 2 * e) * LV + j] = (bf16_t)(xs[e] & 0xffffu); VTs[(half * 32 + 8 * i + 2 * e + 1) * LV + j] = (bf16_t)(xs[e] >> 16); }
        }
    }
    __syncthreads();
#pragma unroll 1
    for (int qk = 0; qk < 4; ++qk) {
    const int qtile = (wave & 1) * 4 + qk;
    const int qi = 16 * qtile + (lane & 15);
    bf16x8 qf[2];
#pragma unroll
    for (int ks = 0; ks < 2; ++ks) qf[ks] = *(const bf16x8*)(proj + (size_t)(rowq0 + qi) * NPROJ + C_AQ + qh * 64 + ks * 32 + 8 * (lane >> 4));
    f32x4 sc[10];
    const float sink = a.in[I_SINKS][qh];
    float mx = sink;
#pragma unroll
    for (int t = 0; t < 9; ++t) {
        const int kt = qtile + t;
        f32x4 acc = {0.f, 0.f, 0.f, 0.f};
#pragma unroll
        for (int ks = 0; ks < 2; ++ks) {
            const bf16x8 kf = *(const LAS bf16x8*)(Ksm + (kt * 16 + (lane & 15)) * LQ + ks * 32 + 8 * (lane >> 4));
            acc = mfma16(kf, qf[ks], acc);
        }
#pragma unroll
        for (int r = 0; r < 4; ++r) {
            const int j = kt * 16 + (lane >> 4) * 4 + r;
            const bool valid = (j >= qi + 1) && (j <= qi + 128) && (blk > 0 || j >= 128);
            acc[r] = valid ? acc[r] * 0.125f : -INFINITY;
            mx = fmaxf(mx, acc[r]);
        }
        sc[t] = acc;
    }
    mx = fmaxf(mx, __shfl_xor(mx, 16)); mx = fmaxf(mx, __shfl_xor(mx, 32));
    float sum = 0.f;
#pragma unroll
    for (int t = 0; t < 9; ++t)
#pragma unroll
        for (int r = 0; r < 4; ++r) { const float p = __expf(sc[t][r] - mx); sc[t][r] = p; sum += p; }
    sum += __shfl_xor(sum, 16); sum += __shfl_xor(sum, 32);
    const float inv = 1.f / (sum + __expf(sink - mx));
    sc[9] = (f32x4){0.f, 0.f, 0.f, 0.f};
    bf16x8 pf[5];
#pragma unroll
    for (int p = 0; p < 5; ++p) {
        const f32x4 x0 = sc[2 * p] * inv, x1 = sc[2 * p + 1] * inv;
        u32x4 w; w.x = pk2(x0[0], x0[1]); w.y = pk2(x0[2], x0[3]); w.z = pk2(x1[0], x1[1]); w.w = pk2(x1[2], x1[3]);
        pf[p] = __builtin_bit_cast(bf16x8, w);
    }
    bf16_t* mix = (bf16_t*)(a.ws + WS_C);
#pragma unroll
    for (int dt = 0; dt < 4; ++dt) {
        f32x4 acc = {0.f, 0.f, 0.f, 0.f};
#pragma unroll
        for (int p = 0; p < 5; ++p) {
            const int k0 = qtile + 2 * p, k1 = (k0 + 1 > 15) ? 15 : k0 + 1;
            const LAS bf16_t* vr = VTs + (dt * 16 + (lane & 15)) * LV + 4 * (lane >> 4);
            const u32x2 lo = *(const LAS u32x2*)(vr + k0 * 16), hi = *(const LAS u32x2*)(vr + k1 * 16);
            const u32x4 w = {lo.x, lo.y, hi.x, hi.y};
            acc = mfma16(__builtin_bit_cast(bf16x8, w), pf[p], acc);
        }
        u32x2 o; o.x = pk2(acc[0], acc[1]); o.y = pk2(acc[2], acc[3]);
        *(u32x2*)(mix + (size_t)(rowq0 + qi) * D + 512 + qh * 64 + dt * 16 + 4 * (lane >> 4)) = o;
    }
    }
    __syncthreads();
}


#ifndef PEER_HQ_LO
#define PEER_HQ_LO 0
#endif
constexpr int LSK = 136;
__device__ __forceinline__ unsigned f2sort(float f) { const unsigned u = __float_as_uint(f); return u ^ ((unsigned)((int)u >> 31) | 0x80000000u); }
__device__ __forceinline__ float sort2f(unsigned s) { return __uint_as_float((s & 0x80000000u) ? (s ^ 0x80000000u) : ~s); }

#define CE_(i, j) { const unsigned hi_ = key[i][r] > key[j][r] ? key[i][r] : key[j][r], lo_ = key[i][r] > key[j][r] ? key[j][r] : key[i][r]; key[i][r] = hi_; key[j][r] = lo_; }
template <int NT>
__device__ __forceinline__ void top16(unsigned (&key)[NT][4], unsigned (&top)[4], int l15) {
    static_assert(NT == 8, "8 keys per lane");
#pragma unroll
    for (int r = 0; r < 4; ++r) {
        CE_(0, 1) CE_(2, 3) CE_(4, 5) CE_(6, 7)
        CE_(0, 2) CE_(1, 3) CE_(4, 6) CE_(5, 7)
        CE_(1, 2) CE_(5, 6)
        CE_(0, 4) CE_(1, 5) CE_(2, 6) CE_(3, 7)
        CE_(2, 4) CE_(3, 5)
        CE_(1, 2) CE_(3, 4) CE_(5, 6)
        top[r] = 0u;
    }
    for (int it = 0; it < 16; ++it) {
        unsigned m[4];
#pragma unroll
        for (int r = 0; r < 4; ++r) m[r] = key[0][r];
#pragma unroll
        for (int st = 0; st < 4; ++st)
#pragma unroll
            for (int r = 0; r < 4; ++r) { const unsigned y = dppu(m[r], st); m[r] = m[r] > y ? m[r] : y; }
        const bool rec = (l15 == it);
#pragma unroll
        for (int r = 0; r < 4; ++r) {
            top[r] = rec ? m[r] : top[r];
            const bool own = key[0][r] == m[r];
#pragma unroll
            for (int t = 0; t < 7; ++t) key[t][r] = own ? key[t + 1][r] : key[t][r];
            key[7][r] = own ? 0u : key[7][r];
        }
    }
}
#undef CE_
__device__ __forceinline__ float gelu_erf(float x) { return 0.5f * x * (1.f + erff(x * 0.70710678118654752f)); }

__device__ __forceinline__ void peer_hq_row(const Args& a, int row, int lane) {
    {
        const bf16_t* hrow = (const bf16_t*)(a.ws + WS_B) + (size_t)row * D + 16 * lane;
        const u32x4 hb0 = *(const u32x4*)hrow, hb1 = *(const u32x4*)(hrow + 8);
        f32x4 v[4]; float am = 0.f;
        v[0] = (f32x4){bflo(hb0.x), bfhi(hb0.x), bflo(hb0.y), bfhi(hb0.y)}; v[1] = (f32x4){bflo(hb0.z), bfhi(hb0.z), bflo(hb0.w), bfhi(hb0.w)};
        v[2] = (f32x4){bflo(hb1.x), bfhi(hb1.x), bflo(hb1.y), bfhi(hb1.y)}; v[3] = (f32x4){bflo(hb1.z), bfhi(hb1.z), bflo(hb1.w), bfhi(hb1.w)};
#pragma unroll
        for (int j = 0; j < 4; ++j) am = fmaxf(am, fmaxf(fmaxf(fabsf(v[j][0]), fabsf(v[j][1])), fmaxf(fabsf(v[j][2]), fabsf(v[j][3]))));
        am = fmaxf(am, __uint_as_float(dppu(__float_as_uint(am), 0))); am = fmaxf(am, __uint_as_float(dppu(__float_as_uint(am), 1))); am = fmaxf(am, __uint_as_float(dppu(__float_as_uint(am), 2)));
        const float s1 = am > 0.f ? am * (1.f / 127.f) : 1.f, i1 = 1.f / s1, i2 = 254.f * i1;
        u32x4 wh, wl;
#pragma unroll
        for (int j = 0; j < 4; ++j) {
            unsigned ph = 0, pl = 0;
#pragma unroll
            for (int e = 0; e < 4; ++e) {
                const float qh = rintf(v[j][e] * i1);
                const float ql = rintf((v[j][e] - qh * s1) * i2);
                ph |= ((unsigned)((int)qh & 255)) << (8 * e); pl |= ((unsigned)((int)ql & 255)) << (8 * e);
            }
            wh[j] = ph; wl[j] = pl;
        }
        *(u32x4*)(a.ws + WS_HQH + (size_t)row * D + 16 * lane) = wh;
        if (PEER_HQ_LO) *(u32x4*)(a.ws + WS_HQL + (size_t)row * D + 16 * lane) = wl;
        if ((lane & 7) == 0) ((float*)(a.ws + WS_HS))[(size_t)row * 8 + (lane >> 3)] = s1;
    }
}
__device__ __forceinline__ void peer_score_unit(const Args& a, LAS unsigned char* lds, int pm, int hsel) {
    const int tid = threadIdx.x, lane = tid & 63, wave = tid >> 6, l15 = lane & 15, lq = lane >> 4;
    const bf16_t* pq = (const bf16_t*)(a.ws + WS_A);
    LAS u32x2* SEL = (LAS u32x2*)lds;
    const int T0 = pm * 256;
    {
#pragma unroll 1
        for (int hh = 0; hh < 2; ++hh) {
            const int h = hsel, tt = wave + 8 * hh;
            unsigned tc[2][4];
#pragma unroll
            for (int c = 0; c < 2; ++c) {
                unsigned key[8][4];
#pragma unroll
                for (int r = 0; r < 4; ++r) {
                    const u32x4 sv = *(const u32x4*)(pq + (size_t)(T0 + tt * 16 + lq * 4 + r) * 2048 + h * 256 + c * 128 + 8 * l15);
                    const unsigned sw[4] = {sv.x, sv.y, sv.z, sv.w};
#pragma unroll
                    for (int j = 0; j < 4; ++j) {
                        key[2 * j][r] = (f2sort(bflo(sw[j])) & ~127u) | (unsigned)(8 * l15 + 2 * j);
                        key[2 * j + 1][r] = (f2sort(bfhi(sw[j])) & ~127u) | (unsigned)(8 * l15 + 2 * j + 1);
                    }
                }
                top16<8>(key, tc[c], l15);
            }
            const int gb = lane & 48;
            int ci[4], cj[4]; bool ok[4];
            ci[0] = 0; cj[0] = l15; ok[0] = true;
            ci[1] = l15; cj[1] = 0; ok[1] = l15 >= 1;
            ci[2] = l15 < 7 ? 1 : (l15 < 11 ? 2 : (l15 < 14 ? 3 : 4)); cj[2] = l15 < 7 ? l15 + 1 : (l15 < 11 ? l15 - 6 : (l15 < 14 ? l15 - 10 : l15 - 13)); ok[2] = true;
            ci[3] = l15 < 3 ? 5 + l15 : 0; cj[3] = 1; ok[3] = l15 < 3;
            unsigned ck[4][4]; int ce[4][4];
#pragma unroll
            for (int r = 0; r < 4; ++r) {
                const unsigned t1 = tc[0][r], t2 = tc[1][r];
                const float v1 = sort2f(t1 & ~127u), v2 = sort2f(t2 & ~127u);
                const int i1 = (int)(t1 & 127u), i2 = (int)(t2 & 127u);
#pragma unroll
                for (int sl = 0; sl < 4; ++sl) {
                    const float a1 = __uint_as_float((unsigned)__builtin_amdgcn_ds_bpermute((gb + ci[sl]) * 4, (int)__float_as_uint(v1)));
                    const float a2 = __uint_as_float((unsigned)__builtin_amdgcn_ds_bpermute((gb + cj[sl]) * 4, (int)__float_as_uint(v2)));
                    const int e1 = __builtin_amdgcn_ds_bpermute((gb + ci[sl]) * 4, i1);
                    const int e2 = __builtin_amdgcn_ds_bpermute((gb + cj[sl]) * 4, i2);
                    ce[sl][r] = e1 * 128 + e2;
                    ck[sl][r] = ok[sl] ? ((f2sort(a1 + a2) & ~63u) | (unsigned)(l15 * 4 + sl)) : 0u;
                }
#define CE4_(i, j) { const unsigned hi_ = ck[i][r] > ck[j][r] ? ck[i][r] : ck[j][r], lo_ = ck[i][r] > ck[j][r] ? ck[j][r] : ck[i][r]; ck[i][r] = hi_; ck[j][r] = lo_; }
                CE4_(0, 1) CE4_(2, 3) CE4_(0, 2) CE4_(1, 3) CE4_(1, 2)
#undef CE4_
            }
            unsigned topk[4] = {0u, 0u, 0u, 0u};
            for (int it = 0; it < 16; ++it) {
                unsigned m[4];
#pragma unroll
                for (int r = 0; r < 4; ++r) m[r] = ck[0][r];
#pragma unroll
                for (int st = 0; st < 4; ++st)
#pragma unroll
                    for (int r = 0; r < 4; ++r) { const unsigned y = dppu(m[r], st); m[r] = m[r] > y ? m[r] : y; }
                const bool rec = (l15 == it);
#pragma unroll
                for (int r = 0; r < 4; ++r) {
                    topk[r] = rec ? m[r] : topk[r];
                    const bool own = ck[0][r] == m[r];
                    ck[0][r] = own ? ck[1][r] : ck[0][r]; ck[1][r] = own ? ck[2][r] : ck[1][r]; ck[2][r] = own ? ck[3][r] : ck[2][r]; ck[3][r] = own ? 0u : ck[3][r];
                }
            }
#pragma unroll
            for (int r = 0; r < 4; ++r) {
                const int own = (int)((topk[r] >> 2) & 15u), slot = (int)(topk[r] & 3u);
                int eid = 0;
#pragma unroll
                for (int sl = 0; sl < 4; ++sl) { const int t = __builtin_amdgcn_ds_bpermute((gb + own) * 4, ce[sl][r]); eid = (slot == sl) ? t : eid; }
                const float ts = sort2f(topk[r] & ~63u);
                const float tmax = row16_max_f32(ts);
                const float p = __expf(ts - tmax);
                const float g = p / row16_sum_f32(p);
                { u32x2 o; o.x = (unsigned)eid; o.y = __float_as_uint(g); SEL[(tt * 16 + lq * 4 + r) * 16 + l15] = o; }
            }
        }
    }
    __syncthreads();
    {
        unsigned* sele = (unsigned*)(a.ws + WS_SELE); float* selg = (float*)(a.ws + WS_SELG);
        for (int i = tid; i < 256 * 16; i += NTHREADS) { const u32x2 o = SEL[i]; const size_t gi = (size_t)(T0 + (i >> 4)) * 128 + hsel * 16 + (i & 15); sele[gi] = o.x; selg[gi] = __uint_as_float(o.y); }
    }
    const int r0 = T0 + 32 * hsel;
    if (tid < 32) ((float*)(a.ws + WS_R2))[r0 + tid] = row_rscale((const float*)(a.ws + WS_SSQ), r0 + tid);
    for (int tk = 0; tk < 4; ++tk) peer_hq_row(a, r0 + wave * 4 + tk, lane);
    __syncthreads();
}
struct PeerSplit { int p0, pstep, trank, tn; };
__device__ __forceinline__ PeerSplit peer_split() {
    PeerSplit s; const int G = gridDim.x;
    if ((G & 7) == 0) { s.p0 = blockIdx.x & 7; s.pstep = 8; s.trank = blockIdx.x >> 3; s.tn = G >> 3; }
    else { s.p0 = 0; s.pstep = 1; s.trank = blockIdx.x; s.tn = G; }
    return s;
}
__device__ __forceinline__ void peer_down(const Args& a) {
    const int lane = threadIdx.x & 63, wave = threadIdx.x >> 6;
    const PeerSplit sp = peer_split();
    const unsigned* sele = (const unsigned*)(a.ws + WS_SELE);
    const float* hs = (const float*)(a.ws + WS_HS);
    const int t0 = sp.trank * NWAVES + wave, tstep = sp.tn * NWAVES;
    for (int p = sp.p0; p < 8; p += sp.pstep) {
        const unsigned char* EDs = a.ws + WS_ED + (size_t)p * (16384 * 128) + 16 * (lane & 7);
        float* part = (float*)(a.ws + WS_PART) + (size_t)p * MTOK * 128;
        const unsigned char* hqh = a.ws + WS_HQH + 128 * p + 16 * (lane & 7);
        const unsigned char* hql = a.ws + WS_HQL + 128 * p + 16 * (lane & 7);
        unsigned e0n = 0, e1n = 0; u32x4 h0n = {0u, 0u, 0u, 0u}, h1n = {0u, 0u, 0u, 0u}; float s1n = 0.f;
        if (t0 < MTOK) { e0n = sele[(size_t)t0 * 128 + lane]; e1n = sele[(size_t)t0 * 128 + 64 + lane]; h0n = *(const u32x4*)(hqh + (size_t)t0 * D); if (PEER_HQ_LO) h1n = *(const u32x4*)(hql + (size_t)t0 * D); s1n = hs[(size_t)t0 * 8 + p]; }
        for (int t = t0; t < MTOK; t += tstep) {
            const unsigned e0 = e0n, e1 = e1n; const u32x4 hh = h0n, hl = h1n; const float s1 = s1n, s2 = s1n * (1.f / 254.f);
            const int tn = t + tstep;
            if (tn < MTOK) { e0n = sele[(size_t)tn * 128 + lane]; e1n = sele[(size_t)tn * 128 + 64 + lane]; h0n = *(const u32x4*)(hqh + (size_t)tn * D); if (PEER_HQ_LO) h1n = *(const u32x4*)(hql + (size_t)tn * D); s1n = hs[(size_t)tn * 8 + p]; }
            float m0 = 0.f, m1 = 0.f;
            u32x4 x[16];
#pragma unroll
            for (int i = 0; i < 16; ++i) {
                const int srcl = (8 * (i & 7) + (lane >> 3)) * 4;
                const unsigned e = (unsigned)__builtin_amdgcn_ds_bpermute(srcl, (int)(i < 8 ? e0 : e1));
                x[i] = *(const u32x4*)(EDs + (size_t)e * 128);
            }
#pragma unroll
            for (int i = 0; i < 16; ++i) {
                int ah = 0, al = 0;
#pragma unroll
                for (int j = 0; j < 4; ++j) { ah = __builtin_amdgcn_sdot4((int)x[i][j], (int)hh[j], ah, false); if (PEER_HQ_LO) al = __builtin_amdgcn_sdot4((int)x[i][j], (int)hl[j], al, false); }
                float d = PEER_HQ_LO ? (float)ah * s1 + (float)al * s2 : (float)ah * s1;
                d += __uint_as_float(dppu(__float_as_uint(d), 0)); d += __uint_as_float(dppu(__float_as_uint(d), 1)); d += __uint_as_float(dppu(__float_as_uint(d), 2));
                if (i < 8) m0 = ((lane & 7) == i) ? d : m0; else m1 = ((lane & 7) == i - 8) ? d : m1;
            }
            part[(size_t)t * 128 + 8 * (lane & 7) + (lane >> 3)] = m0;
            part[(size_t)t * 128 + 64 + 8 * (lane & 7) + (lane >> 3)] = m1;
        }
    }
}
__device__ __forceinline__ void peer_coef(const Args& a) {
    const int lane = threadIdx.x & 63, wave = threadIdx.x >> 6;
    const unsigned* sele = (const unsigned*)(a.ws + WS_SELE); const float* selg = (const float*)(a.ws + WS_SELG);
    const float* part = (const float*)(a.ws + WS_PART);
    const float* esc = (const float*)(a.ws + WS_ESC);
    const float* r2g = (const float*)(a.ws + WS_R2);
    unsigned* coefd = (unsigned*)(a.ws + WS_COEF);
    for (int t = blockIdx.x * NWAVES + wave; t < MTOK; t += gridDim.x * NWAVES) {
        const float r2 = r2g[t];
        float c[2];
#pragma unroll
        for (int half = 0; half < 2; ++half) {
            const size_t i = (size_t)t * 128 + half * 64 + lane;
            float s = 0.f;
#pragma unroll
            for (int p = 0; p < 8; ++p) s += part[(size_t)p * MTOK * 128 + i];
            const unsigned e = sele[i];
            c[half] = selg[i] * gelu_erf(s * r2 * esc[e]) * esc[16384 + e];
        }
        float cm = fmaxf(fabsf(c[0]), fabsf(c[1]));
        cm = row16_max_f32(cm); cm = fmaxf(cm, __shfl_xor(cm, 16)); cm = fmaxf(cm, __shfl_xor(cm, 32));
        const float sc = cm > 0.f ? cm * (1.f / 127.f) : 1.f, inv = 1.f / sc;
        const int sh = 8 * ((lane >> 3) & 3);
        unsigned w0 = ((unsigned)((int)rintf(c[0] * inv) & 255)) << sh, w1 = ((unsigned)((int)rintf(c[1] * inv) & 255)) << sh;
        w0 |= (unsigned)__shfl_xor((int)w0, 8); w0 |= (unsigned)__shfl_xor((int)w0, 16);
        w1 |= (unsigned)__shfl_xor((int)w1, 8); w1 |= (unsigned)__shfl_xor((int)w1, 16);
        if ((lane & 24) == 0) {
            coefd[(size_t)t * 32 + (lane & 7) * 4 + (lane >> 5)] = w0;
            coefd[(size_t)t * 32 + (lane & 7) * 4 + 2 + (lane >> 5)] = w1;
        }
        if (lane == 0) ((float*)(a.ws + WS_CS))[t] = sc;
    }
}
__device__ __forceinline__ void peer_up(const Args& a) {
    const int lane = threadIdx.x & 63, wave = threadIdx.x >> 6;
    const PeerSplit sp = peer_split();
    const unsigned* sele = (const unsigned*)(a.ws + WS_SELE);
    const u32x4* coefd = (const u32x4*)(a.ws + WS_COEF);
    const float* csg = (const float*)(a.ws + WS_CS);
    const int t0 = sp.trank * NWAVES + wave, tstep = sp.tn * NWAVES;
    for (int p = sp.p0; p < 8; p += sp.pstep) {
        const unsigned char* EUs = a.ws + WS_EU + (size_t)p * (16384 * 128) + 16 * (lane & 7);
        const bf16_t* hbase = (const bf16_t*)(a.ws + WS_B) + 128 * p + 16 * (lane & 7) + 2 * (lane >> 3);
        float* h3base = (float*)(a.ws + WS_PART) + 128 * p + 16 * (lane & 7) + 2 * (lane >> 3);
        unsigned e0n = 0, e1n = 0, h2n = 0u; u32x4 cdn = {0u, 0u, 0u, 0u}; float csn = 0.f;
        if (t0 < MTOK) { e0n = sele[(size_t)t0 * 128 + lane]; e1n = sele[(size_t)t0 * 128 + 64 + lane]; cdn = coefd[(size_t)t0 * 8 + (lane >> 3)]; csn = csg[t0]; h2n = *(const unsigned*)(hbase + (size_t)t0 * D); }
        for (int t = t0; t < MTOK; t += tstep) {
            const unsigned e0 = e0n, e1 = e1n; const u32x4 cd = cdn; const float cs = csn; const f32x2_t h2 = {bflo(h2n), bfhi(h2n)};
            const int tn = t + tstep;
            if (tn < MTOK) { e0n = sele[(size_t)tn * 128 + lane]; e1n = sele[(size_t)tn * 128 + 64 + lane]; cdn = coefd[(size_t)tn * 8 + (lane >> 3)]; csn = csg[tn]; h2n = *(const unsigned*)(hbase + (size_t)tn * D); }
            int acc[16];
#pragma unroll
            for (int j = 0; j < 16; ++j) acc[j] = 0;
            u32x4 x[16];
#pragma unroll
            for (int i = 0; i < 16; ++i) {
                const int srcl = (8 * (i & 7) + (lane >> 3)) * 4;
                const unsigned e = (unsigned)__builtin_amdgcn_ds_bpermute(srcl, (int)(i < 8 ? e0 : e1));
                x[i] = *(const u32x4*)(EUs + (size_t)e * 128);
            }
#pragma unroll
            for (int g = 0; g < 4; ++g) {
                const int cw = (int)cd[g];
#pragma unroll
                for (int j = 0; j < 4; ++j) {
                    const unsigned xa = x[4 * g][j], xb = x[4 * g + 1][j], xc = x[4 * g + 2][j], xd = x[4 * g + 3][j];
                    const unsigned t0_ = __builtin_amdgcn_perm(xb, xa, 0x05010400u), t1_ = __builtin_amdgcn_perm(xb, xa, 0x07030602u);
                    const unsigned t2_ = __builtin_amdgcn_perm(xd, xc, 0x05010400u), t3_ = __builtin_amdgcn_perm(xd, xc, 0x07030602u);
                    const unsigned o0 = __builtin_amdgcn_perm(t2_, t0_, 0x05040100u), o1 = __builtin_amdgcn_perm(t2_, t0_, 0x07060302u);
                    const unsigned o2 = __builtin_amdgcn_perm(t3_, t1_, 0x05040100u), o3 = __builtin_amdgcn_perm(t3_, t1_, 0x07060302u);
                    acc[4 * j + 0] = __builtin_amdgcn_sdot4((int)o0, cw, acc[4 * j + 0], false);
                    acc[4 * j + 1] = __builtin_amdgcn_sdot4((int)o1, cw, acc[4 * j + 1], false);
                    acc[4 * j + 2] = __builtin_amdgcn_sdot4((int)o2, cw, acc[4 * j + 2], false);
                    acc[4 * j + 3] = __builtin_amdgcn_sdot4((int)o3, cw, acc[4 * j + 3], false);
                }
            }
            const bool b5 = lane & 32, b4 = lane & 16, b3 = lane & 8;
            int k8[8], k4[4], k2[2];
#pragma unroll
            for (int j = 0; j < 8; ++j) k8[j] = (b5 ? acc[8 + j] : acc[j]) + __shfl_xor(b5 ? acc[j] : acc[8 + j], 32);
#pragma unroll
            for (int j = 0; j < 4; ++j) k4[j] = (b4 ? k8[4 + j] : k8[j]) + __shfl_xor(b4 ? k8[j] : k8[4 + j], 16);
#pragma unroll
            for (int j = 0; j < 2; ++j) k2[j] = (b3 ? k4[2 + j] : k4[j]) + __shfl_xor(b3 ? k4[j] : k4[2 + j], 8);
            const f32x2_t h3 = h2 + (f32x2_t){(float)k2[0] * cs, (float)k2[1] * cs};
            *(f32x2_t*)(h3base + (size_t)t * D) = h3;
        }
    }
}
__device__ __forceinline__ void peer_final(const Args& a) {
    const int lane = threadIdx.x & 63, wave = threadIdx.x >> 6;
    const float* gf = a.in[I_GFINAL];
    for (int t = blockIdx.x * NWAVES + wave; t < MTOK; t += gridDim.x * NWAVES) {
        const float* hrow = (const float*)(a.ws + WS_PART) + (size_t)t * D + 4 * lane;
        float* orow = a.out + (size_t)t * D + 4 * lane;
        f32x4 v[4]; float s = 0.f;
#pragma unroll
        for (int j = 0; j < 4; ++j) { v[j] = *(const f32x4*)(hrow + 256 * j); s += v[j][0] * v[j][0] + v[j][1] * v[j][1] + v[j][2] * v[j][2] + v[j][3] * v[j][3]; }
        const float r3 = rsqrtf(wave_sum(s) * (1.f / D) + EPS);
#pragma unroll
        for (int j = 0; j < 4; ++j) *(f32x4*)(orow + 256 * j) = v[j] * r3 * *(const f32x4*)(gf + 4 * lane + 256 * j);
    }
}
__device__ __forceinline__ void peer_fold_task(const Args& a, int task) {
    const int lane = threadIdx.x & 63, wave = threadIdx.x >> 6, l15 = lane & 15, lq = lane >> 4;
    const int hc = task >> 2, c = hc & 1, k0 = (task & 3) * 256 + wave * 32;
    const bf16_t* wgr = (const bf16_t*)(a.ws + WS_WGR);
    const bf16_t* sk = (const bf16_t*)(a.ws + WS_SK) + (size_t)c * 128 * 128;
    bf16_t* btp = (bf16_t*)(a.ws + WS_WPQ);
    f32x4 acc[2][8];
#pragma unroll
    for (int mt = 0; mt < 2; ++mt)
#pragma unroll
        for (int nt = 0; nt < 8; ++nt) acc[mt][nt] = (f32x4){0.f, 0.f, 0.f, 0.f};
#pragma unroll
    for (int ks = 0; ks < 4; ++ks) {
        bf16x8 af[2];
#pragma unroll
        for (int mt = 0; mt < 2; ++mt) af[mt] = *(const bf16x8*)(wgr + (size_t)(k0 + mt * 16 + l15) * 2048 + hc * 128 + ks * 32 + 8 * lq);
#pragma unroll
        for (int nt = 0; nt < 8; ++nt) {
            const bf16x8 bv = *(const bf16x8*)(sk + (size_t)(nt * 16 + l15) * 128 + ks * 32 + 8 * lq);
#pragma unroll
            for (int mt = 0; mt < 2; ++mt) acc[mt][nt] = mfma16(af[mt], bv, acc[mt][nt]);
        }
    }
#pragma unroll
    for (int mt = 0; mt < 2; ++mt)
#pragma unroll
        for (int nt = 0; nt < 8; ++nt) {
            u32x2 o; o.x = pk2(acc[mt][nt][0], acc[mt][nt][1]); o.y = pk2(acc[mt][nt][2], acc[mt][nt][3]);
            *(u32x2*)(btp + (size_t)(hc * 128 + nt * 16 + l15) * 1024 + k0 + mt * 16 + 4 * lq) = o;
        }
}

#define XB_TMO      128
#define XB_XCNT(j)  (256  + 64 * (j))
#define XB_XSUB(j)  (1280 + 64 * (j))
#define XB_XGEN(j)  (2304 + 64 * (j))
#define XB_TOP      3328
#define XB_TOPGEN   3392
#define XCD_BAR_WORDS 3456
#define XB_SPIN_CAP (1u << 22)
__device__ __forceinline__ unsigned xb_ld(unsigned* p)              { return __hip_atomic_load(p, __ATOMIC_RELAXED, __HIP_MEMORY_SCOPE_AGENT); }
__device__ __forceinline__ unsigned xb_add(unsigned* p, unsigned v) { return __hip_atomic_fetch_add(p, v, __ATOMIC_RELAXED, __HIP_MEMORY_SCOPE_AGENT); }
__device__ __forceinline__ unsigned xb_xcc_id() { return (unsigned)__builtin_amdgcn_s_getreg((3 << 11) | 20) & 0xFu; }
#define XB_SPIN(cond, bar) do { unsigned _sp = 0; while (cond) { __builtin_amdgcn_s_sleep(1); \
    if ((++_sp & 255u) == 0u) { if (xb_ld(&(bar)[XB_TMO])) break; if (_sp > XB_SPIN_CAP) { atomicAdd(&(bar)[XB_TMO], 1u); break; } } } } while (0)
struct XcdBarrier { unsigned* bar; unsigned x; volatile LAS unsigned* st; };
__device__ __forceinline__ XcdBarrier xcd_barrier_post(unsigned* bar, volatile LAS unsigned* st) {
    XcdBarrier b; b.bar = bar; b.x = xb_xcc_id(); b.st = st;
    if (threadIdx.x == 0) (void)xb_add(&bar[XB_XCNT(b.x)], 1u);
    return b;
}
__device__ __forceinline__ void xcd_barrier_complete(unsigned* bar, unsigned x, unsigned& nloc, unsigned& nx) {
    const unsigned G = gridDim.x * gridDim.y * gridDim.z;
    unsigned sum, cnt, mine, sp = 0u;
    for (;;) {
        sum = 0u; cnt = 0u; mine = 0u;
#pragma unroll
        for (unsigned j = 0; j < 16; ++j) { const unsigned c = xb_ld(&bar[XB_XCNT(j)]); sum += c; cnt += (c > 0u) ? 1u : 0u; mine = (j == x) ? c : mine; }
        if (sum == G) break;
        __builtin_amdgcn_s_sleep(1);
        if ((++sp & 255u) == 0u) { if (xb_ld(&bar[XB_TMO])) break; if (sp > XB_SPIN_CAP) { atomicAdd(&bar[XB_TMO], 1u); break; } }
    }
    nloc = mine > 0u ? mine : 1u; nx = cnt > 0u ? cnt : 1u;
}
__device__ __forceinline__ void xcd_barrier(const XcdBarrier& b) {
    asm volatile("s_waitcnt vmcnt(0)" ::: "memory");
    __syncthreads();
    if (threadIdx.x == 0) {
        unsigned* bar = b.bar;
        __builtin_amdgcn_s_waitcnt(0);
        unsigned nloc = b.st[0], nx = b.st[1];
        if (nloc == 0u) { xcd_barrier_complete(bar, b.x, nloc, nx); b.st[0] = nloc; b.st[1] = nx; }
        const unsigned old = xb_add(&bar[XB_XSUB(b.x)], 1u);
        const unsigned gen = old / nloc;
        if (old + 1u == (gen + 1u) * nloc) {
            __builtin_amdgcn_fence(__ATOMIC_RELEASE, "agent");
            asm volatile("s_waitcnt vmcnt(0)" ::: "memory");
            const unsigned og = xb_add(&bar[XB_TOP], 1u);
            const unsigned tg = og / nx;
            if (og + 1u == (tg + 1u) * nx) xb_add(&bar[XB_TOPGEN], 1u);
            else XB_SPIN(xb_ld(&bar[XB_TOPGEN]) == tg, bar);
            __builtin_amdgcn_fence(__ATOMIC_ACQUIRE, "agent");
            xb_add(&bar[XB_XGEN(b.x)], 1u);
            asm volatile("s_waitcnt vmcnt(0)" ::: "memory");
        } else {
            XB_SPIN(xb_ld(&bar[XB_XGEN(b.x)]) == gen, bar);
            __builtin_amdgcn_fence(__ATOMIC_ACQUIRE, "agent");
            asm volatile("s_waitcnt vmcnt(0)" ::: "memory");
        }
    }
    __syncthreads();
}


#ifndef FUSE_SCORE
#define FUSE_SCORE 1
#endif
constexpr int NPHASES = 15;
__global__ __launch_bounds__(NTHREADS, 2) void hybrid_fwd(Args a) {
    extern __shared__ __attribute__((aligned(16))) unsigned char smem[];
    LAS unsigned char* lds = (LAS unsigned char*)smem;
    volatile LAS unsigned* xbw = (volatile LAS unsigned*)(lds + LDS_BYTES - 16);
    unsigned char* ws = a.ws;
    const int G = gridDim.x;
    if (threadIdx.x == 0) { xbw[0] = 0u; xbw[1] = 0u; xbw[2] = 0u; xbw[3] = 0u; }
    __syncthreads();
    XcdBarrier xb; xb.bar = (unsigned*)(ws + WS_BAR); xb.x = 0; xb.st = xbw;
    const bool multi = (a.ph_hi - a.ph_lo) > 1;
    if (multi) xb = xcd_barrier_post((unsigned*)(ws + WS_BAR), xbw);
#define PHON(n) 1
#define PH_BEGIN(n) if (PHON(n) && a.ph_lo <= (n) && (n) < a.ph_hi) { auto body_ = [&]() __attribute__((always_inline)) {
#define PH_END(n) }; body_(); if ((n) + 1 < a.ph_hi) xcd_barrier(xb); }
    PH_BEGIN(0) phase0(a, lds); PH_END(0)
    PH_BEGIN(1)
        { pg8::Gemm g{(const bf16_t*)(ws + WS_B), (const bf16_t*)(ws + WS_WIN), MTOK, NPROJ, D};
          pg8::StaticOrder S; S.init(g.M, g.N, G, blockIdx.x);
          EpiRowBf16 E{(bf16_t*)(ws + WS_A), NPROJ, nullptr, 1.0f};
          pg8::gemm_phase<EpiRowBf16, pg8::StaticOrder, false>(lds, g, S, E, nullptr); }
        { pg8::Gemm g{(const bf16_t*)(ws + WS_C), (const bf16_t*)(ws + WS_WXKV), NB * MEMLEN, 2048, D};
          pg8::StaticOrder S; S.init(g.M, g.N, G, (blockIdx.x + G - (64 % G)) % G);
          EpiKV E{(bf16_t*)(ws + WS_KMEM), (bf16_t*)(ws + WS_VTMEM)};
          pg8::gemm_phase<EpiKV, pg8::StaticOrder, false>(lds, g, S, E, nullptr); }
        { const int lo = (G > 160) ? 80 : 0;
          if ((int)blockIdx.x >= lo) p0_experts(a, blockIdx.x - lo, G - lo); }
    PH_END(1)
    PH_BEGIN(2) for (int t = blockIdx.x; t < 1280; t += G) { if (t < 1024) mlstm_local(a, lds, t); else swa_task(a, lds, t - 1024); } PH_END(2)
    PH_BEGIN(3) p0_late_transposes(a, lds); mlstm_scan(a); PH_END(3)
    PH_BEGIN(4)
        {
            for (int fu = blockIdx.x; fu < 128; fu += G) {
                if (fu < 64) {
                    const int j = fu >> 2, bh = j & 7, b = bh >> 2, h = bh & 3;
                    const bf16_t* Kh = (const bf16_t*)(ws + WS_KMEM) + (size_t)bh * 65536; const bf16_t* Vh = (const bf16_t*)(ws + WS_VTMEM) + (size_t)bh * 65536;
                    const bf16_t* WqR = (const bf16_t*)(ws + WS_WXQ) + (size_t)h * 1024 * 256; const bf16_t* WoR = (const bf16_t*)(ws + WS_WXO) + (size_t)h * 1024 * 256;
                    pg8::Gemm g{}; EpiRowBf16 E{nullptr, 1024, nullptr, 1.0f};
                    if (j < 8) { g.A = Kh; g.Bt = WqR; g.M = 256; g.N = 1024; g.K = 256; E.O = (bf16_t*)(ws + WS_WXKV) + ((size_t)b * 1024 + h * 256) * 1024; }
                    else { g.A = WoR; g.Bt = Vh; g.M = 1024; g.N = 256; g.K = 256; E.O = (bf16_t*)(ws + WS_BTO) + (size_t)b * 1024 * 1024 + h * 256; }
                    pg8::StaticOrder S; S.init(g.M, g.N, 4, fu & 3);
                    pg8::gemm_phase<EpiRowBf16, pg8::StaticOrder, false>(lds, g, S, E, nullptr);
                } else peer_fold_task(a, fu - 64);
                __syncthreads();
            }
            __syncthreads();
        }
        for (int t = blockIdx.x; t < 1024; t += G) mlstm_out(a, lds, t);
    PH_END(4)
    PH_BEGIN(5) { pg8::Gemm g{(const bf16_t*)(ws + WS_C), (const bf16_t*)(ws + WS_WOUT), MTOK, D, D};
          pg8::StaticOrder S; S.init(g.M, g.N, G, blockIdx.x);
          EpiResid<false> E{a.in[I_X], (bf16_t*)(ws + WS_B), (float*)(ws + WS_SSQ)};
          pg8::gemm_phase<EpiResid<false>, pg8::StaticOrder, false>(lds, g, S, E, nullptr); } PH_END(5)
    PH_BEGIN(6) { pg8::Gemm g{(const bf16_t*)(ws + WS_B), (const bf16_t*)(ws + WS_WXKV), MTOK, D, D, 32, (size_t)1024 * 1024 * 2};
          EpiSoftmax E{(bf16_t*)(ws + WS_A), (const float*)(ws + WS_SSQ)};
          for (int L = blockIdx.x; L < (MTOK / 256) * (D / 256); L += G) {
              pg8::StaticOrder S; S.init(g.M, g.N, (MTOK / 256) * (D / 256), L);
              pg8::gemm_phase<EpiSoftmax, pg8::StaticOrder, false>(lds, g, S, E, nullptr);
          } } PH_END(6)
    PH_BEGIN(8) { pg8::Gemm g{(const bf16_t*)(ws + WS_A), (const bf16_t*)(ws + WS_BTO), MTOK, D, D, 32, (size_t)1024 * 1024 * 2};
          pg8::StaticOrder S; S.init(g.M, g.N, G, blockIdx.x);
          EpiResid<true> E{(const void*)(ws + WS_B), (bf16_t*)(ws + WS_B), (float*)(ws + WS_SSQ)};
          pg8::gemm_phase<EpiResid<true>, pg8::StaticOrder, false>(lds, g, S, E, nullptr); } PH_END(8)
    PH_BEGIN(9) { pg8::Gemm g{(const bf16_t*)(ws + WS_B), (const bf16_t*)(ws + WS_WPQ), MTOK, 2048, D};
          pg8::StaticOrder S; S.init(g.M, g.N, G, blockIdx.x);
          EpiRowBf16 E{(bf16_t*)(ws + WS_A), 2048, (const float*)(ws + WS_SSQ), 1.0f};
          pg8::gemm_phase<EpiRowBf16, pg8::StaticOrder, false>(lds, g, S, E, nullptr);
#if FUSE_SCORE
          asm volatile("s_waitcnt vmcnt(0)" ::: "memory"); __syncthreads();
          pg8::Unit u;
          for (int i = 0; S.next(i, u); ++i) peer_score_unit(a, lds, u.pm, u.pn);
#endif
          } PH_END(9)

    PH_BEGIN(11) peer_down(a); PH_END(11)
    PH_BEGIN(12) peer_coef(a); PH_END(12)
    PH_BEGIN(13) peer_up(a); PH_END(13)
    PH_BEGIN(14) peer_final(a); PH_END(14)
}

#ifndef MK_ONE_LAUNCH
#define MK_ONE_LAUNCH 1
#endif
extern "C" void kernel_launch(void* const* d_in, const int* in_sizes, int n_in, void* d_out, int out_size, void* d_ws, size_t ws_size, hipStream_t stream) {
    static int grid = 0;
    if (grid == 0) {
        if (n_in != 24 || out_size != MTOK * D || ws_size < WS_END) { fprintf(stderr, "kernel_launch: unexpected shapes (n_in %d out %d ws %zu)\n", n_in, out_size, ws_size); grid = -1; return; }
        int dev = 0, cus = 0;
        if (hipGetDevice(&dev) != hipSuccess || hipDeviceGetAttribute(&cus, hipDeviceAttributeMultiprocessorCount, dev) != hipSuccess) { grid = -1; return; }
        if (hipFuncSetAttribute((const void*)hybrid_fwd, hipFuncAttributeMaxDynamicSharedMemorySize, LDS_BYTES) != hipSuccess) { fprintf(stderr, "kernel_launch: hipFuncSetAttribute failed\n"); grid = -1; return; }
        int per_cu = 0;
        if (hipOccupancyMaxActiveBlocksPerMultiprocessor(&per_cu, (const void*)hybrid_fwd, NTHREADS, LDS_BYTES) != hipSuccess || per_cu < 1) { fprintf(stderr, "kernel_launch: occupancy query says %d\n", per_cu); }
        (void)hipGetLastError();
        grid = cus;
    }
    if (grid < 0) return;
    (void)hipMemsetAsync((char*)d_ws + WS_BAR, 0, XCD_BAR_WORDS * 4, stream);
    Args a{};
    for (int i = 0; i < 24; ++i) a.in[i] = (const float*)d_in[i];
    a.out = (float*)d_out; a.ws = (unsigned char*)d_ws;
#if MK_ONE_LAUNCH
    a.ph_lo = 0; a.ph_hi = NPHASES;
    hipLaunchKernelGGL(hybrid_fwd, dim3(grid), dim3(NTHREADS), LDS_BYTES, stream, a);
#else
    for (int ph = 0; ph < NPHASES; ++ph) {
        a.ph_lo = ph; a.ph_hi = ph + 1;
        hipLaunchKernelGGL(hybrid_fwd, dim3(grid), dim3(NTHREADS), LDS_BYTES, stream, a);
    }
#endif
}
```

```cpp
#include <hip/hip_runtime.h>
#include <cstdio>
#include <cstdint>
namespace pg8 {
#define PG8_LAS __attribute__((address_space(3)))
typedef unsigned short bf16_t;
typedef short bf16x8 __attribute__((ext_vector_type(8)));
typedef float f32x4 __attribute__((ext_vector_type(4)));
typedef unsigned u32x4 __attribute__((ext_vector_type(4)));
constexpr int BM = 256, BK = 64, HALF = 128, HTB = HALF * BK * 2  , STAGE_BYTES = 8 * HTB, NXCD = 8, WGM = 8;

__host__ __device__ __forceinline__ int lds_byte(int r, int c) { const int st = (r >> 4) * 2 + (c >> 5), rr = r & 15, cc = c & 31, ob = rr * 64 + cc * 2; return st * 1024 + (ob ^ (((ob >> 9) & 1) << 5)); }
__host__ __device__ __forceinline__ void stage_rc(int b, int& R, int& C) { const int st = b / 1024, sb = b % 1024, swz = sb ^ (((sb >> 9) & 1) << 5); R = (st >> 1) * 16 + swz / 64; C = (st & 1) * 32 + (swz % 64) / 2; }
__host__ __device__ __forceinline__ int perm32(int rho) { const int n = rho >> 4, i = rho & 15; return 8 * (i >> 2) + 4 * n + (i & 3); }

struct Unit { int pm, pn; };
struct Gemm { const bf16_t* A; const bf16_t* Bt; int M, N, K; int pm_split; size_t bt_split_bytes; };

struct StaticOrder {
    int nM, nN, nwg, G, c;
    __host__ __device__ void init(int M, int N, int G_, int c_) { nM = M / BM; nN = N / BM; nwg = nM * nN; G = G_; c = c_; }
    __host__ __device__ bool next(int i, Unit& u) const {
        const long L = (long)i * G + c; if (L >= nwg) return false;
        int wgid = (int)L; { const int q = nwg / NXCD, r = nwg % NXCD, xcd = wgid % NXCD, off = wgid / NXCD; wgid = (xcd < r ? xcd * (q + 1) : r * (q + 1) + (xcd - r) * q) + off; }
        const int nig = WGM * nN, gid = wgid / nig, fm = gid * WGM, gsz = (nM - fm) < WGM ? (nM - fm) : WGM;
        u.pm = fm + ((wgid % nig) % gsz); u.pn = (wgid % nig) / gsz; return true;
    }
    __device__ __forceinline__ void a_ready(const Unit&) const {}
    __device__ __forceinline__ void done(const Unit&) const {}
};
__device__ __forceinline__ unsigned cvt_pk_bf16(float lo, float hi) { unsigned r; asm volatile("v_cvt_pk_bf16_f32 %0, %1, %2" : "=v"(r) : "v"(lo), "v"(hi)); return r; }
typedef float f32x2 __attribute__((ext_vector_type(2)));
__device__ __forceinline__ f32x2 gelu_pk(f32x2 v) {
    const f32x2 av = __builtin_elementwise_abs(v), d = av * 0.2316418882f + 1.0f;
    f32x2 t; t.x = __builtin_amdgcn_rcpf(d.x); t.y = __builtin_amdgcn_rcpf(d.y);
    f32x2 q = t * 0.5307027145f + (-0.7265760135f); q = q * t + 0.7107068705f; q = q * t + (-0.142248368f); q = q * t + 0.127414796f; q = q * t;
    const f32x2 s = (v * v) * (-0.72134752044f);
    f32x2 e; e.x = __builtin_amdgcn_exp2f(s.x); e.y = __builtin_amdgcn_exp2f(s.y);
    const f32x2 m = v * (q * e), r = v - m;
    f32x2 o; o.x = v.x < 0.f ? m.x : r.x; o.y = v.y < 0.f ? m.y : r.y; return o;
}

template <class Epi, class Sched, bool STAMP = false>
__device__ __forceinline__ void gemm_phase(PG8_LAS unsigned char* lds, const Gemm g, const Sched& S, const Epi& E, unsigned long long* stamps) {
    const int tid = threadIdx.x, wid = __builtin_amdgcn_readfirstlane(tid >> 6), lane = tid & 63, wr = wid >> 2, wc = wid & 3, fr = lane & 15, fq = lane >> 4;
    const int K = g.K, nt = K / BK;
    int ts_lo = 0, ts_hi = 0, nts = 0; const unsigned long long rt_entry = STAMP ? (unsigned long long)wall_clock64() : 0ull;
#define PG8_STAMP() do { if (STAMP && wid == 0 && nts < 64) { const unsigned long long _c = (unsigned long long)clock64(); \
        ts_lo = (lane == nts) ? (int)(unsigned)_c : ts_lo; ts_hi = (lane == nts) ? (int)(unsigned)(_c >> 32) : ts_hi; ++nts; } } while (0)
    PG8_STAMP();
    unsigned voffA[2], voffB[2];
#pragma unroll
    for (int i = 0; i < 2; ++i) { int R, C; stage_rc(tid * 16 + i * 8192, R, C); const int Rb = Epi::PERM ? ((R & ~31) + perm32(R & 31)) : R;
        voffA[i] = (unsigned)(R * K + C) * 2u; voffB[i] = (unsigned)(Rb * K + C) * 2u; }
    const size_t kstep = (size_t)(BK * 2);
    const size_t hstep = (size_t)HALF * K * 2;
    const size_t tstep = 2 * hstep;
    const unsigned ldsw = (unsigned)wid * 1024u;
    const int aoff = lds_byte(wr * 64 + fr, fq * 8), boff = lds_byte(wc * 32 + fr, fq * 8);
#define PG8_SA(b, h) (((b) * 2 + (h)) * HTB)
#define PG8_SB(b, h) ((4 + (b) * 2 + (h)) * HTB)
#define PG8_STAGE(bufoff, gbase, voff) do { _Pragma("unroll") for (int _i = 0; _i < 2; ++_i) \
        __builtin_amdgcn_global_load_lds((const unsigned*)((const char*)(gbase) + (voff)[_i]), (PG8_LAS unsigned*)(lds + (bufoff) + ldsw + _i * 8192), 16, 0, 0); } while (0)
#define PG8_LDA(dst, b, h) do { _Pragma("unroll") for (int m = 0; m < 4; ++m) _Pragma("unroll") for (int k = 0; k < 2; ++k) dst[m][k] = *(const PG8_LAS bf16x8*)(lds + PG8_SA(b, h) + aoff + m * 2048 + k * 1024); } while (0)
#define PG8_LDB(dst, b, h) do { _Pragma("unroll") for (int n = 0; n < 2; ++n) _Pragma("unroll") for (int k = 0; k < 2; ++k) dst[n][k] = *(const PG8_LAS bf16x8*)(lds + PG8_SB(b, h) + boff + n * 2048 + k * 1024); } while (0)
#define PG8_MMA(ai, bj, At, Bt) do { __builtin_amdgcn_s_setprio(1); _Pragma("unroll") for (int m = 0; m < 4; ++m) _Pragma("unroll") for (int n = 0; n < 2; ++n) _Pragma("unroll") for (int k = 0; k < 2; ++k) \
        acc[ai][bj][m][n] = __builtin_amdgcn_mfma_f32_16x16x32_bf16(Bt[n][k], At[m][k], acc[ai][bj][m][n], 0, 0, 0); __builtin_amdgcn_s_setprio(0); } while (0)
#define PG8_WAIT_V(n) asm volatile("s_waitcnt vmcnt(" #n ")" ::: "memory")
#define PG8_WAIT_L(n) asm volatile("s_waitcnt lgkmcnt(" #n ")" ::: "memory")
#define PG8_BAR __builtin_amdgcn_s_barrier()
#define PG8_SCHED __builtin_amdgcn_sched_barrier(0)
    Unit cur, nxt; int ui = 0;
    if (!S.next(0, cur)) return;
    f32x4 acc[2][2][4][2];
#pragma unroll
    for (int a = 0; a < 2; ++a)
#pragma unroll
        for (int b = 0; b < 2; ++b)
#pragma unroll
            for (int m = 0; m < 4; ++m)
#pragma unroll
                for (int n = 0; n < 2; ++n) acc[a][b][m][n] = (f32x4){0.f, 0.f, 0.f, 0.f};
    bf16x8 At[4][2], B0[2][2], B1[2][2];
    const char* cA = (const char*)g.A + (size_t)cur.pm * tstep; const char* cB = (const char*)g.Bt + (size_t)cur.pn * tstep + ((g.pm_split > 0 && cur.pm >= g.pm_split) ? g.bt_split_bytes : (size_t)0);
    S.a_ready(cur);
    PG8_STAGE(PG8_SB(0, 0), cB, voffB); PG8_STAGE(PG8_SA(0, 0), cA, voffA); PG8_STAGE(PG8_SB(0, 1), cB + hstep, voffB); PG8_STAGE(PG8_SA(0, 1), cA + hstep, voffA);
    if (wr == 1) PG8_BAR;
    PG8_WAIT_V(4); PG8_BAR;
    PG8_STAGE(PG8_SB(1, 0), cB + kstep, voffB); PG8_STAGE(PG8_SA(1, 0), cA + kstep, voffA); PG8_STAGE(PG8_SB(1, 1), cB + hstep + kstep, voffB);
    PG8_WAIT_V(6); PG8_BAR;
    PG8_STAMP();
    for (;;) {
        const bool has_next = S.next(ui + 1, nxt);
        const char* nA = has_next ? (const char*)g.A + (size_t)nxt.pm * tstep : cA; const char* nB = has_next ? (const char*)g.Bt + (size_t)nxt.pn * tstep + ((g.pm_split > 0 && nxt.pm >= g.pm_split) ? g.bt_split_bytes : (size_t)0) : cB;
        for (int t = 0; t < nt; t += 2) {
            const bool last = (t == nt - 2);
            const char* a1 = cA + (size_t)(t + 1) * kstep;
            const char* a2 = last ? nA : cA + (size_t)(t + 2) * kstep; const char* b2 = last ? nB : cB + (size_t)(t + 2) * kstep;
            const char* a3 = a2 + kstep; const char* b3 = b2 + kstep;
            if (last && has_next) S.a_ready(nxt);
            PG8_LDB(B0, 0, 0); PG8_SCHED; PG8_LDA(At, 0, 0); PG8_STAGE(PG8_SA(1, 1), a1 + hstep, voffA);
            PG8_WAIT_L(8); PG8_BAR; PG8_WAIT_L(0); PG8_MMA(0, 0, At, B0); PG8_BAR; PG8_SCHED;
            PG8_LDB(B1, 0, 1); PG8_STAGE(PG8_SB(0, 0), b2, voffB);
            PG8_BAR; PG8_WAIT_L(0); PG8_MMA(0, 1, At, B1); PG8_BAR;
            PG8_LDA(At, 0, 1); PG8_STAGE(PG8_SA(0, 0), a2, voffA);
            PG8_BAR; PG8_WAIT_L(0); PG8_MMA(1, 0, At, B0); PG8_BAR; PG8_SCHED;
            PG8_STAGE(PG8_SB(0, 1), b2 + hstep, voffB);
            PG8_WAIT_V(6); PG8_BAR; PG8_MMA(1, 1, At, B1); PG8_BAR;
            PG8_LDB(B0, 1, 0); PG8_SCHED; PG8_LDA(At, 1, 0); PG8_STAGE(PG8_SA(0, 1), a2 + hstep, voffA);
            PG8_WAIT_L(8); PG8_BAR; PG8_WAIT_L(0); PG8_MMA(0, 0, At, B0); PG8_BAR; PG8_SCHED;
            PG8_LDB(B1, 1, 1); PG8_STAGE(PG8_SB(1, 0), b3, voffB);
            PG8_BAR; PG8_WAIT_L(0); PG8_MMA(0, 1, At, B1); PG8_BAR;
            PG8_LDA(At, 1, 1); PG8_STAGE(PG8_SA(1, 0), a3, voffA);
            PG8_BAR; PG8_WAIT_L(0); PG8_MMA(1, 0, At, B0); PG8_BAR; PG8_SCHED;
            PG8_STAGE(PG8_SB(1, 1), b3 + hstep, voffB);
            PG8_WAIT_V(6); PG8_BAR; PG8_MMA(1, 1, At, B1); PG8_BAR;
        }
        PG8_STAMP();
        if constexpr (!Epi::AFTER_DRAIN) { E(acc, cur, wr, wc, fr, fq); S.done(cur); }
        PG8_STAMP();
        if (!has_next) break;
#pragma unroll
        for (int a = 0; a < 2; ++a)
#pragma unroll
            for (int b = 0; b < 2; ++b)
#pragma unroll
                for (int m = 0; m < 4; ++m)
#pragma unroll
                    for (int n = 0; n < 2; ++n) acc[a][b][m][n] = (f32x4){0.f, 0.f, 0.f, 0.f};
        cur = nxt; cA = nA; cB = nB; ++ui;
    }
    PG8_WAIT_V(0);
    if (wr == 0) PG8_BAR;
    PG8_BAR;
    if constexpr (Epi::AFTER_DRAIN) { E.fused(acc, cur, wr, wc, fr, fq, lds, wid, lane); S.done(cur); }
    PG8_STAMP();
    if (STAMP && wid == 0) { stamps[lane] = lane < nts ? (((unsigned long long)(unsigned)ts_hi << 32) | (unsigned)ts_lo) : 0ull;
        if (lane == 62) stamps[62] = rt_entry; if (lane == 63) stamps[63] = (unsigned long long)wall_clock64(); }
#undef PG8_STAMP
#undef PG8_SA
#undef PG8_SB
#undef PG8_STAGE
#undef PG8_LDA
#undef PG8_LDB
#undef PG8_MMA
#undef PG8_WAIT_V
#undef PG8_WAIT_L
#undef PG8_BAR
#undef PG8_SCHED
}
}

#define LAS __attribute__((address_space(3)))
typedef unsigned short bf16_t;
typedef short bf16x8 __attribute__((ext_vector_type(8)));
typedef short bf16x4 __attribute__((ext_vector_type(4)));
typedef float f32x4 __attribute__((ext_vector_type(4)));
typedef unsigned u32x4 __attribute__((ext_vector_type(4)));
typedef unsigned u32x2 __attribute__((ext_vector_type(2)));

constexpr int D = 1024, NB = 2, SEQ = 8192, MTOK = NB * SEQ, MEMLEN = 256;
constexpr int NPROJ = 2304;
constexpr int C_MQ = 0, C_MK = 256, C_MV = 512, C_MO = 1024, C_AQ = 1536, C_AK = 2048, C_AV = 2176;
constexpr float EPS = 1e-6f;
constexpr int NTHREADS = 512, NWAVES = 8;
constexpr int LDS_BYTES = 144 * 1024;

constexpr size_t MiB = (size_t)1 << 20;
constexpr size_t WS_A = 0;
constexpr size_t WS_B = 72 * MiB;
constexpr size_t WS_C = 104 * MiB;
constexpr size_t WS_ED = 136 * MiB;
constexpr size_t WS_EU = 152 * MiB;
constexpr size_t WS_WIN = 200 * MiB;
constexpr size_t WS_WOUT = WS_WIN + 2304 * 1024 * 2;
constexpr size_t WS_WXQ = WS_WOUT + 2 * MiB;
constexpr size_t WS_WXKV = WS_WXQ + 2 * MiB;
constexpr size_t WS_WXO = WS_WXKV + 4 * MiB;
constexpr size_t WS_WPQ = WS_WXO + 2 * MiB;
constexpr size_t WS_G = 219 * MiB;
constexpr size_t WS_GATES = WS_G;
constexpr size_t WS_KMEM = WS_GATES + 512 * 1024;
constexpr size_t WS_VTMEM = WS_KMEM + MiB;
constexpr size_t WS_SSQ = WS_VTMEM + MiB;
constexpr size_t WS_DN = WS_SSQ + MiB;
constexpr size_t WS_DECAY = WS_DN + 256 * 1024;
constexpr size_t WS_SK = WS_DECAY + 4096;
constexpr size_t WS_ESC = WS_SK + 65536;
constexpr size_t WS_SELE = WS_A + 64 * MiB;
constexpr size_t WS_SELG = WS_C;
constexpr size_t WS_COEF = WS_C + 8 * MiB;
constexpr size_t WS_R2 = WS_C + 16 * MiB;
constexpr size_t WS_SSQ3 = WS_C + 17 * MiB;
constexpr size_t WS_PART = WS_A;
constexpr size_t WS_ST = 168 * MiB;
constexpr size_t WS_HQH = 168 * MiB;
constexpr size_t WS_HQL = 184 * MiB;
constexpr size_t WS_HS = WS_C + 18 * MiB;
constexpr size_t WS_CS = WS_C + 19 * MiB;
constexpr size_t WS_BAR = 223 * MiB;
constexpr size_t WS_BTO = 224 * MiB;
constexpr size_t WS_WGR = 228 * MiB;
constexpr size_t WS_END = 232 * MiB;

struct Args {
    const float* in[24];
    float* out;
    unsigned char* ws;
    int ph_lo, ph_hi;
};
enum { I_X = 0, I_MEM, I_GMIX, I_WIN, I_CONVW, I_CONVB, I_BI, I_BF, I_GMHEAD, I_SINKS, I_WOUT, I_GCROSS, I_GMEM, I_WXQ, I_WXK, I_WXV, I_WXO,
       I_GFFN, I_WPQ, I_SK1, I_SK2, I_EDOWN, I_EUP, I_GFINAL };

typedef __bf16 bf16x2_t __attribute__((ext_vector_type(2)));
typedef float f32x2_t __attribute__((ext_vector_type(2)));
__device__ __forceinline__ unsigned pk2(float lo, float hi) { f32x2_t v = {lo, hi}; bf16x2_t b = __builtin_convertvector(v, bf16x2_t); return __builtin_bit_cast(unsigned, b); }
__device__ __forceinline__ bf16_t f2bf(float f) { return (bf16_t)(pk2(f, 0.f) & 0xffffu); }
__device__ __forceinline__ float bf2f(unsigned b) { return __uint_as_float(b << 16); }
__device__ __forceinline__ float bflo(unsigned w) { return __uint_as_float(w << 16); }
__device__ __forceinline__ float bfhi(unsigned w) { return __uint_as_float(w & 0xffff0000u); }
__device__ __forceinline__ float wave_sum(float v) {
#pragma unroll
    for (int o = 1; o < 64; o <<= 1) v += __shfl_xor(v, o);
    return v;
}
__device__ __forceinline__ float sigmoidf_(float x) { return 1.f / (1.f + __expf(-x)); }
#define LDS_FENCE() asm volatile("s_waitcnt lgkmcnt(0)" ::: "memory")

__device__ __forceinline__ unsigned dppu(unsigned x, int ctrl_sel) {
    switch (ctrl_sel) {
        case 0: return (unsigned)__builtin_amdgcn_update_dpp(0, (int)x, 0xB1, 0xF, 0xF, true);
        case 1: return (unsigned)__builtin_amdgcn_update_dpp(0, (int)x, 0x4E, 0xF, 0xF, true);
        case 2: return (unsigned)__builtin_amdgcn_update_dpp(0, (int)x, 0x141, 0xF, 0xF, true);
        default: return (unsigned)__builtin_amdgcn_update_dpp(0, (int)x, 0x140, 0xF, 0xF, true);
    }
}
__device__ __forceinline__ unsigned row16_max_u32(unsigned x) {
    unsigned y;
    y = dppu(x, 0); x = x > y ? x : y;
    y = dppu(x, 1); x = x > y ? x : y;
    y = dppu(x, 2); x = x > y ? x : y;
    y = dppu(x, 3); x = x > y ? x : y;
    return x;
}
__device__ __forceinline__ float row16_sum_f32(float x) {
    x += __uint_as_float(dppu(__float_as_uint(x), 0));
    x += __uint_as_float(dppu(__float_as_uint(x), 1));
    x += __uint_as_float(dppu(__float_as_uint(x), 2));
    x += __uint_as_float(dppu(__float_as_uint(x), 3));
    return x;
}
__device__ __forceinline__ float row16_max_f32(float x) {
    x = fmaxf(x, __uint_as_float(dppu(__float_as_uint(x), 0)));
    x = fmaxf(x, __uint_as_float(dppu(__float_as_uint(x), 1)));
    x = fmaxf(x, __uint_as_float(dppu(__float_as_uint(x), 2)));
    x = fmaxf(x, __uint_as_float(dppu(__float_as_uint(x), 3)));
    return x;
}
__device__ __forceinline__ f32x4 mfma16(bf16x8 a, bf16x8 b, f32x4 c) { return __builtin_amdgcn_mfma_f32_16x16x32_bf16(a, b, c, 0, 0, 0); }

__device__ __forceinline__ float row_rscale(const float* ssq, int row) {
    float s = 0.f;
#pragma unroll
    for (int p = 0; p < 16; ++p) s += ssq[(size_t)p * MTOK + row];
    return rsqrtf(s * (1.f / D) + EPS);
}
struct EpiRowBf16 {
    static constexpr bool PERM = true, AFTER_DRAIN = false;
    bf16_t* O; int ldc; const float* ssq; float mul;
    __device__ __forceinline__ void operator()(const f32x4 (&acc)[2][2][4][2], const pg8::Unit& u, int wr, int wc, int fr, int fq) const {
        const int row0 = u.pm * 256 + wr * 64 + fr, col0 = u.pn * 256 + wc * 32 + 8 * fq;
#pragma unroll
        for (int ai = 0; ai < 2; ++ai)
#pragma unroll
            for (int m = 0; m < 4; ++m) {
                const int row = row0 + ai * 128 + m * 16;
                const float sc = ssq ? row_rscale(ssq, row) * mul : mul;
                bf16_t* rowp = O + (size_t)row * ldc + col0;
#pragma unroll
                for (int bj = 0; bj < 2; ++bj) {
                    const f32x4 v0 = acc[ai][bj][m][0] * sc, v1 = acc[ai][bj][m][1] * sc;
                    u32x4 w; w.x = pk2(v0[0], v0[1]); w.y = pk2(v0[2], v0[3]); w.z = pk2(v1[0], v1[1]); w.w = pk2(v1[2], v1[3]);
                    *(u32x4*)(rowp + bj * 128) = w;
                }
            }
    }
};
template <bool RES_BF16>
struct EpiResid {
    static constexpr bool PERM = true, AFTER_DRAIN = false;
    const void* R; bf16_t* Hb; float* ssq;
    __device__ __forceinline__ void operator()(const f32x4 (&acc)[2][2][4][2], const pg8::Unit& u, int wr, int wc, int fr, int fq) const {
        const int row0 = u.pm * 256 + wr * 64 + fr, col0 = u.pn * 256 + wc * 32 + 8 * fq;
#pragma unroll
        for (int ai = 0; ai < 2; ++ai)
#pragma unroll
            for (int m = 0; m < 4; ++m) {
                const int row = row0 + ai * 128 + m * 16;
                const size_t off = (size_t)row * D + col0;
                float ss = 0.f;
#pragma unroll
                for (int bj = 0; bj < 2; ++bj) {
                    f32x4 r0, r1;
                    if (RES_BF16) { const u32x4 rb = *(const u32x4*)((const bf16_t*)R + off + bj * 128);
                        r0 = (f32x4){bflo(rb.x), bfhi(rb.x), bflo(rb.y), bfhi(rb.y)}; r1 = (f32x4){bflo(rb.z), bfhi(rb.z), bflo(rb.w), bfhi(rb.w)}; }
                    else { r0 = *(const f32x4*)((const float*)R + off + bj * 128); r1 = *(const f32x4*)((const float*)R + off + bj * 128 + 4); }
                    const f32x4 v0 = acc[ai][bj][m][0] + r0, v1 = acc[ai][bj][m][1] + r1;
                    u32x4 w; w.x = pk2(v0[0], v0[1]); w.y = pk2(v0[2], v0[3]); w.z = pk2(v1[0], v1[1]); w.w = pk2(v1[2], v1[3]);
                    *(u32x4*)(Hb + off + bj * 128) = w;
                    ss += v0[0] * v0[0] + v0[1] * v0[1] + v0[2] * v0[2] + v0[3] * v0[3] + v1[0] * v1[0] + v1[1] * v1[1] + v1[2] * v1[2] + v1[3] * v1[3];
                }
                ss += __shfl_xor(ss, 16); ss += __shfl_xor(ss, 32);
                if (fq == 0) ssq[(size_t)(u.pn * 4 + wc) * MTOK + row] = ss;
            }
    }
};
struct EpiKV {
    static constexpr bool PERM = true, AFTER_DRAIN = false;
    bf16_t* Kh; bf16_t* Vh;
    __device__ __forceinline__ void operator()(const f32x4 (&acc)[2][2][4][2], const pg8::Unit& u, int wr, int wc, int fr, int fq) const {
        const int row0 = u.pm * 256 + wr * 64 + fr, col0 = u.pn * 256 + wc * 32 + 8 * fq;
#pragma unroll
        for (int ai = 0; ai < 2; ++ai)
#pragma unroll
            for (int m = 0; m < 4; ++m) {
                const int row = row0 + ai * 128 + m * 16;
#pragma unroll
                for (int bj = 0; bj < 2; ++bj) {
                    const f32x4 v0 = acc[ai][bj][m][0], v1 = acc[ai][bj][m][1];
                    const int c = col0 + bj * 128, cc = c & 1023;
                    u32x4 w; w.x = pk2(v0[0], v0[1]); w.y = pk2(v0[2], v0[3]); w.z = pk2(v1[0], v1[1]); w.w = pk2(v1[2], v1[3]);
                    *(u32x4*)((c < 1024 ? Kh : Vh) + ((size_t)((row >> 8) * 4 + (cc >> 8)) * 256 + (row & 255)) * 256 + (cc & 255)) = w;
                }
            }
    }
};
struct EpiSoftmax {
    static constexpr bool PERM = true, AFTER_DRAIN = true;
    bf16_t* O; const float* ssq;
    __device__ __forceinline__ void operator()(const f32x4 (&)[2][2][4][2], const pg8::Unit&, int, int, int, int) const {}
    __device__ __forceinline__ void fused(const f32x4 (&acc)[2][2][4][2], const pg8::Unit& u, int wr, int wc, int fr, int fq, LAS unsigned char* lds, int wid, int lane) const {
        LAS float* red = (LAS float*)lds;
        const int row0 = u.pm * 256 + wr * 64 + fr, col0 = u.pn * 256 + wc * 32 + 8 * fq;
        float sc[2][4];
#pragma unroll
        for (int ai = 0; ai < 2; ++ai)
#pragma unroll
            for (int m = 0; m < 4; ++m) {
                sc[ai][m] = row_rscale(ssq, row0 + ai * 128 + m * 16);
                float v = -INFINITY;
#pragma unroll
                for (int bj = 0; bj < 2; ++bj)
#pragma unroll
                    for (int n = 0; n < 2; ++n)
#pragma unroll
                        for (int j = 0; j < 4; ++j) v = fmaxf(v, acc[ai][bj][m][n][j] * sc[ai][m]);
                v = fmaxf(v, __shfl_xor(v, 16)); v = fmaxf(v, __shfl_xor(v, 32));
                if (fq == 0) red[wc * 256 + ai * 128 + wr * 64 + m * 16 + fr] = v;
            }
        __syncthreads();
        float rsum[2][4], rmax[2][4];
#pragma unroll
        for (int ai = 0; ai < 2; ++ai)
#pragma unroll
            for (int m = 0; m < 4; ++m) {
                const int rl = ai * 128 + wr * 64 + m * 16 + fr;
                rmax[ai][m] = fmaxf(fmaxf(red[rl], red[256 + rl]), fmaxf(red[512 + rl], red[768 + rl]));
                float s = 0.f;
#pragma unroll
                for (int bj = 0; bj < 2; ++bj)
#pragma unroll
                    for (int n = 0; n < 2; ++n)
#pragma unroll
                        for (int j = 0; j < 4; ++j) s += __expf(acc[ai][bj][m][n][j] * sc[ai][m] - rmax[ai][m]);
                s += __shfl_xor(s, 16); s += __shfl_xor(s, 32);
                if (fq == 0) red[1024 + wc * 256 + rl] = s;
            }
        __syncthreads();
#pragma unroll
        for (int ai = 0; ai < 2; ++ai)
#pragma unroll
            for (int m = 0; m < 4; ++m) {
                const int rl = ai * 128 + wr * 64 + m * 16 + fr;
                const float inv = 1.f / ((red[1024 + rl] + red[1280 + rl]) + (red[1536 + rl] + red[1792 + rl]));
                rsum[ai][m] = inv;
                bf16_t* rowp = O + (size_t)(row0 + ai * 128 + m * 16) * D + col0;
#pragma unroll
                for (int bj = 0; bj < 2; ++bj) {
                    float e[2][4];
#pragma unroll
                    for (int n = 0; n < 2; ++n)
#pragma unroll
                        for (int j = 0; j < 4; ++j) e[n][j] = __expf(acc[ai][bj][m][n][j] * sc[ai][m] - rmax[ai][m]) * inv;
                    u32x4 w; w.x = pk2(e[0][0], e[0][1]); w.y = pk2(e[0][2], e[0][3]); w.z = pk2(e[1][0], e[1][1]); w.w = pk2(e[1][2], e[1][3]);
                    *(u32x4*)(rowp + bj * 128) = w;
                }
            }
        __syncthreads();
    }
};

__device__ __forceinline__ void p0_transpose_item(const float* W, int ldw, int col0, int K, bf16_t* WT, int row0, const float* g, LAS float* scr, int item, int nblk, int lane) {
    const int kb = item / nblk, nb = item % nblk, k0 = 64 * kb, n0 = 32 * nb;
    float tv[32];
#pragma unroll
    for (int i = 0; i < 32; ++i) tv[i] = W[(size_t)(k0 + 2 * i + (lane >> 5)) * ldw + col0 + n0 + (lane & 31)];
#pragma unroll
    for (int i = 0; i < 32; ++i) {
        const int kk = 2 * i + (lane >> 5);
        float v = tv[i];
        if (g) v *= g[k0 + kk];
        scr[kk * 33 + (lane & 31)] = v;
    }
    LDS_FENCE();
    const int c = lane & 7;
#pragma unroll
    for (int j = 0; j < 4; ++j) {
        const int n = (lane >> 3) + 8 * j; const LAS float* s = scr + (8 * c) * 33 + n;
        u32x4 o; o.x = pk2(s[0 * 33], s[1 * 33]); o.y = pk2(s[2 * 33], s[3 * 33]); o.z = pk2(s[4 * 33], s[5 * 33]); o.w = pk2(s[6 * 33], s[7 * 33]);
        *(u32x4*)(WT + (size_t)(row0 + n0 + n) * K + k0 + 8 * c) = o;
    }
    LDS_FENCE();
}
__device__ __forceinline__ void rms_row_load(const float* xrow, int lane, f32x4 (&v)[4]) {
    const f32x4* xr = (const f32x4*)xrow + lane;
#pragma unroll
    for (int j = 0; j < 4; ++j) v[j] = xr[64 * j];
}
__device__ __forceinline__ void rms_row_finish(const float* g, bf16_t* orow, int lane, f32x4 (&v)[4]) {
    float s = 0.f;
#pragma unroll
    for (int j = 0; j < 4; ++j) s += (v[j][0] * v[j][0] + v[j][1] * v[j][1]) + (v[j][2] * v[j][2] + v[j][3] * v[j][3]);
    const float r = rsqrtf(wave_sum(s) * (1.f / D) + EPS);
    unsigned long long* o8 = (unsigned long long*)orow + lane;
#pragma unroll
    for (int j = 0; j < 4; ++j) {
        const f32x4 gv = ((const f32x4*)g)[lane + 64 * j];
        v[j] = v[j] * r * gv;
        o8[64 * j] = (unsigned long long)pk2(v[j][0], v[j][1]) | ((unsigned long long)pk2(v[j][2], v[j][3]) << 32);
    }
}
__device__ __forceinline__ void p0_late_transposes(const Args& a, LAS unsigned char* lds) {
    const int tid = threadIdx.x, lane = tid & 63, wave = tid >> 6;
    if (wave < 5) return;
    const int G = gridDim.x, gw = blockIdx.x * 3 + (wave - 5), NGW = G * 3;
    unsigned char* ws = a.ws;
    LAS float* scr = (LAS float*)(lds + wave * 8704);
    constexpr int I_SQ = 16 * 32, I_HD = 4 * 32;
    constexpr int NITEMS = I_SQ + 4 * I_HD;
    for (int it = gw; it < NITEMS; it += NGW) {
        int r = it;
        if (r < I_SQ) { p0_transpose_item(a.in[I_WOUT], D, 0, D, (bf16_t*)(ws + WS_WOUT), 0, nullptr, scr, r, 32, lane); continue; } r -= I_SQ;
        { const int h = r / I_HD; p0_transpose_item(a.in[I_WXO] + (size_t)h * 256 * D, D, 0, 256, (bf16_t*)(ws + WS_WXO) + (size_t)h * 1024 * 256, 0, nullptr, scr, r % I_HD, 32, lane); }
    }
    {
        const float* wp = a.in[I_WPQ]; const float* gf = a.in[I_GFFN];
        bf16_t* wgr = (bf16_t*)(ws + WS_WGR);
        for (int i = (blockIdx.x * 3 + (wave - 5)) * 64 + lane; i < 1024 * 256; i += G * 3 * 64) {
            const int k = i >> 8, c8 = (i & 255) * 8;
            const float gk = gf[k];
            const f32x4 v0 = *(const f32x4*)(wp + (size_t)k * 2048 + c8) * gk, v1 = *(const f32x4*)(wp + (size_t)k * 2048 + c8 + 4) * gk;
            u32x4 w; w.x = pk2(v0[0], v0[1]); w.y = pk2(v0[2], v0[3]); w.z = pk2(v1[0], v1[1]); w.w = pk2(v1[2], v1[3]);
            *(u32x4*)(wgr + (size_t)k * 2048 + c8) = w;
        }
    }
    const float* wq = a.in[I_WXQ]; const float* gc = a.in[I_GCROSS];
    bf16_t* wqr = (bf16_t*)(ws + WS_WXQ);
    for (int i = (blockIdx.x * 3 + (wave - 5)) * 64 + lane; i < 1024 * 128; i += G * 3 * 64) {
        const int k = i >> 7, c8 = (i & 127) * 8, h = c8 >> 8, dh = c8 & 255;
        const float gk = gc[k] * 0.0625f;
        const f32x4 v0 = *(const f32x4*)(wq + (size_t)k * D + c8) * gk, v1 = *(const f32x4*)(wq + (size_t)k * D + c8 + 4) * gk;
        u32x4 w; w.x = pk2(v0[0], v0[1]); w.y = pk2(v0[2], v0[3]); w.z = pk2(v1[0], v1[1]); w.w = pk2(v1[2], v1[3]);
        *(u32x4*)(wqr + ((size_t)h * 1024 + k) * 256 + dh) = w;
    }
}
__device__ __forceinline__ void p0_experts(const Args& a, int part, int npart) {
    const int tid = threadIdx.x, lane = tid & 63, wave = tid >> 6;
    const int gw = part * NWAVES + wave, NGW = npart * NWAVES;
    unsigned char* ws = a.ws;
    {
        const float* gf = a.in[I_GFFN];
        float* esc = (float*)(ws + WS_ESC);
        f32x4 gv[4];
#pragma unroll
        for (int j = 0; j < 4; ++j) gv[j] = *(const f32x4*)(gf + 4 * lane + 256 * j);
        for (int r0 = 4 * gw; r0 < 2 * 16384; r0 += 4 * NGW) {
            f32x4 v[4][4];
#pragma unroll
            for (int q = 0; q < 4; ++q) {
                const int r = r0 + q; const bool up = r >= 16384; const int e = up ? r - 16384 : r;
                const float* src = (up ? a.in[I_EUP] : a.in[I_EDOWN]) + (size_t)e * D + 4 * lane;
#pragma unroll
                for (int j = 0; j < 4; ++j) v[q][j] = __builtin_nontemporal_load((const f32x4*)(src + 256 * j));
            }
#pragma unroll
            for (int q = 0; q < 4; ++q) {
                const int r = r0 + q; const bool up = r >= 16384; const int e = up ? r - 16384 : r;
                float am = 0.f;
#pragma unroll
                for (int j = 0; j < 4; ++j) { if (!up) v[q][j] = v[q][j] * gv[j];
                    am = fmaxf(am, fmaxf(fmaxf(fabsf(v[q][j][0]), fabsf(v[q][j][1])), fmaxf(fabsf(v[q][j][2]), fabsf(v[q][j][3])))); }
                am = row16_max_f32(am); am = fmaxf(am, __shfl_xor(am, 16)); am = fmaxf(am, __shfl_xor(am, 32));
                const float sc = am > 0.f ? am * (1.f / 127.f) : 1.f, inv = 1.f / sc;
                unsigned char* dstp = ws + (up ? WS_EU : WS_ED) + (size_t)(lane >> 5) * (16384 * 128) + (size_t)e * 128 + 4 * (lane & 31);
                const size_t jstep = (size_t)2 * 16384 * 128;
#pragma unroll
                for (int j = 0; j < 4; ++j) {
                    const int q0 = (int)rintf(v[q][j][0] * inv), q1 = (int)rintf(v[q][j][1] * inv), q2 = (int)rintf(v[q][j][2] * inv), q3 = (int)rintf(v[q][j][3] * inv);
                    *(unsigned*)(dstp + jstep * j) = (unsigned)(q0 & 255) | ((unsigned)(q1 & 255) << 8) | ((unsigned)(q2 & 255) << 16) | ((unsigned)q3 << 24);
                }
                if (lane == 0) esc[r] = sc;
            }
        }
    }
}
__device__ __forceinline__ void phase0(const Args& a, LAS unsigned char* lds) {
    const int tid = threadIdx.x, lane = tid & 63, wave = tid >> 6;
    const int G = gridDim.x, gw = blockIdx.x * NWAVES + wave, NGW = G * NWAVES;
    unsigned char* ws = a.ws;
    LAS float* scr = (LAS float*)(lds + wave * 8704);
    {
        constexpr int I_W1 = 16 * 48, I_W2 = 16 * 24, I_SQ = 16 * 32;
        constexpr int NITEMS = I_W1 + I_W2 + 2 * I_SQ;
        for (int it = gw; it < NITEMS; it += NGW) {
            int r = it;
            if (r < I_W1) { p0_transpose_item(a.in[I_WIN], 2312, 0, D, (bf16_t*)(ws + WS_WIN), 0, nullptr, scr, r, 48, lane); continue; } r -= I_W1;
            if (r < I_W2) { p0_transpose_item(a.in[I_WIN], 2312, 1544, D, (bf16_t*)(ws + WS_WIN), 1536, nullptr, scr, r, 24, lane); continue; } r -= I_W2;
            if (r < I_SQ) { p0_transpose_item(a.in[I_WXK], D, 0, D, (bf16_t*)(ws + WS_WXKV), 0, nullptr, scr, r, 32, lane); continue; } r -= I_SQ;
            p0_transpose_item(a.in[I_WXV], D, 0, D, (bf16_t*)(ws + WS_WXKV), 1024, nullptr, scr, r, 32, lane);
        }
    }
    {
        const size_t T = (size_t)G * NTHREADS, gt = (size_t)blockIdx.x * NTHREADS + tid;
        for (size_t i = gt; i < 2 * 16384 / 8; i += T) {
            const bool s2 = i >= 2048; const size_t j = s2 ? i - 2048 : i;
            const float* src = (s2 ? a.in[I_SK2] : a.in[I_SK1]) + j * 8;
            const f32x4 v0 = *(const f32x4*)src, v1 = *(const f32x4*)(src + 4);
            u32x4 w; w.x = pk2(v0[0], v0[1]); w.y = pk2(v0[2], v0[3]); w.z = pk2(v1[0], v1[1]); w.w = pk2(v1[2], v1[3]);
            *(u32x4*)((bf16_t*)(ws + WS_SK) + (s2 ? 16384 : 0) + j * 8) = w;
        }
    }
    {
        const float* win = a.in[I_WIN];
        float* gates = (float*)(ws + WS_GATES);
        const float* bi = a.in[I_BI]; const float* bfg = a.in[I_BF];
        LAS f32x4* wg = (LAS f32x4*)(lds + 8 * 8704);
        __syncthreads();
        for (int i = tid; i < 2048; i += NTHREADS) {
            const int ln = i & 63, e = (i >> 6) & 3, j = (i >> 8) & 3, half = i >> 10;
            wg[i] = *(const f32x4*)(win + (size_t)(4 * ln + 256 * j + e) * 2312 + 1536 + 4 * half);
        }
        __syncthreads();
        for (int rowp = 2 * gw; rowp < MTOK; rowp += 2 * NGW) {
          f32x4 vv[2][4];
          rms_row_load(a.in[I_X] + (size_t)rowp * D, lane, vv[0]); rms_row_load(a.in[I_X] + (size_t)(rowp + 1) * D, lane, vv[1]);
#pragma unroll
          for (int q = 0; q < 2; ++q) {
            const int row = rowp + q;
            f32x4 (&v)[4] = vv[q];
            rms_row_finish(a.in[I_GMIX], (bf16_t*)(ws + WS_B) + (size_t)row * D, lane, v);
            f32x4 g0 = {0.f, 0.f, 0.f, 0.f}, g1 = {0.f, 0.f, 0.f, 0.f};
#pragma unroll
            for (int j = 0; j < 4; ++j)
#pragma unroll
                for (int e = 0; e < 4; ++e) { const float xv = v[j][e]; g0 += xv * wg[(j * 4 + e) * 64 + lane]; g1 += xv * wg[1024 + (j * 4 + e) * 64 + lane]; }
            const bool b5 = lane & 32, b4 = lane & 16, b3 = lane & 8;
            f32x4 k4, s4;
#pragma unroll
            for (int i = 0; i < 4; ++i) { k4[i] = b5 ? g1[i] : g0[i]; s4[i] = b5 ? g0[i] : g1[i]; }
#pragma unroll
            for (int i = 0; i < 4; ++i) k4[i] += __shfl_xor(s4[i], 32);
            float k2a = b4 ? k4[2] : k4[0], k2b = b4 ? k4[3] : k4[1];
            k2a += __shfl_xor(b4 ? k4[0] : k4[2], 16); k2b += __shfl_xor(b4 ? k4[1] : k4[3], 16);
            float k1 = (b3 ? k2b : k2a) + __shfl_xor(b3 ? k2a : k2b, 8);
            k1 += __uint_as_float(dppu(__float_as_uint(k1), 0)); k1 += __uint_as_float(dppu(__float_as_uint(k1), 1)); k1 += __uint_as_float(dppu(__float_as_uint(k1), 2));
            if ((lane & 7) == 0) {
                const int c = lane >> 3;
                float val = k1;
                if (c < 4) val += bi[c];
                else { const float f = val + bfg[c - 4]; val = fminf(f, 0.f) - log1pf(__expf(-fabsf(f))); }
                gates[(size_t)row * 8 + c] = val;
            }
          }
        }
    }
    for (int row = gw; row < NB * MEMLEN; row += NGW) {
        f32x4 v[4];
        rms_row_load(a.in[I_MEM] + (size_t)row * D, lane, v);
        rms_row_finish(a.in[I_GMEM], (bf16_t*)(ws + WS_C) + (size_t)row * D, lane, v);
    }
}

constexpr int LQ = 72;
__device__ __forceinline__ void conv8_load(const bf16_t* src, int tok_in_seq, u32x4 (&xv)[4]) {
#pragma unroll
    for (int j = 0; j < 4; ++j) { const int d = (tok_in_seq - 3 + j >= 0) ? j - 3 : 0; xv[j] = *(const u32x4*)(src + (ptrdiff_t)d * NPROJ); }
}
__device__ __forceinline__ void conv8_finish(const u32x4 (&xv)[4], int tok_in_seq, const float* cw, const float* cb, int ch, float (&y)[8]) {
#pragma unroll
    for (int e = 0; e < 8; ++e) y[e] = cb[ch + e];
#pragma unroll
    for (int j = 0; j < 4; ++j) {
        const float m = (tok_in_seq - 3 + j >= 0) ? 1.f : 0.f;
        const f32x4 w0 = *(const f32x4*)(cw + j * 512 + ch) * m, w1 = *(const f32x4*)(cw + j * 512 + ch + 4) * m;
        y[0] += w0[0] * bflo(xv[j].x); y[1] += w0[1] * bfhi(xv[j].x); y[2] += w0[2] * bflo(xv[j].y); y[3] += w0[3] * bfhi(xv[j].y);
        y[4] += w1[0] * bflo(xv[j].z); y[5] += w1[1] * bfhi(xv[j].z); y[6] += w1[2] * bflo(xv[j].w); y[7] += w1[3] * bfhi(xv[j].w);
    }
#pragma unroll
    for (int e = 0; e < 8; ++e) y[e] = y[e] * sigmoidf_(y[e]);
}
__device__ __forceinline__ void conv8(const bf16_t* src, int tok_in_seq, const float* cw, const float* cb, int ch, float (&y)[8]) {
    u32x4 xv[4]; conv8_load(src, tok_in_seq, xv); conv8_finish(xv, tok_in_seq, cw, cb, ch, y);
}
__device__ __forceinline__ float chunk_cumsum(float lf, int lane) {
    float b = lf;
#pragma unroll
    for (int o = 1; o < 64; o <<= 1) { const float t = __shfl_up(b, o); if (lane >= o) b += t; }
    return b;
}

__device__ __forceinline__ void mlstm_local(const Args& a, LAS unsigned char* lds, int task) {
    const int tid = threadIdx.x, lane = tid & 63, wave = tid >> 6;
    const int b = task >> 9, h = (task >> 7) & 3, c = task & 127;
    const int row0 = b * SEQ + c * 64;
    const bf16_t* proj = (const bf16_t*)(a.ws + WS_A);
    const float* gates = (const float*)(a.ws + WS_GATES);
    LAS bf16_t* VTw = (LAS bf16_t*)lds;
    LAS bf16_t* KT = (LAS bf16_t*)(lds + 144 * LQ * 2);
    LAS float* wS = (LAS float*)(lds + 144 * LQ * 2 + 64 * LQ * 2);
    if (wave == 0) {
        const float ig = gates[(size_t)(row0 + lane) * 8 + h], lf = gates[(size_t)(row0 + lane) * 8 + 4 + h];
        const float bs = chunk_cumsum(lf, lane);
        const float bL = __shfl(bs, 63);
        wS[lane] = __expf(bL - bs + ig);
        if (lane == 63) ((float*)(a.ws + WS_DECAY))[task] = __expf(bL);
    }
    {
        const int s = tid >> 3, cg = (tid & 7) * 8;
        float y[8];
        conv8(proj + (size_t)(row0 + s) * NPROJ + C_MK + h * 64 + cg, c * 64 + s, a.in[I_CONVW], a.in[I_CONVB], 256 + h * 64 + cg, y);
#pragma unroll
        for (int e = 0; e < 8; ++e) KT[(cg + e) * LQ + s] = f2bf(y[e]);
    }
    __syncthreads();
    {
        const int s = tid >> 3, vg = (tid & 7) * 16;
        const float w = wS[s];
        const u32x4 x0 = *(const u32x4*)(proj + (size_t)(row0 + s) * NPROJ + C_MV + h * 128 + vg), x1 = *(const u32x4*)(proj + (size_t)(row0 + s) * NPROJ + C_MV + h * 128 + vg + 8);
        const unsigned xs[8] = {x0.x, x0.y, x0.z, x0.w, x1.x, x1.y, x1.z, x1.w};
#pragma unroll
        for (int e = 0; e < 8; ++e) { VTw[(vg + 2 * e) * LQ + s] = f2bf(w * bflo(xs[e])); VTw[(vg + 2 * e + 1) * LQ + s] = f2bf(w * bfhi(xs[e])); }
        if ((tid & 7) == 0) VTw[128 * LQ + s] = f2bf(w);
        for (int i = tid; i < 15 * 64; i += NTHREADS) VTw[(129 + (i >> 6)) * LQ + (i & 63)] = 0;
    }
    __syncthreads();
    float* dC = (float*)(a.ws + WS_B) + (size_t)task * 8192;
    float* dn = (float*)(a.ws + WS_DN) + (size_t)task * 64;
    for (int T = wave; T < 36; T += 8) {
        const int mt = T >> 2, nt = T & 3;
        f32x4 acc = {0.f, 0.f, 0.f, 0.f};
#pragma unroll
        for (int ks = 0; ks < 2; ++ks) {
            const bf16x8 av = *(const LAS bf16x8*)(VTw + (mt * 16 + (lane & 15)) * LQ + ks * 32 + 8 * (lane >> 4));
            const bf16x8 bv = *(const LAS bf16x8*)(KT + (nt * 16 + (lane & 15)) * LQ + ks * 32 + 8 * (lane >> 4));
            acc = mfma16(av, bv, acc);
        }
        const int col = nt * 16 + (lane & 15);
        if (mt < 8) {
#pragma unroll
            for (int r = 0; r < 4; ++r) dC[(mt * 16 + (lane >> 4) * 4 + r) * 64 + col] = acc[r];
        } else if ((lane >> 4) == 0) dn[col] = acc[0];
    }
    __syncthreads();
}

__device__ __forceinline__ void mlstm_scan(const Args& a) {
    const size_t T = (size_t)gridDim.x * NTHREADS;
    const float* decay = (const float*)(a.ws + WS_DECAY);
    for (size_t chain = ((size_t)(threadIdx.x >> 6) * gridDim.x + blockIdx.x) * 64 + (threadIdx.x & 63); chain < 8 * 8256; chain += T) {
        const int bh = (int)(chain / 8256), e = (int)(chain % 8256);
        float* p; size_t stride; bf16_t* pst = nullptr;
        if (e < 8192) { p = (float*)(a.ws + WS_B) + (size_t)bh * 128 * 8192 + e; stride = 8192; pst = (bf16_t*)(a.ws + WS_ST) + (size_t)bh * 128 * 8192 + e; }
        else { p = (float*)(a.ws + WS_DN) + (size_t)bh * 128 * 64 + (e - 8192); stride = 64; }
        float C = 0.f;
        for (int c0 = 0; c0 < 128; c0 += 32) {
            float t[32], dk[32];
#pragma unroll
            for (int j = 0; j < 32; ++j) { t[j] = p[(size_t)(c0 + j) * stride]; dk[j] = decay[bh * 128 + c0 + j]; }
#pragma unroll
            for (int j = 0; j < 32; ++j) {
                if (pst) pst[(size_t)(c0 + j) * 8192] = f2bf(C); else p[(size_t)(c0 + j) * stride] = C;
                C = dk[j] * C + t[j];
            }
        }
    }
}

__device__ __forceinline__ void mlstm_out(const Args& a, LAS unsigned char* lds, int task) {
    const int tid = threadIdx.x, lane = tid & 63, wave = tid >> 6;
    const int b = task >> 9, h = (task >> 7) & 3, c = task & 127;
    const int row0 = b * SEQ + c * 64;
    const bf16_t* proj = (const bf16_t*)(a.ws + WS_A);
    const float* gates = (const float*)(a.ws + WS_GATES);
    LAS bf16_t* Qs = (LAS bf16_t*)lds;
    LAS bf16_t* Ks = Qs + 64 * LQ;
    LAS bf16_t* Qp = Ks + 64 * LQ;
    LAS bf16_t* Ps = Qp + 64 * LQ;
    LAS bf16_t* VT = Ps + 64 * LQ;
    LAS bf16_t* Cs = VT + 144 * LQ;
    LAS float* bS = (LAS float*)(Cs + 144 * LQ);
    LAS float* iS = bS + 64;
    LAS float* denS = iS + 64;
    LAS float* ssqS = denS + 64;
    const float ig_l = gates[(size_t)(row0 + lane) * 8 + h], lf_l = gates[(size_t)(row0 + lane) * 8 + 4 + h];
    const float b_l = chunk_cumsum(lf_l, lane);
    if (wave == 0) { bS[lane] = b_l; iS[lane] = ig_l; }
    const float eb_s = __expf(__shfl(b_l, tid >> 3));
    u32x4 qtap[4];
    conv8_load(proj + (size_t)(row0 + (tid >> 3)) * NPROJ + C_MQ + h * 64 + (tid & 7) * 8, c * 64 + (tid >> 3), qtap);
    bf16_t mo_pre[4][4];
#pragma unroll
    for (int r = 0; r < 4; ++r)
#pragma unroll
        for (int i = 0; i < 4; ++i)
            mo_pre[r][i] = proj[(size_t)(row0 + (wave & 3) * 16 + (lane >> 4) * 4 + r) * NPROJ + C_MO + h * 128 + ((wave >> 2) * 4 + i) * 16 + (lane & 15)];
    {
        const int s = tid >> 3, cg = (tid & 7) * 8;
        float y[8];
        conv8(proj + (size_t)(row0 + s) * NPROJ + C_MK + h * 64 + cg, c * 64 + s, a.in[I_CONVW], a.in[I_CONVB], 256 + h * 64 + cg, y);
        u32x4 w; w.x = pk2(y[0], y[1]); w.y = pk2(y[2], y[3]); w.z = pk2(y[4], y[5]); w.w = pk2(y[6], y[7]);
        *(LAS u32x4*)(Ks + s * LQ + cg) = w;
        const int vg = (tid & 7) * 16;
        const u32x4 x0 = *(const u32x4*)(proj + (size_t)(row0 + s) * NPROJ + C_MV + h * 128 + vg), x1 = *(const u32x4*)(proj + (size_t)(row0 + s) * NPROJ + C_MV + h * 128 + vg + 8);
        const unsigned xs[8] = {x0.x, x0.y, x0.z, x0.w, x1.x, x1.y, x1.z, x1.w};
#pragma unroll
        for (int e = 0; e < 8; ++e) { VT[(vg + 2 * e) * LQ + s] = (bf16_t)(xs[e] & 0xffffu); VT[(vg + 2 * e + 1) * LQ + s] = (bf16_t)(xs[e] >> 16); }
        if ((tid & 7) == 0) VT[128 * LQ + s] = 0x3F80;
        for (int i = tid; i < 15 * 64; i += NTHREADS) { VT[(129 + (i >> 6)) * LQ + (i & 63)] = 0; Cs[(129 + (i >> 6)) * LQ + (i & 63)] = 0; }
        const bf16_t* st = (const bf16_t*)(a.ws + WS_ST) + (size_t)task * 8192;
        const int v = tid >> 2, k0 = (tid & 3) * 16;
        *(LAS u32x4*)(Cs + v * LQ + k0) = *(const u32x4*)(st + v * 64 + k0);
        *(LAS u32x4*)(Cs + v * LQ + k0 + 8) = *(const u32x4*)(st + v * 64 + k0 + 8);
        if (tid < 64) Cs[128 * LQ + tid] = f2bf(((const float*)(a.ws + WS_DN))[(size_t)task * 64 + tid]);
    }
    {
        const int s = tid >> 3, cg = (tid & 7) * 8;
        float y[8];
        conv8_finish(qtap, c * 64 + s, a.in[I_CONVW], a.in[I_CONVB], h * 64 + cg, y);
        const float eb = eb_s;
#pragma unroll
        for (int e = 0; e < 8; ++e) y[e] *= 0.125f;
        u32x4 w; w.x = pk2(y[0], y[1]); w.y = pk2(y[2], y[3]); w.z = pk2(y[4], y[5]); w.w = pk2(y[6], y[7]);
        *(LAS u32x4*)(Qs + s * LQ + cg) = w;
        w.x = pk2(y[0] * eb, y[1] * eb); w.y = pk2(y[2] * eb, y[3] * eb); w.z = pk2(y[4] * eb, y[5] * eb); w.w = pk2(y[6] * eb, y[7] * eb);
        *(LAS u32x4*)(Qp + s * LQ + cg) = w;
    }
    __syncthreads();
    {
        const int mt = wave >> 1;
#pragma unroll
        for (int i = 0; i < 2; ++i) {
            const int nt = (wave & 1) * 2 + i;
            f32x4 acc = {0.f, 0.f, 0.f, 0.f};
#pragma unroll
            for (int ks = 0; ks < 2; ++ks) {
                const bf16x8 av = *(const LAS bf16x8*)(Qs + (mt * 16 + (lane & 15)) * LQ + ks * 32 + 8 * (lane >> 4));
                const bf16x8 bv = *(const LAS bf16x8*)(Ks + (nt * 16 + (lane & 15)) * LQ + ks * 32 + 8 * (lane >> 4));
                acc = mfma16(av, bv, acc);
            }
            const int s = nt * 16 + (lane & 15);
            const float bs = bS[s], is = iS[s];
#pragma unroll
            for (int r = 0; r < 4; ++r) {
                const int t = mt * 16 + (lane >> 4) * 4 + r;
                const float p = (s <= t) ? acc[r] * __expf(bS[t] - bs + is) : 0.f;
                Ps[t * LQ + s] = f2bf(p);
            }
        }
    }
    __syncthreads();
    const int mt = wave & 3, ng = wave >> 2;
    f32x4 acc[5];
#pragma unroll
    for (int i = 0; i < 5; ++i) acc[i] = (f32x4){0.f, 0.f, 0.f, 0.f};
#pragma unroll
    for (int ks = 0; ks < 4; ++ks) {
        const LAS bf16_t* Ab = (ks < 2) ? Ps : Qp; const LAS bf16_t* Bb = (ks < 2) ? VT : Cs;
        const int ko = (ks & 1) * 32 + 8 * (lane >> 4);
        const bf16x8 av = *(const LAS bf16x8*)(Ab + (mt * 16 + (lane & 15)) * LQ + ko);
#pragma unroll
        for (int i = 0; i < 4; ++i) {
            const bf16x8 bv = *(const LAS bf16x8*)(Bb + ((ng * 4 + i) * 16 + (lane & 15)) * LQ + ko);
            acc[i] = mfma16(av, bv, acc[i]);
        }
        {
            const bf16x8 bv = *(const LAS bf16x8*)(Bb + (128 + (lane & 15)) * LQ + ko);
            acc[4] = mfma16(av, bv, acc[4]);
        }
    }
    float rinv[4];
#pragma unroll
    for (int r = 0; r < 4; ++r) {
        const float den = __uint_as_float((unsigned)__builtin_amdgcn_ds_bpermute((lane & 48) * 4, (int)__float_as_uint(acc[4][r])));
        rinv[r] = 1.f / fmaxf(fabsf(den), 1.f);
        float ss = 0.f;
#pragma unroll
        for (int i = 0; i < 4; ++i) { acc[i][r] *= rinv[r]; ss += acc[i][r] * acc[i][r]; }
        ss = row16_sum_f32(ss);
        if ((lane & 15) == 0) ssqS[ng * 64 + mt * 16 + (lane >> 4) * 4 + r] = ss;
    }
    __syncthreads();
    bf16_t* mix = (bf16_t*)(a.ws + WS_C);
    const float* gmh = a.in[I_GMHEAD];
#pragma unroll
    for (int r = 0; r < 4; ++r) {
        const int t = mt * 16 + (lane >> 4) * 4 + r;
        const float rn = rsqrtf((ssqS[t] + ssqS[64 + t]) * (1.f / 128.f) + EPS);
#pragma unroll
        for (int i = 0; i < 4; ++i) {
            const int v = (ng * 4 + i) * 16 + (lane & 15);
            const float mo = bf2f(mo_pre[r][i]);
            mix[(size_t)(row0 + t) * D + h * 128 + v] = f2bf(acc[i][r] * rn * gmh[h * 128 + v] * sigmoidf_(mo));
        }
    }
    __syncthreads();
}

constexpr int LV = 264;
__device__ __forceinline__ void swa_task(const Args& a, LAS unsigned char* lds, int task) {
    const int tid = threadIdx.x, lane = tid & 63, wave = tid >> 6;
    const int b = task >> 7, kvh = (task >> 6) & 1, blk = task & 63, qh = kvh * 4 + (wave >> 1);
    const int rowq0 = b * SEQ + blk * 128;
    const bf16_t* proj = (const bf16_t*)(a.ws + WS_A);
    LAS bf16_t* Ksm = (LAS bf16_t*)lds;
    LAS bf16_t* VTs = Ksm + 256 * LQ;
    {
        const int j = tid >> 1, half = tid & 1;
        const bool ex = (blk > 0) || (j >= 128);
        u32x4 kv[4], vv[4];
#pragma unroll
        for (int i = 0; i < 4; ++i) { kv[i] = (u32x4){0u, 0u, 0u, 0u}; vv[i] = (u32x4){0u, 0u, 0u, 0u}; }
        if (ex) {
            const bf16_t* kp = proj + (size_t)(rowq0 - 128 + j) * NPROJ + C_AK + kvh * 64 + half * 32;
            const bf16_t* vp = proj + (size_t)(rowq0 - 128 + j) * NPROJ + C_AV + kvh * 64 + half * 32;
#pragma unroll
            for (int i = 0; i < 4; ++i) { kv[i] = *(const u32x4*)(kp + 8 * i); vv[i] = *(const u32x4*)(vp + 8 * i); }
        }
#pragma unroll
        for (int i = 0; i < 4; ++i) {
            *(LAS u32x4*)(Ksm + j * LQ + half * 32 + 8 * i) = kv[i];
            const unsigned xs[4] = {vv[i].x, vv[i].y, vv[i].z, vv[i].w};
#pragma unroll
            for (int e = 0; e < 4; ++e) { VTs[(half * 32 + 8 * i + 2 * e) * LV + j] = (bf16_t)(xs[e] & 0xffffu); VTs[(half * 32 + 8 * i + 2 * e + 1) * LV + j] = (bf16_t)(xs[e] >> 16); }
        }
    }
    __syncthreads();
#pragma unroll 1
    for (int qk = 0; qk < 4; ++qk) {
    const int qtile = (wave & 1) * 4 + qk;
    const int qi = 16 * qtile + (lane & 15);
    bf16x8 qf[2];
#pragma unroll
    for (int ks = 0; ks < 2; ++ks) qf[ks] = *(const bf16x8*)(proj + (size_t)(rowq0 + qi) * NPROJ + C_AQ + qh * 64 + ks * 32 + 8 * (lane >> 4));
    f32x4 sc[10];
    const float sink = a.in[I_SINKS][qh];
    float mx = sink;
#pragma unroll
    for (int t = 0; t < 9; ++t) {
        const int kt = qtile + t;
        f32x4 acc = {0.f, 0.f, 0.f, 0.f};
#pragma unroll
        for (int ks = 0; ks < 2; ++ks) {
            const bf16x8 kf = *(const LAS bf16x8*)(Ksm + (kt * 16 + (lane & 15)) * LQ + ks * 32 + 8 * (lane >> 4));
            acc = mfma16(kf, qf[ks], acc);
        }
#pragma unroll
        for (int r = 0; r < 4; ++r) {
            const int j = kt * 16 + (lane >> 4) * 4 + r;
            const bool valid = (j >= qi + 1) && (j <= qi + 128) && (blk > 0 || j >= 128);
            acc[r] = valid ? acc[r] * 0.125f : -INFINITY;
            mx = fmaxf(mx, acc[r]);
        }
        sc[t] = acc;
    }
    mx = fmaxf(mx, __shfl_xor(mx, 16)); mx = fmaxf(mx, __shfl_xor(mx, 32));
    float sum = 0.f;
#pragma unroll
    for (int t = 0; t < 9; ++t)
#pragma unroll
        for (int r = 0; r < 4; ++r) { const float p = __expf(sc[t][r] - mx); sc[t][r] = p; sum += p; }
    sum += __shfl_xor(sum, 16); sum += __shfl_xor(sum, 32);
    const float inv = 1.f / (sum + __expf(sink - mx));
    sc[9] = (f32x4){0.f, 0.f, 0.f, 0.f};
    bf16x8 pf[5];
#pragma unroll
    for (int p = 0; p < 5; ++p) {
        const f32x4 x0 = sc[2 * p] * inv, x1 = sc[2 * p + 1] * inv;
        u32x4 w; w.x = pk2(x0[0], x0[1]); w.y = pk2(x0[2], x0[3]); w.z = pk2(x1[0], x1[1]); w.w = pk2(x1[2], x1[3]);
        pf[p] = __builtin_bit_cast(bf16x8, w);
    }
    bf16_t* mix = (bf16_t*)(a.ws + WS_C);
#pragma unroll
    for (int dt = 0; dt < 4; ++dt) {
        f32x4 acc = {0.f, 0.f, 0.f, 0.f};
#pragma unroll
        for (int p = 0; p < 5; ++p) {
            const int k0 = qtile + 2 * p, k1 = (k0 + 1 > 15) ? 15 : k0 + 1;
            const LAS bf16_t* vr = VTs + (dt * 16 + (lane & 15)) * LV + 4 * (lane >> 4);
            const u32x2 lo = *(const LAS u32x2*)(vr + k0 * 16), hi = *(const LAS u32x2*)(vr + k1 * 16);
            const u32x4 w = {lo.x, lo.y, hi.x, hi.y};
            acc = mfma16(__builtin_bit_cast(bf16x8, w), pf[p], acc);
        }
        u32x2 o; o.x = pk2(acc[0], acc[1]); o.y = pk2(acc[2], acc[3]);
        *(u32x2*)(mix + (size_t)(rowq0 + qi) * D + 512 + qh * 64 + dt * 16 + 4 * (lane >> 4)) = o;
    }
    }
    __syncthreads();
}


#ifndef PEER_HQ_LO
#define PEER_HQ_LO 0
#endif
constexpr int LSK = 136;
__device__ __forceinline__ unsigned f2sort(float f) { const unsigned u = __float_as_uint(f); return u ^ ((unsigned)((int)u >> 31) | 0x80000000u); }
__device__ __forceinline__ float sort2f(unsigned s) { return __uint_as_float((s & 0x80000000u) ? (s ^ 0x80000000u) : ~s); }

#define CE_(i, j) { const unsigned hi_ = key[i][r] > key[j][r] ? key[i][r] : key[j][r], lo_ = key[i][r] > key[j][r] ? key[j][r] : key[i][r]; key[i][r] = hi_; key[j][r] = lo_; }
template <int NT>
__device__ __forceinline__ void top16(unsigned (&key)[NT][4], unsigned (&top)[4], int l15) {
    static_assert(NT == 8, "8 keys per lane");
#pragma unroll
    for (int r = 0; r < 4; ++r) {
        CE_(0, 1) CE_(2, 3) CE_(4, 5) CE_(6, 7)
        CE_(0, 2) CE_(1, 3) CE_(4, 6) CE_(5, 7)
        CE_(1, 2) CE_(5, 6)
        CE_(0, 4) CE_(1, 5) CE_(2, 6) CE_(3, 7)
        CE_(2, 4) CE_(3, 5)
        CE_(1, 2) CE_(3, 4) CE_(5, 6)
        top[r] = 0u;
    }
    for (int it = 0; it < 16; ++it) {
        unsigned m[4];
#pragma unroll
        for (int r = 0; r < 4; ++r) m[r] = key[0][r];
#pragma unroll
        for (int st = 0; st < 4; ++st)
#pragma unroll
            for (int r = 0; r < 4; ++r) { const unsigned y = dppu(m[r], st); m[r] = m[r] > y ? m[r] : y; }
        const bool rec = (l15 == it);
#pragma unroll
        for (int r = 0; r < 4; ++r) {
            top[r] = rec ? m[r] : top[r];
            const bool own = key[0][r] == m[r];
#pragma unroll
            for (int t = 0; t < 7; ++t) key[t][r] = own ? key[t + 1][r] : key[t][r];
            key[7][r] = own ? 0u : key[7][r];
        }
    }
}
#undef CE_
__device__ __forceinline__ float gelu_erf(float x) { return 0.5f * x * (1.f + erff(x * 0.70710678118654752f)); }

__device__ __forceinline__ void peer_hq_row(const Args& a, int row, int lane) {
    {
        const bf16_t* hrow = (const bf16_t*)(a.ws + WS_B) + (size_t)row * D + 16 * lane;
        const u32x4 hb0 = *(const u32x4*)hrow, hb1 = *(const u32x4*)(hrow + 8);
        f32x4 v[4]; float am = 0.f;
        v[0] = (f32x4){bflo(hb0.x), bfhi(hb0.x), bflo(hb0.y), bfhi(hb0.y)}; v[1] = (f32x4){bflo(hb0.z), bfhi(hb0.z), bflo(hb0.w), bfhi(hb0.w)};
        v[2] = (f32x4){bflo(hb1.x), bfhi(hb1.x), bflo(hb1.y), bfhi(hb1.y)}; v[3] = (f32x4){bflo(hb1.z), bfhi(hb1.z), bflo(hb1.w), bfhi(hb1.w)};
#pragma unroll
        for (int j = 0; j < 4; ++j) am = fmaxf(am, fmaxf(fmaxf(fabsf(v[j][0]), fabsf(v[j][1])), fmaxf(fabsf(v[j][2]), fabsf(v[j][3]))));
        am = fmaxf(am, __uint_as_float(dppu(__float_as_uint(am), 0))); am = fmaxf(am, __uint_as_float(dppu(__float_as_uint(am), 1))); am = fmaxf(am, __uint_as_float(dppu(__float_as_uint(am), 2)));
        const float s1 = am > 0.f ? am * (1.f / 127.f) : 1.f, i1 = 1.f / s1, i2 = 254.f * i1;
        u32x4 wh, wl;
#pragma unroll
        for (int j = 0; j < 4; ++j) {
            unsigned ph = 0, pl = 0;
#pragma unroll
            for (int e = 0; e < 4; ++e) {
                const float qh = rintf(v[j][e] * i1);
                const float ql = rintf((v[j][e] - qh * s1) * i2);
                ph |= ((unsigned)((int)qh & 255)) << (8 * e); pl |= ((unsigned)((int)ql & 255)) << (8 * e);
            }
            wh[j] = ph; wl[j] = pl;
        }
        *(u32x4*)(a.ws + WS_HQH + (size_t)row * D + 16 * lane) = wh;
        if (PEER_HQ_LO) *(u32x4*)(a.ws + WS_HQL + (size_t)row * D + 16 * lane) = wl;
        if ((lane & 7) == 0) ((float*)(a.ws + WS_HS))[(size_t)row * 8 + (lane >> 3)] = s1;
    }
}
__device__ __forceinline__ void peer_score_unit(const Args& a, LAS unsigned char* lds, int pm, int hsel) {
    const int tid = threadIdx.x, lane = tid & 63, wave = tid >> 6, l15 = lane & 15, lq = lane >> 4;
    const bf16_t* pq = (const bf16_t*)(a.ws + WS_A);
    LAS u32x2* SEL = (LAS u32x2*)lds;
    const int T0 = pm * 256;
    {
#pragma unroll 1
        for (int hh = 0; hh < 2; ++hh) {
            const int h = hsel, tt = wave + 8 * hh;
            unsigned tc[2][4];
#pragma unroll
            for (int c = 0; c < 2; ++c) {
                unsigned key[8][4];
#pragma unroll
                for (int r = 0; r < 4; ++r) {
                    const u32x4 sv = *(const u32x4*)(pq + (size_t)(T0 + tt * 16 + lq * 4 + r) * 2048 + h * 256 + c * 128 + 8 * l15);
                    const unsigned sw[4] = {sv.x, sv.y, sv.z, sv.w};
#pragma unroll
                    for (int j = 0; j < 4; ++j) {
                        key[2 * j][r] = (f2sort(bflo(sw[j])) & ~127u) | (unsigned)(8 * l15 + 2 * j);
                        key[2 * j + 1][r] = (f2sort(bfhi(sw[j])) & ~127u) | (unsigned)(8 * l15 + 2 * j + 1);
                    }
                }
                top16<8>(key, tc[c], l15);
            }
            const int gb = lane & 48;
            int ci[4], cj[4]; bool ok[4];
            ci[0] = 0; cj[0] = l15; ok[0] = true;
            ci[1] = l15; cj[1] = 0; ok[1] = l15 >= 1;
            ci[2] = l15 < 7 ? 1 : (l15 < 11 ? 2 : (l15 < 14 ? 3 : 4)); cj[2] = l15 < 7 ? l15 + 1 : (l15 < 11 ? l15 - 6 : (l15 < 14 ? l15 - 10 : l15 - 13)); ok[2] = true;
            ci[3] = l15 < 3 ? 5 + l15 : 0; cj[3] = 1; ok[3] = l15 < 3;
            unsigned ck[4][4]; int ce[4][4];
#pragma unroll
            for (int r = 0; r < 4; ++r) {
                const unsigned t1 = tc[0][r], t2 = tc[1][r];
                const float v1 = sort2f(t1 & ~127u), v2 = sort2f(t2 & ~127u);
                const int i1 = (int)(t1 & 127u), i2 = (int)(t2 & 127u);
#pragma unroll
                for (int sl = 0; sl < 4; ++sl) {
                    const float a1 = __uint_as_float((unsigned)__builtin_amdgcn_ds_bpermute((gb + ci[sl]) * 4, (int)__float_as_uint(v1)));
                    const float a2 = __uint_as_float((unsigned)__builtin_amdgcn_ds_bpermute((gb + cj[sl]) * 4, (int)__float_as_uint(v2)));
                    const int e1 = __builtin_amdgcn_ds_bpermute((gb + ci[sl]) * 4, i1);
                    const int e2 = __builtin_amdgcn_ds_bpermute((gb + cj[sl]) * 4, i2);
                    ce[sl][r] = e1 * 128 + e2;
                    ck[sl][r] = ok[sl] ? ((f2sort(a1 + a2) & ~63u) | (unsigned)(l15 * 4 + sl)) : 0u;
                }
#define CE4_(i, j) { const unsigned hi_ = ck[i][r] > ck[j][r] ? ck[i][r] : ck[j][r], lo_ = ck[i][r] > ck[j][r] ? ck[j][r] : ck[i][r]; ck[i][r] = hi_; ck[j][r] = lo_; }
                CE4_(0, 1) CE4_(2, 3) CE4_(0, 2) CE4_(1, 3) CE4_(1, 2)
#undef CE4_
            }
            unsigned topk[4] = {0u, 0u, 0u, 0u};
            for (int it = 0; it < 16; ++it) {
                unsigned m[4];
#pragma unroll
                for (int r = 0; r < 4; ++r) m[r] = ck[0][r];
#pragma unroll
                for (int st = 0; st < 4; ++st)
#pragma unroll
                    for (int r = 0; r < 4; ++r) { const unsigned y = dppu(m[r], st); m[r] = m[r] > y ? m[r] : y; }
                const bool rec = (l15 == it);
#pragma unroll
                for (int r = 0; r < 4; ++r) {
                    topk[r] = rec ? m[r] : topk[r];
                    const bool own = ck[0][r] == m[r];
                    ck[0][r] = own ? ck[1][r] : ck[0][r]; ck[1][r] = own ? ck[2][r] : ck[1][r]; ck[2][r] = own ? ck[3][r] : ck[2][r]; ck[3][r] = own ? 0u : ck[3][r];
                }
            }
#pragma unroll
            for (int r = 0; r < 4; ++r) {
                const int own = (int)((topk[r] >> 2) & 15u), slot = (int)(topk[r] & 3u);
                int eid = 0;
#pragma unroll
                for (int sl = 0; sl < 4; ++sl) { const int t = __builtin_amdgcn_ds_bpermute((gb + own) * 4, ce[sl][r]); eid = (slot == sl) ? t : eid; }
                const float ts = sort2f(topk[r] & ~63u);
                const float tmax = row16_max_f32(ts);
                const float p = __expf(ts - tmax);
                const float g = p / row16_sum_f32(p);
                { u32x2 o; o.x = (unsigned)eid; o.y = __float_as_uint(g); SEL[(tt * 16 + lq * 4 + r) * 16 + l15] = o; }
            }
        }
    }
    __syncthreads();
    {
        unsigned* sele = (unsigned*)(a.ws + WS_SELE); float* selg = (float*)(a.ws + WS_SELG);
        for (int i = tid; i < 256 * 16; i += NTHREADS) { const u32x2 o = SEL[i]; const size_t gi = (size_t)(T0 + (i >> 4)) * 128 + hsel * 16 + (i & 15); sele[gi] = o.x << 7; selg[gi] = __uint_as_float(o.y); }
    }
    const int r0 = T0 + 32 * hsel;
    if (tid < 32) ((float*)(a.ws + WS_R2))[r0 + tid] = row_rscale((const float*)(a.ws + WS_SSQ), r0 + tid);
    for (int tk = 0; tk < 4; ++tk) peer_hq_row(a, r0 + wave * 4 + tk, lane);
    __syncthreads();
}
struct PeerSplit { int p0, pstep, trank, tn; };
__device__ __forceinline__ PeerSplit peer_split() {
    PeerSplit s; const int G = gridDim.x;
    if ((G & 7) == 0) { s.p0 = blockIdx.x & 7; s.pstep = 8; s.trank = blockIdx.x >> 3; s.tn = G >> 3; }
    else { s.p0 = 0; s.pstep = 1; s.trank = blockIdx.x; s.tn = G; }
    return s;
}
__device__ __forceinline__ void peer_down(const Args& a, LAS unsigned char* lds) {
    const int lane = threadIdx.x & 63, wave = threadIdx.x >> 6;
    const PeerSplit sp = peer_split();
    const unsigned* sele = (const unsigned*)(a.ws + WS_SELE);
    const float* hs = (const float*)(a.ws + WS_HS);
    LAS unsigned* stage = (LAS unsigned*)(lds + wave * 512);
    const LAS u32x4* stq = (const LAS u32x4*)(lds + wave * 512 + 64 * (lane >> 3));
    const unsigned loff = 16u * (lane & 7);
    const int t0 = sp.trank * NWAVES + wave, tstep = sp.tn * NWAVES;
    const bool b2 = lane & 4, b1 = lane & 2, b0 = lane & 1;
    for (int p = sp.p0; p < 8; p += sp.pstep) {
        const unsigned char* EDp = a.ws + WS_ED + (size_t)p * (16384 * 128);
        float* part = (float*)(a.ws + WS_PART) + (size_t)p * MTOK * 128 + 16 * (lane >> 3) + (lane & 7);
        const unsigned char* hqh = a.ws + WS_HQH + 128 * p + loff;
        if (t0 >= MTOK) continue;
        unsigned e0n = sele[(size_t)t0 * 128 + lane], e1n = sele[(size_t)t0 * 128 + 64 + lane];
        stage[lane] = e0n; stage[64 + lane] = e1n;
        u32x4 en[4];
#pragma unroll
        for (int k = 0; k < 4; ++k) en[k] = stq[k];
        u32x4 h0n = *(const u32x4*)(hqh + (size_t)t0 * D); float s1n = hs[(size_t)t0 * 8 + p];
        { const int tc = min(t0 + tstep, MTOK - 1); e0n = sele[(size_t)tc * 128 + lane]; e1n = sele[(size_t)tc * 128 + 64 + lane]; }
        for (int t = t0; t < MTOK; t += tstep) {
            const u32x4 hh = h0n; const float s1 = s1n;
            u32x4 x[16];
#pragma unroll
            for (int i = 0; i < 16; ++i) x[i] = *(const u32x4*)(EDp + (en[i >> 2][i & 3] + loff));
            __builtin_amdgcn_sched_barrier(0);
            stage[lane] = e0n; stage[64 + lane] = e1n;
#pragma unroll
            for (int k = 0; k < 4; ++k) en[k] = stq[k];
            { const int tc = min(t + tstep, MTOK - 1); h0n = *(const u32x4*)(hqh + (size_t)tc * D); s1n = hs[(size_t)tc * 8 + p]; }
            { const int tc = min(t + 2 * tstep, MTOK - 1); e0n = sele[(size_t)tc * 128 + lane]; e1n = sele[(size_t)tc * 128 + 64 + lane]; }
            __builtin_amdgcn_sched_barrier(0);
            int v[16];
#pragma unroll
            for (int i = 0; i < 16; ++i) {
                int ah = 0;
#pragma unroll
                for (int j = 0; j < 4; ++j) ah = __builtin_amdgcn_sdot4((int)x[i][j], (int)hh[j], ah, false);
                v[i] = ah;
            }
            int m[2];
#pragma unroll
            for (int hf = 0; hf < 2; ++hf) {
                int k4[4], k2[2];
#pragma unroll
                for (int j = 0; j < 4; ++j) k4[j] = (b2 ? v[8 * hf + 4 + j] : v[8 * hf + j]) + (int)dppu((unsigned)(b2 ? v[8 * hf + j] : v[8 * hf + 4 + j]), 2);
#pragma unroll
                for (int j = 0; j < 2; ++j) k2[j] = (b1 ? k4[2 + j] : k4[j]) + (int)dppu((unsigned)(b1 ? k4[j] : k4[2 + j]), 1);
                m[hf] = (b0 ? k2[1] : k2[0]) + (int)dppu((unsigned)(b0 ? k2[0] : k2[1]), 0);
            }
            part[(size_t)t * 128] = (float)m[0] * s1;
            part[(size_t)t * 128 + 8] = (float)m[1] * s1;
        }
    }
}
__device__ __forceinline__ void peer_coef(const Args& a) {
    const int lane = threadIdx.x & 63, wave = threadIdx.x >> 6;
    const unsigned* sele = (const unsigned*)(a.ws + WS_SELE); const float* selg = (const float*)(a.ws + WS_SELG);
    const float* part = (const float*)(a.ws + WS_PART);
    const float* esc = (const float*)(a.ws + WS_ESC);
    const float* r2g = (const float*)(a.ws + WS_R2);
    unsigned* coefd = (unsigned*)(a.ws + WS_COEF);
    for (int t = blockIdx.x * NWAVES + wave; t < MTOK; t += gridDim.x * NWAVES) {
        const float r2 = r2g[t];
        float c[2];
#pragma unroll
        for (int half = 0; half < 2; ++half) {
            const size_t i = (size_t)t * 128 + half * 64 + lane;
            float s = 0.f;
#pragma unroll
            for (int p = 0; p < 8; ++p) s += part[(size_t)p * MTOK * 128 + i];
            const unsigned e = sele[i] >> 7;
            c[half] = selg[i] * gelu_erf(s * r2 * esc[e]) * esc[16384 + e];
        }
        float cm = fmaxf(fabsf(c[0]), fabsf(c[1]));
        cm = row16_max_f32(cm); cm = fmaxf(cm, __shfl_xor(cm, 16)); cm = fmaxf(cm, __shfl_xor(cm, 32));
        const float sc = cm > 0.f ? cm * (1.f / 127.f) : 1.f, inv = 1.f / sc;
        const int sh = 8 * (lane & 3);
        unsigned w0 = ((unsigned)((int)rintf(c[0] * inv) & 255)) << sh, w1 = ((unsigned)((int)rintf(c[1] * inv) & 255)) << sh;
        w0 |= dppu(w0, 0); w0 |= dppu(w0, 1);
        w1 |= dppu(w1, 0); w1 |= dppu(w1, 1);
        if ((lane & 3) == 0) { coefd[(size_t)t * 32 + (lane >> 2)] = w0; coefd[(size_t)t * 32 + 16 + (lane >> 2)] = w1; }
        if (lane == 0) ((float*)(a.ws + WS_CS))[t] = sc;
    }
}
__device__ __forceinline__ void peer_up(const Args& a, LAS unsigned char* lds) {
    const int lane = threadIdx.x & 63, wave = threadIdx.x >> 6;
    const PeerSplit sp = peer_split();
    const unsigned* sele = (const unsigned*)(a.ws + WS_SELE);
    const u32x4* coefd = (const u32x4*)(a.ws + WS_COEF) + (lane >> 3);
    const float* csg = (const float*)(a.ws + WS_CS);
    LAS unsigned* stage = (LAS unsigned*)(lds + wave * 512);
    const LAS u32x4* stq = (const LAS u32x4*)(lds + wave * 512 + 64 * (lane >> 3));
    const unsigned loff = 16u * (lane & 7);
    const int t0 = sp.trank * NWAVES + wave, tstep = sp.tn * NWAVES;
    const bool b3 = lane & 8;
    for (int p = sp.p0; p < 8; p += sp.pstep) {
        const unsigned char* EUp = a.ws + WS_EU + (size_t)p * (16384 * 128);
        const bf16_t* hbase = (const bf16_t*)(a.ws + WS_B) + 128 * p + 16 * (lane & 7) + 2 * (lane >> 3);
        float* h3base = (float*)(a.ws + WS_PART) + 128 * p + 16 * (lane & 7) + 2 * (lane >> 3);
        if (t0 >= MTOK) continue;
        unsigned e0n = sele[(size_t)t0 * 128 + lane], e1n = sele[(size_t)t0 * 128 + 64 + lane];
        stage[lane] = e0n; stage[64 + lane] = e1n;
        u32x4 en[4];
#pragma unroll
        for (int k = 0; k < 4; ++k) en[k] = stq[k];
        u32x4 cdn = coefd[(size_t)t0 * 8]; float csn = csg[t0]; unsigned h2n = *(const unsigned*)(hbase + (size_t)t0 * D);
        { const int tc = min(t0 + tstep, MTOK - 1); e0n = sele[(size_t)tc * 128 + lane]; e1n = sele[(size_t)tc * 128 + 64 + lane]; }
        for (int t = t0; t < MTOK; t += tstep) {
            const u32x4 cd = cdn; const float cs = csn; const f32x2_t h2 = {bflo(h2n), bfhi(h2n)};
            u32x4 x[16];
#pragma unroll
            for (int i = 0; i < 16; ++i) x[i] = *(const u32x4*)(EUp + (en[i >> 2][i & 3] + loff));
            __builtin_amdgcn_sched_barrier(0);
            stage[lane] = e0n; stage[64 + lane] = e1n;
#pragma unroll
            for (int k = 0; k < 4; ++k) en[k] = stq[k];
            { const int tc = min(t + tstep, MTOK - 1); cdn = coefd[(size_t)tc * 8]; csn = csg[tc]; h2n = *(const unsigned*)(hbase + (size_t)tc * D); }
            { const int tc = min(t + 2 * tstep, MTOK - 1); e0n = sele[(size_t)tc * 128 + lane]; e1n = sele[(size_t)tc * 128 + 64 + lane]; }
            __builtin_amdgcn_sched_barrier(0);
            int acc[16];
#pragma unroll
            for (int j = 0; j < 16; ++j) acc[j] = 0;
#pragma unroll
            for (int g = 0; g < 4; ++g) {
                const int cw = (int)cd[g];
#pragma unroll
                for (int j = 0; j < 4; ++j) {
                    const unsigned xa = x[4 * g][j], xb = x[4 * g + 1][j], xc = x[4 * g + 2][j], xd = x[4 * g + 3][j];
                    const unsigned t0_ = __builtin_amdgcn_perm(xb, xa, 0x05010400u), t1_ = __builtin_amdgcn_perm(xb, xa, 0x07030602u);
                    const unsigned t2_ = __builtin_amdgcn_perm(xd, xc, 0x05010400u), t3_ = __builtin_amdgcn_perm(xd, xc, 0x07030602u);
                    const unsigned o0 = __builtin_amdgcn_perm(t2_, t0_, 0x05040100u), o1 = __builtin_amdgcn_perm(t2_, t0_, 0x07060302u);
                    const unsigned o2 = __builtin_amdgcn_perm(t3_, t1_, 0x05040100u), o3 = __builtin_amdgcn_perm(t3_, t1_, 0x07060302u);
                    acc[4 * j + 0] = __builtin_amdgcn_sdot4((int)o0, cw, acc[4 * j + 0], false);
                    acc[4 * j + 1] = __builtin_amdgcn_sdot4((int)o1, cw, acc[4 * j + 1], false);
                    acc[4 * j + 2] = __builtin_amdgcn_sdot4((int)o2, cw, acc[4 * j + 2], false);
                    acc[4 * j + 3] = __builtin_amdgcn_sdot4((int)o3, cw, acc[4 * j + 3], false);
                }
            }
            int k8[8], k4[4], k2[2];
#pragma unroll
            for (int j = 0; j < 8; ++j) { const auto r = __builtin_amdgcn_permlane32_swap((unsigned)acc[j], (unsigned)acc[8 + j], false, false); k8[j] = (int)(r[0] + r[1]); }
#pragma unroll
            for (int j = 0; j < 4; ++j) { const auto r = __builtin_amdgcn_permlane16_swap((unsigned)k8[j], (unsigned)k8[4 + j], false, false); k4[j] = (int)(r[0] + r[1]); }
#pragma unroll
            for (int j = 0; j < 2; ++j) k2[j] = (b3 ? k4[2 + j] : k4[j]) + __builtin_amdgcn_update_dpp(0, b3 ? k4[j] : k4[2 + j], 0x128, 0xF, 0xF, true);
            const f32x2_t h3 = h2 + (f32x2_t){(float)k2[0] * cs, (float)k2[1] * cs};
            *(f32x2_t*)(h3base + (size_t)t * D) = h3;
        }
    }
}
__device__ __forceinline__ void peer_final(const Args& a) {
    const int lane = threadIdx.x & 63, wave = threadIdx.x >> 6;
    const float* gf = a.in[I_GFINAL];
    for (int t = blockIdx.x * NWAVES + wave; t < MTOK; t += gridDim.x * NWAVES) {
        const float* hrow = (const float*)(a.ws + WS_PART) + (size_t)t * D + 4 * lane;
        float* orow = a.out + (size_t)t * D + 4 * lane;
        f32x4 v[4]; float s = 0.f;
#pragma unroll
        for (int j = 0; j < 4; ++j) { v[j] = *(const f32x4*)(hrow + 256 * j); s += v[j][0] * v[j][0] + v[j][1] * v[j][1] + v[j][2] * v[j][2] + v[j][3] * v[j][3]; }
        const float r3 = rsqrtf(wave_sum(s) * (1.f / D) + EPS);
#pragma unroll
        for (int j = 0; j < 4; ++j) *(f32x4*)(orow + 256 * j) = v[j] * r3 * *(const f32x4*)(gf + 4 * lane + 256 * j);
    }
}
__device__ __forceinline__ void peer_fold_task(const Args& a, int task) {
    const int lane = threadIdx.x & 63, wave = threadIdx.x >> 6, l15 = lane & 15, lq = lane >> 4;
    const int hc = task >> 2, c = hc & 1, k0 = (task & 3) * 256 + wave * 32;
    const bf16_t* wgr = (const bf16_t*)(a.ws + WS_WGR);
    const bf16_t* sk = (const bf16_t*)(a.ws + WS_SK) + (size_t)c * 128 * 128;
    bf16_t* btp = (bf16_t*)(a.ws + WS_WPQ);
    f32x4 acc[2][8];
#pragma unroll
    for (int mt = 0; mt < 2; ++mt)
#pragma unroll
        for (int nt = 0; nt < 8; ++nt) acc[mt][nt] = (f32x4){0.f, 0.f, 0.f, 0.f};
#pragma unroll
    for (int ks = 0; ks < 4; ++ks) {
        bf16x8 af[2];
#pragma unroll
        for (int mt = 0; mt < 2; ++mt) af[mt] = *(const bf16x8*)(wgr + (size_t)(k0 + mt * 16 + l15) * 2048 + hc * 128 + ks * 32 + 8 * lq);
#pragma unroll
        for (int nt = 0; nt < 8; ++nt) {
            const bf16x8 bv = *(const bf16x8*)(sk + (size_t)(nt * 16 + l15) * 128 + ks * 32 + 8 * lq);
#pragma unroll
            for (int mt = 0; mt < 2; ++mt) acc[mt][nt] = mfma16(af[mt], bv, acc[mt][nt]);
        }
    }
#pragma unroll
    for (int mt = 0; mt < 2; ++mt)
#pragma unroll
        for (int nt = 0; nt < 8; ++nt) {
            u32x2 o; o.x = pk2(acc[mt][nt][0], acc[mt][nt][1]); o.y = pk2(acc[mt][nt][2], acc[mt][nt][3]);
            *(u32x2*)(btp + (size_t)(hc * 128 + nt * 16 + l15) * 1024 + k0 + mt * 16 + 4 * lq) = o;
        }
}

#define XB_TMO      128
#define XB_XCNT(j)  (256  + 64 * (j))
#define XB_XSUB(j)  (1280 + 64 * (j))
#define XB_XGEN(j)  (2304 + 64 * (j))
#define XB_TOP      3328
#define XB_TOPGEN   3392
#define XCD_BAR_WORDS 3456
#define XB_SPIN_CAP (1u << 22)
__device__ __forceinline__ unsigned xb_ld(unsigned* p)              { return __hip_atomic_load(p, __ATOMIC_RELAXED, __HIP_MEMORY_SCOPE_AGENT); }
__device__ __forceinline__ unsigned xb_add(unsigned* p, unsigned v) { return __hip_atomic_fetch_add(p, v, __ATOMIC_RELAXED, __HIP_MEMORY_SCOPE_AGENT); }
__device__ __forceinline__ unsigned xb_xcc_id() { return (unsigned)__builtin_amdgcn_s_getreg((3 << 11) | 20) & 0xFu; }
#define XB_SPIN(cond, bar) do { unsigned _sp = 0; while (cond) { __builtin_amdgcn_s_sleep(1); \
    if ((++_sp & 255u) == 0u) { if (xb_ld(&(bar)[XB_TMO])) break; if (_sp > XB_SPIN_CAP) { atomicAdd(&(bar)[XB_TMO], 1u); break; } } } } while (0)
struct XcdBarrier { unsigned* bar; unsigned x; volatile LAS unsigned* st; };
__device__ __forceinline__ XcdBarrier xcd_barrier_post(unsigned* bar, volatile LAS unsigned* st) {
    XcdBarrier b; b.bar = bar; b.x = xb_xcc_id(); b.st = st;
    if (threadIdx.x == 0) (void)xb_add(&bar[XB_XCNT(b.x)], 1u);
    return b;
}
__device__ __forceinline__ void xcd_barrier_complete(unsigned* bar, unsigned x, unsigned& nloc, unsigned& nx) {
    const unsigned G = gridDim.x * gridDim.y * gridDim.z;
    unsigned sum, cnt, mine, sp = 0u;
    for (;;) {
        sum = 0u; cnt = 0u; mine = 0u;
#pragma unroll
        for (unsigned j = 0; j < 16; ++j) { const unsigned c = xb_ld(&bar[XB_XCNT(j)]); sum += c; cnt += (c > 0u) ? 1u : 0u; mine = (j == x) ? c : mine; }
        if (sum == G) break;
        __builtin_amdgcn_s_sleep(1);
        if ((++sp & 255u) == 0u) { if (xb_ld(&bar[XB_TMO])) break; if (sp > XB_SPIN_CAP) { atomicAdd(&bar[XB_TMO], 1u); break; } }
    }
    nloc = mine > 0u ? mine : 1u; nx = cnt > 0u ? cnt : 1u;
}
__device__ __forceinline__ void xcd_barrier(const XcdBarrier& b) {
    asm volatile("s_waitcnt vmcnt(0)" ::: "memory");
    __syncthreads();
    if (threadIdx.x == 0) {
        unsigned* bar = b.bar;
        __builtin_amdgcn_s_waitcnt(0);
        unsigned nloc = b.st[0], nx = b.st[1];
        if (nloc == 0u) { xcd_barrier_complete(bar, b.x, nloc, nx); b.st[0] = nloc; b.st[1] = nx; }
        const unsigned old = xb_add(&bar[XB_XSUB(b.x)], 1u);
        const unsigned gen = old / nloc;
        if (old + 1u == (gen + 1u) * nloc) {
            __builtin_amdgcn_fence(__ATOMIC_RELEASE, "agent");
            asm volatile("s_waitcnt vmcnt(0)" ::: "memory");
            const unsigned og = xb_add(&bar[XB_TOP], 1u);
            const unsigned tg = og / nx;
            if (og + 1u == (tg + 1u) * nx) xb_add(&bar[XB_TOPGEN], 1u);
            else XB_SPIN(xb_ld(&bar[XB_TOPGEN]) == tg, bar);
            __builtin_amdgcn_fence(__ATOMIC_ACQUIRE, "agent");
            xb_add(&bar[XB_XGEN(b.x)], 1u);
            asm volatile("s_waitcnt vmcnt(0)" ::: "memory");
        } else {
            XB_SPIN(xb_ld(&bar[XB_XGEN(b.x)]) == gen, bar);
            __builtin_amdgcn_fence(__ATOMIC_ACQUIRE, "agent");
            asm volatile("s_waitcnt vmcnt(0)" ::: "memory");
        }
    }
    __syncthreads();
}


#ifndef FUSE_SCORE
#define FUSE_SCORE 1
#endif
constexpr int NPHASES = 15;
__global__ __launch_bounds__(NTHREADS, 2) void hybrid_fwd(Args a) {
    extern __shared__ __attribute__((aligned(16))) unsigned char smem[];
    LAS unsigned char* lds = (LAS unsigned char*)smem;
    volatile LAS unsigned* xbw = (volatile LAS unsigned*)(lds + LDS_BYTES - 16);
    unsigned char* ws = a.ws;
    const int G = gridDim.x;
    if (threadIdx.x == 0) { xbw[0] = 0u; xbw[1] = 0u; xbw[2] = 0u; xbw[3] = 0u; }
    __syncthreads();
    XcdBarrier xb; xb.bar = (unsigned*)(ws + WS_BAR); xb.x = 0; xb.st = xbw;
    const bool multi = (a.ph_hi - a.ph_lo) > 1;
    if (multi) xb = xcd_barrier_post((unsigned*)(ws + WS_BAR), xbw);
#define PHON(n) 1
#define PH_BEGIN(n) if (PHON(n) && a.ph_lo <= (n) && (n) < a.ph_hi) { auto body_ = [&]() __attribute__((always_inline)) {
#define PH_END(n) }; body_(); if ((n) + 1 < a.ph_hi) xcd_barrier(xb); }
    PH_BEGIN(0) phase0(a, lds); PH_END(0)
    PH_BEGIN(1)
        { pg8::Gemm g{(const bf16_t*)(ws + WS_B), (const bf16_t*)(ws + WS_WIN), MTOK, NPROJ, D};
          pg8::StaticOrder S; S.init(g.M, g.N, G, blockIdx.x);
          EpiRowBf16 E{(bf16_t*)(ws + WS_A), NPROJ, nullptr, 1.0f};
          pg8::gemm_phase<EpiRowBf16, pg8::StaticOrder, false>(lds, g, S, E, nullptr); }
        { pg8::Gemm g{(const bf16_t*)(ws + WS_C), (const bf16_t*)(ws + WS_WXKV), NB * MEMLEN, 2048, D};
          pg8::StaticOrder S; S.init(g.M, g.N, G, (blockIdx.x + G - (64 % G)) % G);
          EpiKV E{(bf16_t*)(ws + WS_KMEM), (bf16_t*)(ws + WS_VTMEM)};
          pg8::gemm_phase<EpiKV, pg8::StaticOrder, false>(lds, g, S, E, nullptr); }
        { const int lo = (G > 160) ? 80 : 0;
          if ((int)blockIdx.x >= lo) p0_experts(a, blockIdx.x - lo, G - lo); }
    PH_END(1)
    PH_BEGIN(2) for (int t = blockIdx.x; t < 1280; t += G) { if (t < 1024) mlstm_local(a, lds, t); else swa_task(a, lds, t - 1024); } PH_END(2)
    PH_BEGIN(3) p0_late_transposes(a, lds); mlstm_scan(a); PH_END(3)
    PH_BEGIN(4)
        {
            for (int fu = blockIdx.x; fu < 128; fu += G) {
                if (fu < 64) {
                    const int j = fu >> 2, bh = j & 7, b = bh >> 2, h = bh & 3;
                    const bf16_t* Kh = (const bf16_t*)(ws + WS_KMEM) + (size_t)bh * 65536; const bf16_t* Vh = (const bf16_t*)(ws + WS_VTMEM) + (size_t)bh * 65536;
                    const bf16_t* WqR = (const bf16_t*)(ws + WS_WXQ) + (size_t)h * 1024 * 256; const bf16_t* WoR = (const bf16_t*)(ws + WS_WXO) + (size_t)h * 1024 * 256;
                    pg8::Gemm g{}; EpiRowBf16 E{nullptr, 1024, nullptr, 1.0f};
                    if (j < 8) { g.A = Kh; g.Bt = WqR; g.M = 256; g.N = 1024; g.K = 256; E.O = (bf16_t*)(ws + WS_WXKV) + ((size_t)b * 1024 + h * 256) * 1024; }
                    else { g.A = WoR; g.Bt = Vh; g.M = 1024; g.N = 256; g.K = 256; E.O = (bf16_t*)(ws + WS_BTO) + (size_t)b * 1024 * 1024 + h * 256; }
                    pg8::StaticOrder S; S.init(g.M, g.N, 4, fu & 3);
                    pg8::gemm_phase<EpiRowBf16, pg8::StaticOrder, false>(lds, g, S, E, nullptr);
                } else peer_fold_task(a, fu - 64);
                __syncthreads();
            }
            __syncthreads();
        }
        for (int t = blockIdx.x; t < 1024; t += G) mlstm_out(a, lds, t);
    PH_END(4)
    PH_BEGIN(5) { pg8::Gemm g{(const bf16_t*)(ws + WS_C), (const bf16_t*)(ws + WS_WOUT), MTOK, D, D};
          pg8::StaticOrder S; S.init(g.M, g.N, G, blockIdx.x);
          EpiResid<false> E{a.in[I_X], (bf16_t*)(ws + WS_B), (float*)(ws + WS_SSQ)};
          pg8::gemm_phase<EpiResid<false>, pg8::StaticOrder, false>(lds, g, S, E, nullptr); } PH_END(5)
    PH_BEGIN(6) { pg8::Gemm g{(const bf16_t*)(ws + WS_B), (const bf16_t*)(ws + WS_WXKV), MTOK, D, D, 32, (size_t)1024 * 1024 * 2};
          EpiSoftmax E{(bf16_t*)(ws + WS_A), (const float*)(ws + WS_SSQ)};
          for (int L = blockIdx.x; L < (MTOK / 256) * (D / 256); L += G) {
              pg8::StaticOrder S; S.init(g.M, g.N, (MTOK / 256) * (D / 256), L);
              pg8::gemm_phase<EpiSoftmax, pg8::StaticOrder, false>(lds, g, S, E, nullptr);
          } } PH_END(6)
    PH_BEGIN(8) { pg8::Gemm g{(const bf16_t*)(ws + WS_A), (const bf16_t*)(ws + WS_BTO), MTOK, D, D, 32, (size_t)1024 * 1024 * 2};
          pg8::StaticOrder S; S.init(g.M, g.N, G, blockIdx.x);
          EpiResid<true> E{(const void*)(ws + WS_B), (bf16_t*)(ws + WS_B), (float*)(ws + WS_SSQ)};
          pg8::gemm_phase<EpiResid<true>, pg8::StaticOrder, false>(lds, g, S, E, nullptr); } PH_END(8)
    PH_BEGIN(9) { pg8::Gemm g{(const bf16_t*)(ws + WS_B), (const bf16_t*)(ws + WS_WPQ), MTOK, 2048, D};
          pg8::StaticOrder S; S.init(g.M, g.N, G, blockIdx.x);
          EpiRowBf16 E{(bf16_t*)(ws + WS_A), 2048, (const float*)(ws + WS_SSQ), 1.0f};
          pg8::gemm_phase<EpiRowBf16, pg8::StaticOrder, false>(lds, g, S, E, nullptr);
#if FUSE_SCORE
          asm volatile("s_waitcnt vmcnt(0)" ::: "memory"); __syncthreads();
          pg8::Unit u;
          for (int i = 0; S.next(i, u); ++i) peer_score_unit(a, lds, u.pm, u.pn);
#endif
          } PH_END(9)

    PH_BEGIN(11) peer_down(a, lds); PH_END(11)
    PH_BEGIN(12) peer_coef(a); PH_END(12)
    PH_BEGIN(13) peer_up(a, lds); PH_END(13)
    PH_BEGIN(14) peer_final(a); PH_END(14)
}

#ifndef MK_ONE_LAUNCH
#define MK_ONE_LAUNCH 1
#endif
extern "C" void kernel_launch(void* const* d_in, const int* in_sizes, int n_in, void* d_out, int out_size, void* d_ws, size_t ws_size, hipStream_t stream) {
    static int grid = 0;
    if (grid == 0) {
        if (n_in != 24 || out_size != MTOK * D || ws_size < WS_END) { fprintf(stderr, "kernel_launch: unexpected shapes (n_in %d out %d ws %zu)\n", n_in, out_size, ws_size); grid = -1; return; }
        int dev = 0, cus = 0;
        if (hipGetDevice(&dev) != hipSuccess || hipDeviceGetAttribute(&cus, hipDeviceAttributeMultiprocessorCount, dev) != hipSuccess) { grid = -1; return; }
        if (hipFuncSetAttribute((const void*)hybrid_fwd, hipFuncAttributeMaxDynamicSharedMemorySize, LDS_BYTES) != hipSuccess) { fprintf(stderr, "kernel_launch: hipFuncSetAttribute failed\n"); grid = -1; return; }
        int per_cu = 0;
        if (hipOccupancyMaxActiveBlocksPerMultiprocessor(&per_cu, (const void*)hybrid_fwd, NTHREADS, LDS_BYTES) != hipSuccess || per_cu < 1) { fprintf(stderr, "kernel_launch: occupancy query says %d\n", per_cu); }
        (void)hipGetLastError();
        grid = cus;
    }
    if (grid < 0) return;
    (void)hipMemsetAsync((char*)d_ws + WS_BAR, 0, XCD_BAR_WORDS * 4, stream);
    Args a{};
    for (int i = 0; i < 24; ++i) a.in[i] = (const float*)d_in[i];
    a.out = (float*)d_out; a.ws = (unsigned char*)d_ws;
#if MK_ONE_LAUNCH
    a.ph_lo = 0; a.ph_hi = NPHASES;
    hipLaunchKernelGGL(hybrid_fwd, dim3(grid), dim3(NTHREADS), LDS_BYTES, stream, a);
#else
    for (int ph = 0; ph < NPHASES; ++ph) {
        a.ph_lo = ph; a.ph_hi = ph + 1;
        hipLaunchKernelGGL(hybrid_fwd, dim3(grid), dim3(NTHREADS), LDS_BYTES, stream, a);
    }
#endif
}
```

```cpp
#include <hip/hip_runtime.h>
#include <cstdio>
#include <cstdint>
namespace pg8 {
#define PG8_LAS __attribute__((address_space(3)))
typedef unsigned short bf16_t;
typedef short bf16x8 __attribute__((ext_vector_type(8)));
typedef float f32x4 __attribute__((ext_vector_type(4)));
typedef unsigned u32x4 __attribute__((ext_vector_type(4)));
constexpr int BM = 256, BK = 64, HALF = 128, HTB = HALF * BK * 2  , STAGE_BYTES = 8 * HTB, NXCD = 8, WGM = 8;

__host__ __device__ __forceinline__ int lds_byte(int r, int c) { const int st = (r >> 4) * 2 + (c >> 5), rr = r & 15, cc = c & 31, ob = rr * 64 + cc * 2; return st * 1024 + (ob ^ (((ob >> 9) & 1) << 5)); }
__host__ __device__ __forceinline__ void stage_rc(int b, int& R, int& C) { const int st = b / 1024, sb = b % 1024, swz = sb ^ (((sb >> 9) & 1) << 5); R = (st >> 1) * 16 + swz / 64; C = (st & 1) * 32 + (swz % 64) / 2; }
__host__ __device__ __forceinline__ int perm32(int rho) { const int n = rho >> 4, i = rho & 15; return 8 * (i >> 2) + 4 * n + (i & 3); }

struct Unit { int pm, pn; };
struct Gemm { const bf16_t* A; const bf16_t* Bt; int M, N, K; int pm_split; size_t bt_split_bytes; };

struct StaticOrder {
    int nM, nN, nwg, G, c;
    __host__ __device__ void init(int M, int N, int G_, int c_) { nM = M / BM; nN = N / BM; nwg = nM * nN; G = G_; c = c_; }
    __host__ __device__ bool next(int i, Unit& u) const {
        const long L = (long)i * G + c; if (L >= nwg) return false;
        int wgid = (int)L; { const int q = nwg / NXCD, r = nwg % NXCD, xcd = wgid % NXCD, off = wgid / NXCD; wgid = (xcd < r ? xcd * (q + 1) : r * (q + 1) + (xcd - r) * q) + off; }
        const int nig = WGM * nN, gid = wgid / nig, fm = gid * WGM, gsz = (nM - fm) < WGM ? (nM - fm) : WGM;
        u.pm = fm + ((wgid % nig) % gsz); u.pn = (wgid % nig) / gsz; return true;
    }
    __device__ __forceinline__ void a_ready(const Unit&) const {}
    __device__ __forceinline__ void done(const Unit&) const {}
};
__device__ __forceinline__ unsigned cvt_pk_bf16(float lo, float hi) { unsigned r; asm volatile("v_cvt_pk_bf16_f32 %0, %1, %2" : "=v"(r) : "v"(lo), "v"(hi)); return r; }
typedef float f32x2 __attribute__((ext_vector_type(2)));
__device__ __forceinline__ f32x2 gelu_pk(f32x2 v) {
    const f32x2 av = __builtin_elementwise_abs(v), d = av * 0.2316418882f + 1.0f;
    f32x2 t; t.x = __builtin_amdgcn_rcpf(d.x); t.y = __builtin_amdgcn_rcpf(d.y);
    f32x2 q = t * 0.5307027145f + (-0.7265760135f); q = q * t + 0.7107068705f; q = q * t + (-0.142248368f); q = q * t + 0.127414796f; q = q * t;
    const f32x2 s = (v * v) * (-0.72134752044f);
    f32x2 e; e.x = __builtin_amdgcn_exp2f(s.x); e.y = __builtin_amdgcn_exp2f(s.y);
    const f32x2 m = v * (q * e), r = v - m;
    f32x2 o; o.x = v.x < 0.f ? m.x : r.x; o.y = v.y < 0.f ? m.y : r.y; return o;
}

template <class Epi, class Sched, bool STAMP = false>
__device__ __forceinline__ void gemm_phase(PG8_LAS unsigned char* lds, const Gemm g, const Sched& S, const Epi& E, unsigned long long* stamps) {
    const int tid = threadIdx.x, wid = __builtin_amdgcn_readfirstlane(tid >> 6), lane = tid & 63, wr = wid >> 2, wc = wid & 3, fr = lane & 15, fq = lane >> 4;
    const int K = g.K, nt = K / BK;
    int ts_lo = 0, ts_hi = 0, nts = 0; const unsigned long long rt_entry = STAMP ? (unsigned long long)wall_clock64() : 0ull;
#define PG8_STAMP() do { if (STAMP && wid == 0 && nts < 64) { const unsigned long long _c = (unsigned long long)clock64(); \
        ts_lo = (lane == nts) ? (int)(unsigned)_c : ts_lo; ts_hi = (lane == nts) ? (int)(unsigned)(_c >> 32) : ts_hi; ++nts; } } while (0)
    PG8_STAMP();
    unsigned voffA[2], voffB[2];
#pragma unroll
    for (int i = 0; i < 2; ++i) { int R, C; stage_rc(tid * 16 + i * 8192, R, C); const int Rb = Epi::PERM ? ((R & ~31) + perm32(R & 31)) : R;
        voffA[i] = (unsigned)(R * K + C) * 2u; voffB[i] = (unsigned)(Rb * K + C) * 2u; }
    const size_t kstep = (size_t)(BK * 2);
    const size_t hstep = (size_t)HALF * K * 2;
    const size_t tstep = 2 * hstep;
    const unsigned ldsw = (unsigned)wid * 1024u;
    const int aoff = lds_byte(wr * 64 + fr, fq * 8), boff = lds_byte(wc * 32 + fr, fq * 8);
#define PG8_SA(b, h) (((b) * 2 + (h)) * HTB)
#define PG8_SB(b, h) ((4 + (b) * 2 + (h)) * HTB)
#define PG8_STAGE(bufoff, gbase, voff) do { _Pragma("unroll") for (int _i = 0; _i < 2; ++_i) \
        __builtin_amdgcn_global_load_lds((const unsigned*)((const char*)(gbase) + (voff)[_i]), (PG8_LAS unsigned*)(lds + (bufoff) + ldsw + _i * 8192), 16, 0, 0); } while (0)
#define PG8_LDA(dst, b, h) do { _Pragma("unroll") for (int m = 0; m < 4; ++m) _Pragma("unroll") for (int k = 0; k < 2; ++k) dst[m][k] = *(const PG8_LAS bf16x8*)(lds + PG8_SA(b, h) + aoff + m * 2048 + k * 1024); } while (0)
#define PG8_LDB(dst, b, h) do { _Pragma("unroll") for (int n = 0; n < 2; ++n) _Pragma("unroll") for (int k = 0; k < 2; ++k) dst[n][k] = *(const PG8_LAS bf16x8*)(lds + PG8_SB(b, h) + boff + n * 2048 + k * 1024); } while (0)
#define PG8_MMA(ai, bj, At, Bt) do { __builtin_amdgcn_s_setprio(1); _Pragma("unroll") for (int m = 0; m < 4; ++m) _Pragma("unroll") for (int n = 0; n < 2; ++n) _Pragma("unroll") for (int k = 0; k < 2; ++k) \
        acc[ai][bj][m][n] = __builtin_amdgcn_mfma_f32_16x16x32_bf16(Bt[n][k], At[m][k], acc[ai][bj][m][n], 0, 0, 0); __builtin_amdgcn_s_setprio(0); } while (0)
#define PG8_WAIT_V(n) asm volatile("s_waitcnt vmcnt(" #n ")" ::: "memory")
#define PG8_WAIT_L(n) asm volatile("s_waitcnt lgkmcnt(" #n ")" ::: "memory")
#define PG8_BAR __builtin_amdgcn_s_barrier()
#define PG8_SCHED __builtin_amdgcn_sched_barrier(0)
    Unit cur, nxt; int ui = 0;
    if (!S.next(0, cur)) return;
    f32x4 acc[2][2][4][2];
#pragma unroll
    for (int a = 0; a < 2; ++a)
#pragma unroll
        for (int b = 0; b < 2; ++b)
#pragma unroll
            for (int m = 0; m < 4; ++m)
#pragma unroll
                for (int n = 0; n < 2; ++n) acc[a][b][m][n] = (f32x4){0.f, 0.f, 0.f, 0.f};
    bf16x8 At[4][2], B0[2][2], B1[2][2];
    const char* cA = (const char*)g.A + (size_t)cur.pm * tstep; const char* cB = (const char*)g.Bt + (size_t)cur.pn * tstep + ((g.pm_split > 0 && cur.pm >= g.pm_split) ? g.bt_split_bytes : (size_t)0);
    S.a_ready(cur);
    PG8_STAGE(PG8_SB(0, 0), cB, voffB); PG8_STAGE(PG8_SA(0, 0), cA, voffA); PG8_STAGE(PG8_SB(0, 1), cB + hstep, voffB); PG8_STAGE(PG8_SA(0, 1), cA + hstep, voffA);
    if (wr == 1) PG8_BAR;
    PG8_WAIT_V(4); PG8_BAR;
    PG8_STAGE(PG8_SB(1, 0), cB + kstep, voffB); PG8_STAGE(PG8_SA(1, 0), cA + kstep, voffA); PG8_STAGE(PG8_SB(1, 1), cB + hstep + kstep, voffB);
    PG8_WAIT_V(6); PG8_BAR;
    PG8_STAMP();
    for (;;) {
        const bool has_next = S.next(ui + 1, nxt);
        const char* nA = has_next ? (const char*)g.A + (size_t)nxt.pm * tstep : cA; const char* nB = has_next ? (const char*)g.Bt + (size_t)nxt.pn * tstep + ((g.pm_split > 0 && nxt.pm >= g.pm_split) ? g.bt_split_bytes : (size_t)0) : cB;
        for (int t = 0; t < nt; t += 2) {
            const bool last = (t == nt - 2);
            const char* a1 = cA + (size_t)(t + 1) * kstep;
            const char* a2 = last ? nA : cA + (size_t)(t + 2) * kstep; const char* b2 = last ? nB : cB + (size_t)(t + 2) * kstep;
            const char* a3 = a2 + kstep; const char* b3 = b2 + kstep;
            if (last && has_next) S.a_ready(nxt);
            PG8_LDB(B0, 0, 0); PG8_SCHED; PG8_LDA(At, 0, 0); PG8_STAGE(PG8_SA(1, 1), a1 + hstep, voffA);
            PG8_WAIT_L(8); PG8_BAR; PG8_WAIT_L(0); PG8_MMA(0, 0, At, B0); PG8_BAR; PG8_SCHED;
            PG8_LDB(B1, 0, 1); PG8_STAGE(PG8_SB(0, 0), b2, voffB);
            PG8_BAR; PG8_WAIT_L(0); PG8_MMA(0, 1, At, B1); PG8_BAR;
            PG8_LDA(At, 0, 1); PG8_STAGE(PG8_SA(0, 0), a2, voffA);
            PG8_BAR; PG8_WAIT_L(0); PG8_MMA(1, 0, At, B0); PG8_BAR; PG8_SCHED;
            PG8_STAGE(PG8_SB(0, 1), b2 + hstep, voffB);
            PG8_WAIT_V(6); PG8_BAR; PG8_MMA(1, 1, At, B1); PG8_BAR;
            PG8_LDB(B0, 1, 0); PG8_SCHED; PG8_LDA(At, 1, 0); PG8_STAGE(PG8_SA(0, 1), a2 + hstep, voffA);
            PG8_WAIT_L(8); PG8_BAR; PG8_WAIT_L(0); PG8_MMA(0, 0, At, B0); PG8_BAR; PG8_SCHED;
            PG8_LDB(B1, 1, 1); PG8_STAGE(PG8_SB(1, 0), b3, voffB);
            PG8_BAR; PG8_WAIT_L(0); PG8_MMA(0, 1, At, B1); PG8_BAR;
            PG8_LDA(At, 1, 1); PG8_STAGE(PG8_SA(1, 0), a3, voffA);
            PG8_BAR; PG8_WAIT_L(0); PG8_MMA(1, 0, At, B0); PG8_BAR; PG8_SCHED;
            PG8_STAGE(PG8_SB(1, 1), b3 + hstep, voffB);
            PG8_WAIT_V(6); PG8_BAR; PG8_MMA(1, 1, At, B1); PG8_BAR;
        }
        PG8_STAMP();
        if constexpr (!Epi::AFTER_DRAIN) { E(acc, cur, wr, wc, fr, fq); S.done(cur); }
        PG8_STAMP();
        if (!has_next) break;
#pragma unroll
        for (int a = 0; a < 2; ++a)
#pragma unroll
            for (int b = 0; b < 2; ++b)
#pragma unroll
                for (int m = 0; m < 4; ++m)
#pragma unroll
                    for (int n = 0; n < 2; ++n) acc[a][b][m][n] = (f32x4){0.f, 0.f, 0.f, 0.f};
        cur = nxt; cA = nA; cB = nB; ++ui;
    }
    PG8_WAIT_V(0);
    if (wr == 0) PG8_BAR;
    PG8_BAR;
    if constexpr (Epi::AFTER_DRAIN) { E.fused(acc, cur, wr, wc, fr, fq, lds, wid, lane); S.done(cur); }
    PG8_STAMP();
    if (STAMP && wid == 0) { stamps[lane] = lane < nts ? (((unsigned long long)(unsigned)ts_hi << 32) | (unsigned)ts_lo) : 0ull;
        if (lane == 62) stamps[62] = rt_entry; if (lane == 63) stamps[63] = (unsigned long long)wall_clock64(); }
#undef PG8_STAMP
#undef PG8_SA
#undef PG8_SB
#undef PG8_STAGE
#undef PG8_LDA
#undef PG8_LDB
#undef PG8_MMA
#undef PG8_WAIT_V
#undef PG8_WAIT_L
#undef PG8_BAR
#undef PG8_SCHED
}
}

#define LAS __attribute__((address_space(3)))
typedef unsigned short bf16_t;
typedef short bf16x8 __attribute__((ext_vector_type(8)));
typedef short bf16x4 __attribute__((ext_vector_type(4)));
typedef float f32x4 __attribute__((ext_vector_type(4)));
typedef unsigned u32x4 __attribute__((ext_vector_type(4)));
typedef unsigned u32x2 __attribute__((ext_vector_type(2)));

constexpr int D = 1024, NB = 2, SEQ = 8192, MTOK = NB * SEQ, MEMLEN = 256;
constexpr int NPROJ = 2304;
constexpr int C_MQ = 0, C_MK = 256, C_MV = 512, C_MO = 1024, C_AQ = 1536, C_AK = 2048, C_AV = 2176;
constexpr float EPS = 1e-6f;
constexpr int NTHREADS = 512, NWAVES = 8;
constexpr int LDS_BYTES = 144 * 1024;

constexpr size_t MiB = (size_t)1 << 20;
constexpr size_t WS_A = 0;
constexpr size_t WS_B = 72 * MiB;
constexpr size_t WS_C = 104 * MiB;
constexpr size_t WS_ED = 136 * MiB;
constexpr size_t WS_EU = 152 * MiB;
constexpr size_t WS_WIN = 200 * MiB;
constexpr size_t WS_WOUT = WS_WIN + 2304 * 1024 * 2;
constexpr size_t WS_WXQ = WS_WOUT + 2 * MiB;
constexpr size_t WS_WXKV = WS_WXQ + 2 * MiB;
constexpr size_t WS_WXO = WS_WXKV + 4 * MiB;
constexpr size_t WS_WPQ = WS_WXO + 2 * MiB;
constexpr size_t WS_G = 219 * MiB;
constexpr size_t WS_GATES = WS_G;
constexpr size_t WS_KMEM = WS_GATES + 512 * 1024;
constexpr size_t WS_VTMEM = WS_KMEM + MiB;
constexpr size_t WS_SSQ = WS_VTMEM + MiB;
constexpr size_t WS_DN = WS_SSQ + MiB;
constexpr size_t WS_DECAY = WS_DN + 256 * 1024;
constexpr size_t WS_SK = WS_DECAY + 4096;
constexpr size_t WS_ESC = WS_SK + 65536;
constexpr size_t WS_SELE = WS_A + 64 * MiB;
constexpr size_t WS_SELG = WS_C;
constexpr size_t WS_COEF = WS_C + 8 * MiB;
constexpr size_t WS_R2 = WS_C + 16 * MiB;
constexpr size_t WS_SSQ3 = WS_C + 17 * MiB;
constexpr size_t WS_PART = WS_A;
constexpr size_t WS_H3 = WS_A;
constexpr size_t WS_ST = 168 * MiB;
constexpr size_t WS_HQH = 168 * MiB;
constexpr size_t WS_HQL = 184 * MiB;
constexpr size_t WS_HS = WS_C + 18 * MiB;
constexpr size_t WS_CS = WS_C + 19 * MiB;
constexpr size_t WS_BAR = 223 * MiB;
constexpr size_t WS_BTO = 224 * MiB;
constexpr size_t WS_WGR = 228 * MiB;
constexpr size_t WS_END = 232 * MiB;

struct Args {
    const float* in[24];
    float* out;
    unsigned char* ws;
    int ph_lo, ph_hi;
};
enum { I_X = 0, I_MEM, I_GMIX, I_WIN, I_CONVW, I_CONVB, I_BI, I_BF, I_GMHEAD, I_SINKS, I_WOUT, I_GCROSS, I_GMEM, I_WXQ, I_WXK, I_WXV, I_WXO,
       I_GFFN, I_WPQ, I_SK1, I_SK2, I_EDOWN, I_EUP, I_GFINAL };

typedef __bf16 bf16x2_t __attribute__((ext_vector_type(2)));
typedef float f32x2_t __attribute__((ext_vector_type(2)));
__device__ __forceinline__ unsigned pk2(float lo, float hi) { f32x2_t v = {lo, hi}; bf16x2_t b = __builtin_convertvector(v, bf16x2_t); return __builtin_bit_cast(unsigned, b); }
__device__ __forceinline__ bf16_t f2bf(float f) { return (bf16_t)(pk2(f, 0.f) & 0xffffu); }
__device__ __forceinline__ float bf2f(unsigned b) { return __uint_as_float(b << 16); }
__device__ __forceinline__ float bflo(unsigned w) { return __uint_as_float(w << 16); }
__device__ __forceinline__ float bfhi(unsigned w) { return __uint_as_float(w & 0xffff0000u); }
__device__ __forceinline__ float wave_sum(float v) {
#pragma unroll
    for (int o = 1; o < 64; o <<= 1) v += __shfl_xor(v, o);
    return v;
}
__device__ __forceinline__ float sigmoidf_(float x) { return 1.f / (1.f + __expf(-x)); }
#define LDS_FENCE() asm volatile("s_waitcnt lgkmcnt(0)" ::: "memory")

__device__ __forceinline__ unsigned dppu(unsigned x, int ctrl_sel) {
    switch (ctrl_sel) {
        case 0: return (unsigned)__builtin_amdgcn_update_dpp(0, (int)x, 0xB1, 0xF, 0xF, true);
        case 1: return (unsigned)__builtin_amdgcn_update_dpp(0, (int)x, 0x4E, 0xF, 0xF, true);
        case 2: return (unsigned)__builtin_amdgcn_update_dpp(0, (int)x, 0x141, 0xF, 0xF, true);
        default: return (unsigned)__builtin_amdgcn_update_dpp(0, (int)x, 0x140, 0xF, 0xF, true);
    }
}
__device__ __forceinline__ unsigned row16_max_u32(unsigned x) {
    unsigned y;
    y = dppu(x, 0); x = x > y ? x : y;
    y = dppu(x, 1); x = x > y ? x : y;
    y = dppu(x, 2); x = x > y ? x : y;
    y = dppu(x, 3); x = x > y ? x : y;
    return x;
}
__device__ __forceinline__ float row16_sum_f32(float x) {
    x += __uint_as_float(dppu(__float_as_uint(x), 0));
    x += __uint_as_float(dppu(__float_as_uint(x), 1));
    x += __uint_as_float(dppu(__float_as_uint(x), 2));
    x += __uint_as_float(dppu(__float_as_uint(x), 3));
    return x;
}
__device__ __forceinline__ float row16_max_f32(float x) {
    x = fmaxf(x, __uint_as_float(dppu(__float_as_uint(x), 0)));
    x = fmaxf(x, __uint_as_float(dppu(__float_as_uint(x), 1)));
    x = fmaxf(x, __uint_as_float(dppu(__float_as_uint(x), 2)));
    x = fmaxf(x, __uint_as_float(dppu(__float_as_uint(x), 3)));
    return x;
}
__device__ __forceinline__ f32x4 mfma16(bf16x8 a, bf16x8 b, f32x4 c) { return __builtin_amdgcn_mfma_f32_16x16x32_bf16(a, b, c, 0, 0, 0); }

__device__ __forceinline__ float row_rscale(const float* ssq, int row) {
    float s = 0.f;
#pragma unroll
    for (int p = 0; p < 16; ++p) s += ssq[(size_t)p * MTOK + row];
    return rsqrtf(s * (1.f / D) + EPS);
}
struct EpiRowBf16 {
    static constexpr bool PERM = true, AFTER_DRAIN = false;
    bf16_t* O; int ldc; const float* ssq; float mul;
    __device__ __forceinline__ void operator()(const f32x4 (&acc)[2][2][4][2], const pg8::Unit& u, int wr, int wc, int fr, int fq) const {
        const int row0 = u.pm * 256 + wr * 64 + fr, col0 = u.pn * 256 + wc * 32 + 8 * fq;
#pragma unroll
        for (int ai = 0; ai < 2; ++ai)
#pragma unroll
            for (int m = 0; m < 4; ++m) {
                const int row = row0 + ai * 128 + m * 16;
                const float sc = ssq ? row_rscale(ssq, row) * mul : mul;
                bf16_t* rowp = O + (size_t)row * ldc + col0;
#pragma unroll
                for (int bj = 0; bj < 2; ++bj) {
                    const f32x4 v0 = acc[ai][bj][m][0] * sc, v1 = acc[ai][bj][m][1] * sc;
                    u32x4 w; w.x = pk2(v0[0], v0[1]); w.y = pk2(v0[2], v0[3]); w.z = pk2(v1[0], v1[1]); w.w = pk2(v1[2], v1[3]);
                    *(u32x4*)(rowp + bj * 128) = w;
                }
            }
    }
};
template <bool RES_BF16>
struct EpiResid {
    static constexpr bool PERM = true, AFTER_DRAIN = false;
    const void* R; bf16_t* Hb; float* ssq;
    __device__ __forceinline__ void operator()(const f32x4 (&acc)[2][2][4][2], const pg8::Unit& u, int wr, int wc, int fr, int fq) const {
        const int row0 = u.pm * 256 + wr * 64 + fr, col0 = u.pn * 256 + wc * 32 + 8 * fq;
#pragma unroll
        for (int ai = 0; ai < 2; ++ai)
#pragma unroll
            for (int m = 0; m < 4; ++m) {
                const int row = row0 + ai * 128 + m * 16;
                const size_t off = (size_t)row * D + col0;
                float ss = 0.f;
#pragma unroll
                for (int bj = 0; bj < 2; ++bj) {
                    f32x4 r0, r1;
                    if (RES_BF16) { const u32x4 rb = *(const u32x4*)((const bf16_t*)R + off + bj * 128);
                        r0 = (f32x4){bflo(rb.x), bfhi(rb.x), bflo(rb.y), bfhi(rb.y)}; r1 = (f32x4){bflo(rb.z), bfhi(rb.z), bflo(rb.w), bfhi(rb.w)}; }
                    else { r0 = *(const f32x4*)((const float*)R + off + bj * 128); r1 = *(const f32x4*)((const float*)R + off + bj * 128 + 4); }
                    const f32x4 v0 = acc[ai][bj][m][0] + r0, v1 = acc[ai][bj][m][1] + r1;
                    u32x4 w; w.x = pk2(v0[0], v0[1]); w.y = pk2(v0[2], v0[3]); w.z = pk2(v1[0], v1[1]); w.w = pk2(v1[2], v1[3]);
                    *(u32x4*)(Hb + off + bj * 128) = w;
                    ss += v0[0] * v0[0] + v0[1] * v0[1] + v0[2] * v0[2] + v0[3] * v0[3] + v1[0] * v1[0] + v1[1] * v1[1] + v1[2] * v1[2] + v1[3] * v1[3];
                }
                ss += __shfl_xor(ss, 16); ss += __shfl_xor(ss, 32);
                if (fq == 0) ssq[(size_t)(u.pn * 4 + wc) * MTOK + row] = ss;
            }
    }
};
struct EpiKV {
    static constexpr bool PERM = true, AFTER_DRAIN = false;
    bf16_t* Kh; bf16_t* Vh;
    __device__ __forceinline__ void operator()(const f32x4 (&acc)[2][2][4][2], const pg8::Unit& u, int wr, int wc, int fr, int fq) const {
        const int row0 = u.pm * 256 + wr * 64 + fr, col0 = u.pn * 256 + wc * 32 + 8 * fq;
#pragma unroll
        for (int ai = 0; ai < 2; ++ai)
#pragma unroll
            for (int m = 0; m < 4; ++m) {
                const int row = row0 + ai * 128 + m * 16;
#pragma unroll
                for (int bj = 0; bj < 2; ++bj) {
                    const f32x4 v0 = acc[ai][bj][m][0], v1 = acc[ai][bj][m][1];
                    const int c = col0 + bj * 128, cc = c & 1023;
                    u32x4 w; w.x = pk2(v0[0], v0[1]); w.y = pk2(v0[2], v0[3]); w.z = pk2(v1[0], v1[1]); w.w = pk2(v1[2], v1[3]);
                    *(u32x4*)((c < 1024 ? Kh : Vh) + ((size_t)((row >> 8) * 4 + (cc >> 8)) * 256 + (row & 255)) * 256 + (cc & 255)) = w;
                }
            }
    }
};
struct EpiSoftmax {
    static constexpr bool PERM = true, AFTER_DRAIN = true;
    bf16_t* O; const float* ssq;
    __device__ __forceinline__ void operator()(const f32x4 (&)[2][2][4][2], const pg8::Unit&, int, int, int, int) const {}
    __device__ __forceinline__ void fused(const f32x4 (&acc)[2][2][4][2], const pg8::Unit& u, int wr, int wc, int fr, int fq, LAS unsigned char* lds, int wid, int lane) const {
        LAS float* red = (LAS float*)lds;
        const int row0 = u.pm * 256 + wr * 64 + fr, col0 = u.pn * 256 + wc * 32 + 8 * fq;
        float sc[2][4];
#pragma unroll
        for (int ai = 0; ai < 2; ++ai)
#pragma unroll
            for (int m = 0; m < 4; ++m) {
                sc[ai][m] = row_rscale(ssq, row0 + ai * 128 + m * 16);
                float v = -INFINITY;
#pragma unroll
                for (int bj = 0; bj < 2; ++bj)
#pragma unroll
                    for (int n = 0; n < 2; ++n)
#pragma unroll
                        for (int j = 0; j < 4; ++j) v = fmaxf(v, acc[ai][bj][m][n][j] * sc[ai][m]);
                v = fmaxf(v, __shfl_xor(v, 16)); v = fmaxf(v, __shfl_xor(v, 32));
                if (fq == 0) red[wc * 256 + ai * 128 + wr * 64 + m * 16 + fr] = v;
            }
        __syncthreads();
        float rsum[2][4], rmax[2][4];
#pragma unroll
        for (int ai = 0; ai < 2; ++ai)
#pragma unroll
            for (int m = 0; m < 4; ++m) {
                const int rl = ai * 128 + wr * 64 + m * 16 + fr;
                rmax[ai][m] = fmaxf(fmaxf(red[rl], red[256 + rl]), fmaxf(red[512 + rl], red[768 + rl]));
                float s = 0.f;
#pragma unroll
                for (int bj = 0; bj < 2; ++bj)
#pragma unroll
                    for (int n = 0; n < 2; ++n)
#pragma unroll
                        for (int j = 0; j < 4; ++j) s += __expf(acc[ai][bj][m][n][j] * sc[ai][m] - rmax[ai][m]);
                s += __shfl_xor(s, 16); s += __shfl_xor(s, 32);
                if (fq == 0) red[1024 + wc * 256 + rl] = s;
            }
        __syncthreads();
#pragma unroll
        for (int ai = 0; ai < 2; ++ai)
#pragma unroll
            for (int m = 0; m < 4; ++m) {
                const int rl = ai * 128 + wr * 64 + m * 16 + fr;
                const float inv = 1.f / ((red[1024 + rl] + red[1280 + rl]) + (red[1536 + rl] + red[1792 + rl]));
                rsum[ai][m] = inv;
                bf16_t* rowp = O + (size_t)(row0 + ai * 128 + m * 16) * D + col0;
#pragma unroll
                for (int bj = 0; bj < 2; ++bj) {
                    float e[2][4];
#pragma unroll
                    for (int n = 0; n < 2; ++n)
#pragma unroll
                        for (int j = 0; j < 4; ++j) e[n][j] = __expf(acc[ai][bj][m][n][j] * sc[ai][m] - rmax[ai][m]) * inv;
                    u32x4 w; w.x = pk2(e[0][0], e[0][1]); w.y = pk2(e[0][2], e[0][3]); w.z = pk2(e[1][0], e[1][1]); w.w = pk2(e[1][2], e[1][3]);
                    *(u32x4*)(rowp + bj * 128) = w;
                }
            }
        __syncthreads();
    }
};

__device__ __forceinline__ void p0_transpose_item(const float* W, int ldw, int col0, int K, bf16_t* WT, int row0, const float* g, LAS float* scr, int item, int nblk, int lane) {
    const int kb = item / nblk, nb = item % nblk, k0 = 64 * kb, n0 = 32 * nb;
    float tv[32];
#pragma unroll
    for (int i = 0; i < 32; ++i) tv[i] = W[(size_t)(k0 + 2 * i + (lane >> 5)) * ldw + col0 + n0 + (lane & 31)];
#pragma unroll
    for (int i = 0; i < 32; ++i) {
        const int kk = 2 * i + (lane >> 5);
        float v = tv[i];
        if (g) v *= g[k0 + kk];
        scr[kk * 33 + (lane & 31)] = v;
    }
    LDS_FENCE();
    const int c = lane & 7;
#pragma unroll
    for (int j = 0; j < 4; ++j) {
        const int n = (lane >> 3) + 8 * j; const LAS float* s = scr + (8 * c) * 33 + n;
        u32x4 o; o.x = pk2(s[0 * 33], s[1 * 33]); o.y = pk2(s[2 * 33], s[3 * 33]); o.z = pk2(s[4 * 33], s[5 * 33]); o.w = pk2(s[6 * 33], s[7 * 33]);
        *(u32x4*)(WT + (size_t)(row0 + n0 + n) * K + k0 + 8 * c) = o;
    }
    LDS_FENCE();
}
__device__ __forceinline__ void rms_row_load(const float* xrow, int lane, f32x4 (&v)[4]) {
    const f32x4* xr = (const f32x4*)xrow + lane;
#pragma unroll
    for (int j = 0; j < 4; ++j) v[j] = xr[64 * j];
}
__device__ __forceinline__ void rms_row_finish(const float* g, bf16_t* orow, int lane, f32x4 (&v)[4]) {
    float s = 0.f;
#pragma unroll
    for (int j = 0; j < 4; ++j) s += (v[j][0] * v[j][0] + v[j][1] * v[j][1]) + (v[j][2] * v[j][2] + v[j][3] * v[j][3]);
    const float r = rsqrtf(wave_sum(s) * (1.f / D) + EPS);
    unsigned long long* o8 = (unsigned long long*)orow + lane;
#pragma unroll
    for (int j = 0; j < 4; ++j) {
        const f32x4 gv = ((const f32x4*)g)[lane + 64 * j];
        v[j] = v[j] * r * gv;
        o8[64 * j] = (unsigned long long)pk2(v[j][0], v[j][1]) | ((unsigned long long)pk2(v[j][2], v[j][3]) << 32);
    }
}
__device__ __forceinline__ void p0_late_transposes(const Args& a, LAS unsigned char* lds) {
    const int tid = threadIdx.x, lane = tid & 63, wave = tid >> 6;
    if (wave < 5) return;
    const int G = gridDim.x, gw = blockIdx.x * 3 + (wave - 5), NGW = G * 3;
    unsigned char* ws = a.ws;
    LAS float* scr = (LAS float*)(lds + wave * 8704);
    constexpr int I_SQ = 16 * 32, I_HD = 4 * 32;
    constexpr int NITEMS = I_SQ + 4 * I_HD;
    for (int it = gw; it < NITEMS; it += NGW) {
        int r = it;
        if (r < I_SQ) { p0_transpose_item(a.in[I_WOUT], D, 0, D, (bf16_t*)(ws + WS_WOUT), 0, nullptr, scr, r, 32, lane); continue; } r -= I_SQ;
        { const int h = r / I_HD; p0_transpose_item(a.in[I_WXO] + (size_t)h * 256 * D, D, 0, 256, (bf16_t*)(ws + WS_WXO) + (size_t)h * 1024 * 256, 0, nullptr, scr, r % I_HD, 32, lane); }
    }
    {
        const float* wp = a.in[I_WPQ]; const float* gf = a.in[I_GFFN];
        bf16_t* wgr = (bf16_t*)(ws + WS_WGR);
        for (int i = (blockIdx.x * 3 + (wave - 5)) * 64 + lane; i < 1024 * 256; i += G * 3 * 64) {
            const int k = i >> 8, c8 = (i & 255) * 8;
            const float gk = gf[k];
            const f32x4 v0 = *(const f32x4*)(wp + (size_t)k * 2048 + c8) * gk, v1 = *(const f32x4*)(wp + (size_t)k * 2048 + c8 + 4) * gk;
            u32x4 w; w.x = pk2(v0[0], v0[1]); w.y = pk2(v0[2], v0[3]); w.z = pk2(v1[0], v1[1]); w.w = pk2(v1[2], v1[3]);
            *(u32x4*)(wgr + (size_t)k * 2048 + c8) = w;
        }
    }
    const float* wq = a.in[I_WXQ]; const float* gc = a.in[I_GCROSS];
    bf16_t* wqr = (bf16_t*)(ws + WS_WXQ);
    for (int i = (blockIdx.x * 3 + (wave - 5)) * 64 + lane; i < 1024 * 128; i += G * 3 * 64) {
        const int k = i >> 7, c8 = (i & 127) * 8, h = c8 >> 8, dh = c8 & 255;
        const float gk = gc[k] * 0.0625f;
        const f32x4 v0 = *(const f32x4*)(wq + (size_t)k * D + c8) * gk, v1 = *(const f32x4*)(wq + (size_t)k * D + c8 + 4) * gk;
        u32x4 w; w.x = pk2(v0[0], v0[1]); w.y = pk2(v0[2], v0[3]); w.z = pk2(v1[0], v1[1]); w.w = pk2(v1[2], v1[3]);
        *(u32x4*)(wqr + ((size_t)h * 1024 + k) * 256 + dh) = w;
    }
}
__device__ __forceinline__ void p0_experts(const Args& a, int part, int npart) {
    const int tid = threadIdx.x, lane = tid & 63, wave = tid >> 6;
    const int gw = part * NWAVES + wave, NGW = npart * NWAVES;
    unsigned char* ws = a.ws;
    {
        const float* gf = a.in[I_GFFN];
        float* esc = (float*)(ws + WS_ESC);
        f32x4 gv[4];
#pragma unroll
        for (int j = 0; j < 4; ++j) gv[j] = *(const f32x4*)(gf + 4 * lane + 256 * j);
        for (int r0 = 4 * gw; r0 < 2 * 16384; r0 += 4 * NGW) {
            f32x4 v[4][4];
#pragma unroll
            for (int q = 0; q < 4; ++q) {
                const int r = r0 + q; const bool up = r >= 16384; const int e = up ? r - 16384 : r;
                const float* src = (up ? a.in[I_EUP] : a.in[I_EDOWN]) + (size_t)e * D + 4 * lane;
#pragma unroll
                for (int j = 0; j < 4; ++j) v[q][j] = __builtin_nontemporal_load((const f32x4*)(src + 256 * j));
            }
#pragma unroll
            for (int q = 0; q < 4; ++q) {
                const int r = r0 + q; const bool up = r >= 16384; const int e = up ? r - 16384 : r;
                float am = 0.f;
#pragma unroll
                for (int j = 0; j < 4; ++j) { if (!up) v[q][j] = v[q][j] * gv[j];
                    am = fmaxf(am, fmaxf(fmaxf(fabsf(v[q][j][0]), fabsf(v[q][j][1])), fmaxf(fabsf(v[q][j][2]), fabsf(v[q][j][3])))); }
                am = row16_max_f32(am); am = fmaxf(am, __shfl_xor(am, 16)); am = fmaxf(am, __shfl_xor(am, 32));
                const float sc = am > 0.f ? am * (1.f / 127.f) : 1.f, inv = 1.f / sc;
                unsigned char* dstp = ws + (up ? WS_EU : WS_ED) + (size_t)(lane >> 5) * (16384 * 128) + (size_t)e * 128 + 4 * (lane & 31);
                const size_t jstep = (size_t)2 * 16384 * 128;
#pragma unroll
                for (int j = 0; j < 4; ++j) {
                    const int q0 = (int)rintf(v[q][j][0] * inv), q1 = (int)rintf(v[q][j][1] * inv), q2 = (int)rintf(v[q][j][2] * inv), q3 = (int)rintf(v[q][j][3] * inv);
                    *(unsigned*)(dstp + jstep * j) = (unsigned)(q0 & 255) | ((unsigned)(q1 & 255) << 8) | ((unsigned)(q2 & 255) << 16) | ((unsigned)q3 << 24);
                }
                if (lane == 0) esc[r] = sc;
            }
        }
    }
}
__device__ __forceinline__ void phase0(const Args& a, LAS unsigned char* lds) {
    const int tid = threadIdx.x, lane = tid & 63, wave = tid >> 6;
    const int G = gridDim.x, gw = blockIdx.x * NWAVES + wave, NGW = G * NWAVES;
    unsigned char* ws = a.ws;
    LAS float* scr = (LAS float*)(lds + wave * 8704);
    {
        constexpr int I_W1 = 16 * 48, I_W2 = 16 * 24, I_SQ = 16 * 32;
        constexpr int NITEMS = I_W1 + I_W2 + 2 * I_SQ;
        for (int it = gw; it < NITEMS; it += NGW) {
            int r = it;
            if (r < I_W1) { p0_transpose_item(a.in[I_WIN], 2312, 0, D, (bf16_t*)(ws + WS_WIN), 0, nullptr, scr, r, 48, lane); continue; } r -= I_W1;
            if (r < I_W2) { p0_transpose_item(a.in[I_WIN], 2312, 1544, D, (bf16_t*)(ws + WS_WIN), 1536, nullptr, scr, r, 24, lane); continue; } r -= I_W2;
            if (r < I_SQ) { p0_transpose_item(a.in[I_WXK], D, 0, D, (bf16_t*)(ws + WS_WXKV), 0, nullptr, scr, r, 32, lane); continue; } r -= I_SQ;
            p0_transpose_item(a.in[I_WXV], D, 0, D, (bf16_t*)(ws + WS_WXKV), 1024, nullptr, scr, r, 32, lane);
        }
    }
    {
        const size_t T = (size_t)G * NTHREADS, gt = (size_t)blockIdx.x * NTHREADS + tid;
        for (size_t i = gt; i < 2 * 16384 / 8; i += T) {
            const bool s2 = i >= 2048; const size_t j = s2 ? i - 2048 : i;
            const float* src = (s2 ? a.in[I_SK2] : a.in[I_SK1]) + j * 8;
            const f32x4 v0 = *(const f32x4*)src, v1 = *(const f32x4*)(src + 4);
            u32x4 w; w.x = pk2(v0[0], v0[1]); w.y = pk2(v0[2], v0[3]); w.z = pk2(v1[0], v1[1]); w.w = pk2(v1[2], v1[3]);
            *(u32x4*)((bf16_t*)(ws + WS_SK) + (s2 ? 16384 : 0) + j * 8) = w;
        }
    }
    {
        const float* win = a.in[I_WIN];
        float* gates = (float*)(ws + WS_GATES);
        const float* bi = a.in[I_BI]; const float* bfg = a.in[I_BF];
        LAS f32x4* wg = (LAS f32x4*)(lds + 8 * 8704);
        __syncthreads();
        for (int i = tid; i < 2048; i += NTHREADS) {
            const int ln = i & 63, e = (i >> 6) & 3, j = (i >> 8) & 3, half = i >> 10;
            wg[i] = *(const f32x4*)(win + (size_t)(4 * ln + 256 * j + e) * 2312 + 1536 + 4 * half);
        }
        __syncthreads();
        for (int rowp = 2 * gw; rowp < MTOK; rowp += 2 * NGW) {
          f32x4 vv[2][4];
          rms_row_load(a.in[I_X] + (size_t)rowp * D, lane, vv[0]); rms_row_load(a.in[I_X] + (size_t)(rowp + 1) * D, lane, vv[1]);
#pragma unroll
          for (int q = 0; q < 2; ++q) {
            const int row = rowp + q;
            f32x4 (&v)[4] = vv[q];
            rms_row_finish(a.in[I_GMIX], (bf16_t*)(ws + WS_B) + (size_t)row * D, lane, v);
            f32x4 g0 = {0.f, 0.f, 0.f, 0.f}, g1 = {0.f, 0.f, 0.f, 0.f};
#pragma unroll
            for (int j = 0; j < 4; ++j)
#pragma unroll
                for (int e = 0; e < 4; ++e) { const float xv = v[j][e]; g0 += xv * wg[(j * 4 + e) * 64 + lane]; g1 += xv * wg[1024 + (j * 4 + e) * 64 + lane]; }
            const bool b5 = lane & 32, b4 = lane & 16, b3 = lane & 8;
            f32x4 k4, s4;
#pragma unroll
            for (int i = 0; i < 4; ++i) { k4[i] = b5 ? g1[i] : g0[i]; s4[i] = b5 ? g0[i] : g1[i]; }
#pragma unroll
            for (int i = 0; i < 4; ++i) k4[i] += __shfl_xor(s4[i], 32);
            float k2a = b4 ? k4[2] : k4[0], k2b = b4 ? k4[3] : k4[1];
            k2a += __shfl_xor(b4 ? k4[0] : k4[2], 16); k2b += __shfl_xor(b4 ? k4[1] : k4[3], 16);
            float k1 = (b3 ? k2b : k2a) + __shfl_xor(b3 ? k2a : k2b, 8);
            k1 += __uint_as_float(dppu(__float_as_uint(k1), 0)); k1 += __uint_as_float(dppu(__float_as_uint(k1), 1)); k1 += __uint_as_float(dppu(__float_as_uint(k1), 2));
            if ((lane & 7) == 0) {
                const int c = lane >> 3;
                float val = k1;
                if (c < 4) val += bi[c];
                else { const float f = val + bfg[c - 4]; val = fminf(f, 0.f) - log1pf(__expf(-fabsf(f))); }
                gates[(size_t)row * 8 + c] = val;
            }
          }
        }
    }
    for (int row = gw; row < NB * MEMLEN; row += NGW) {
        f32x4 v[4];
        rms_row_load(a.in[I_MEM] + (size_t)row * D, lane, v);
        rms_row_finish(a.in[I_GMEM], (bf16_t*)(ws + WS_C) + (size_t)row * D, lane, v);
    }
}

constexpr int LQ = 72;
__device__ __forceinline__ void conv8_load(const bf16_t* src, int tok_in_seq, u32x4 (&xv)[4]) {
#pragma unroll
    for (int j = 0; j < 4; ++j) { const int d = (tok_in_seq - 3 + j >= 0) ? j - 3 : 0; xv[j] = *(const u32x4*)(src + (ptrdiff_t)d * NPROJ); }
}
__device__ __forceinline__ void conv8_finish(const u32x4 (&xv)[4], int tok_in_seq, const float* cw, const float* cb, int ch, float (&y)[8]) {
#pragma unroll
    for (int e = 0; e < 8; ++e) y[e] = cb[ch + e];
#pragma unroll
    for (int j = 0; j < 4; ++j) {
        const float m = (tok_in_seq - 3 + j >= 0) ? 1.f : 0.f;
        const f32x4 w0 = *(const f32x4*)(cw + j * 512 + ch) * m, w1 = *(const f32x4*)(cw + j * 512 + ch + 4) * m;
        y[0] += w0[0] * bflo(xv[j].x); y[1] += w0[1] * bfhi(xv[j].x); y[2] += w0[2] * bflo(xv[j].y); y[3] += w0[3] * bfhi(xv[j].y);
        y[4] += w1[0] * bflo(xv[j].z); y[5] += w1[1] * bfhi(xv[j].z); y[6] += w1[2] * bflo(xv[j].w); y[7] += w1[3] * bfhi(xv[j].w);
    }
#pragma unroll
    for (int e = 0; e < 8; ++e) y[e] = y[e] * sigmoidf_(y[e]);
}
__device__ __forceinline__ void conv8(const bf16_t* src, int tok_in_seq, const float* cw, const float* cb, int ch, float (&y)[8]) {
    u32x4 xv[4]; conv8_load(src, tok_in_seq, xv); conv8_finish(xv, tok_in_seq, cw, cb, ch, y);
}
__device__ __forceinline__ float chunk_cumsum(float lf, int lane) {
    float b = lf;
#pragma unroll
    for (int o = 1; o < 64; o <<= 1) { const float t = __shfl_up(b, o); if (lane >= o) b += t; }
    return b;
}

__device__ __forceinline__ void mlstm_local(const Args& a, LAS unsigned char* lds, int task) {
    const int tid = threadIdx.x, lane = tid & 63, wave = tid >> 6;
    const int b = task >> 9, h = (task >> 7) & 3, c = task & 127;
    const int row0 = b * SEQ + c * 64;
    const bf16_t* proj = (const bf16_t*)(a.ws + WS_A);
    const float* gates = (const float*)(a.ws + WS_GATES);
    LAS bf16_t* VTw = (LAS bf16_t*)lds;
    LAS bf16_t* KT = (LAS bf16_t*)(lds + 144 * LQ * 2);
    LAS float* wS = (LAS float*)(lds + 144 * LQ * 2 + 64 * LQ * 2);
    if (wave == 0) {
        const float ig = gates[(size_t)(row0 + lane) * 8 + h], lf = gates[(size_t)(row0 + lane) * 8 + 4 + h];
        const float bs = chunk_cumsum(lf, lane);
        const float bL = __shfl(bs, 63);
        wS[lane] = __expf(bL - bs + ig);
        if (lane == 63) ((float*)(a.ws + WS_DECAY))[task] = __expf(bL);
    }
    {
        const int s = tid >> 3, cg = (tid & 7) * 8;
        float y[8];
        conv8(proj + (size_t)(row0 + s) * NPROJ + C_MK + h * 64 + cg, c * 64 + s, a.in[I_CONVW], a.in[I_CONVB], 256 + h * 64 + cg, y);
#pragma unroll
        for (int e = 0; e < 8; ++e) KT[(cg + e) * LQ + s] = f2bf(y[e]);
    }
    __syncthreads();
    {
        const int s = tid >> 3, vg = (tid & 7) * 16;
        const float w = wS[s];
        const u32x4 x0 = *(const u32x4*)(proj + (size_t)(row0 + s) * NPROJ + C_MV + h * 128 + vg), x1 = *(const u32x4*)(proj + (size_t)(row0 + s) * NPROJ + C_MV + h * 128 + vg + 8);
        const unsigned xs[8] = {x0.x, x0.y, x0.z, x0.w, x1.x, x1.y, x1.z, x1.w};
#pragma unroll
        for (int e = 0; e < 8; ++e) { VTw[(vg + 2 * e) * LQ + s] = f2bf(w * bflo(xs[e])); VTw[(vg + 2 * e + 1) * LQ + s] = f2bf(w * bfhi(xs[e])); }
        if ((tid & 7) == 0) VTw[128 * LQ + s] = f2bf(w);
        for (int i = tid; i < 15 * 64; i += NTHREADS) VTw[(129 + (i >> 6)) * LQ + (i & 63)] = 0;
    }
    __syncthreads();
    float* dC = (float*)(a.ws + WS_B) + (size_t)task * 8192;
    float* dn = (float*)(a.ws + WS_DN) + (size_t)task * 64;
    for (int T = wave; T < 36; T += 8) {
        const int mt = T >> 2, nt = T & 3;
        f32x4 acc = {0.f, 0.f, 0.f, 0.f};
#pragma unroll
        for (int ks = 0; ks < 2; ++ks) {
            const bf16x8 av = *(const LAS bf16x8*)(VTw + (mt * 16 + (lane & 15)) * LQ + ks * 32 + 8 * (lane >> 4));
            const bf16x8 bv = *(const LAS bf16x8*)(KT + (nt * 16 + (lane & 15)) * LQ + ks * 32 + 8 * (lane >> 4));
            acc = mfma16(av, bv, acc);
        }
        const int col = nt * 16 + (lane & 15);
        if (mt < 8) {
#pragma unroll
            for (int r = 0; r < 4; ++r) dC[(mt * 16 + (lane >> 4) * 4 + r) * 64 + col] = acc[r];
        } else if ((lane >> 4) == 0) dn[col] = acc[0];
    }
    __syncthreads();
}

__device__ __forceinline__ void mlstm_scan(const Args& a) {
    const size_t T = (size_t)gridDim.x * NTHREADS;
    const float* decay = (const float*)(a.ws + WS_DECAY);
    for (size_t chain = ((size_t)(threadIdx.x >> 6) * gridDim.x + blockIdx.x) * 64 + (threadIdx.x & 63); chain < 8 * 8256; chain += T) {
        const int bh = (int)(chain / 8256), e = (int)(chain % 8256);
        float* p; size_t stride; bf16_t* pst = nullptr;
        if (e < 8192) { p = (float*)(a.ws + WS_B) + (size_t)bh * 128 * 8192 + e; stride = 8192; pst = (bf16_t*)(a.ws + WS_ST) + (size_t)bh * 128 * 8192 + e; }
        else { p = (float*)(a.ws + WS_DN) + (size_t)bh * 128 * 64 + (e - 8192); stride = 64; }
        float C = 0.f;
        for (int c0 = 0; c0 < 128; c0 += 32) {
            float t[32], dk[32];
#pragma unroll
            for (int j = 0; j < 32; ++j) { t[j] = p[(size_t)(c0 + j) * stride]; dk[j] = decay[bh * 128 + c0 + j]; }
#pragma unroll
            for (int j = 0; j < 32; ++j) {
                if (pst) pst[(size_t)(c0 + j) * 8192] = f2bf(C); else p[(size_t)(c0 + j) * stride] = C;
                C = dk[j] * C + t[j];
            }
        }
    }
}

__device__ __forceinline__ void mlstm_out(const Args& a, LAS unsigned char* lds, int task) {
    const int tid = threadIdx.x, lane = tid & 63, wave = tid >> 6;
    const int b = task >> 9, h = (task >> 7) & 3, c = task & 127;
    const int row0 = b * SEQ + c * 64;
    const bf16_t* proj = (const bf16_t*)(a.ws + WS_A);
    const float* gates = (const float*)(a.ws + WS_GATES);
    LAS bf16_t* Qs = (LAS bf16_t*)lds;
    LAS bf16_t* Ks = Qs + 64 * LQ;
    LAS bf16_t* Qp = Ks + 64 * LQ;
    LAS bf16_t* Ps = Qp + 64 * LQ;
    LAS bf16_t* VT = Ps + 64 * LQ;
    LAS bf16_t* Cs = VT + 144 * LQ;
    LAS float* bS = (LAS float*)(Cs + 144 * LQ);
    LAS float* iS = bS + 64;
    LAS float* denS = iS + 64;
    LAS float* ssqS = denS + 64;
    const float ig_l = gates[(size_t)(row0 + lane) * 8 + h], lf_l = gates[(size_t)(row0 + lane) * 8 + 4 + h];
    const float b_l = chunk_cumsum(lf_l, lane);
    if (wave == 0) { bS[lane] = b_l; iS[lane] = ig_l; }
    const float eb_s = __expf(__shfl(b_l, tid >> 3));
    u32x4 qtap[4];
    conv8_load(proj + (size_t)(row0 + (tid >> 3)) * NPROJ + C_MQ + h * 64 + (tid & 7) * 8, c * 64 + (tid >> 3), qtap);
    bf16_t mo_pre[4][4];
#pragma unroll
    for (int r = 0; r < 4; ++r)
#pragma unroll
        for (int i = 0; i < 4; ++i)
            mo_pre[r][i] = proj[(size_t)(row0 + (wave & 3) * 16 + (lane >> 4) * 4 + r) * NPROJ + C_MO + h * 128 + ((wave >> 2) * 4 + i) * 16 + (lane & 15)];
    {
        const int s = tid >> 3, cg = (tid & 7) * 8;
        float y[8];
        conv8(proj + (size_t)(row0 + s) * NPROJ + C_MK + h * 64 + cg, c * 64 + s, a.in[I_CONVW], a.in[I_CONVB], 256 + h * 64 + cg, y);
        u32x4 w; w.x = pk2(y[0], y[1]); w.y = pk2(y[2], y[3]); w.z = pk2(y[4], y[5]); w.w = pk2(y[6], y[7]);
        *(LAS u32x4*)(Ks + s * LQ + cg) = w;
        const int vg = (tid & 7) * 16;
        const u32x4 x0 = *(const u32x4*)(proj + (size_t)(row0 + s) * NPROJ + C_MV + h * 128 + vg), x1 = *(const u32x4*)(proj + (size_t)(row0 + s) * NPROJ + C_MV + h * 128 + vg + 8);
        const unsigned xs[8] = {x0.x, x0.y, x0.z, x0.w, x1.x, x1.y, x1.z, x1.w};
#pragma unroll
        for (int e = 0; e < 8; ++e) { VT[(vg + 2 * e) * LQ + s] = (bf16_t)(xs[e] & 0xffffu); VT[(vg + 2 * e + 1) * LQ + s] = (bf16_t)(xs[e] >> 16); }
        if ((tid & 7) == 0) VT[128 * LQ + s] = 0x3F80;
        for (int i = tid; i < 15 * 64; i += NTHREADS) { VT[(129 + (i >> 6)) * LQ + (i & 63)] = 0; Cs[(129 + (i >> 6)) * LQ + (i & 63)] = 0; }
        const bf16_t* st = (const bf16_t*)(a.ws + WS_ST) + (size_t)task * 8192;
        const int v = tid >> 2, k0 = (tid & 3) * 16;
        *(LAS u32x4*)(Cs + v * LQ + k0) = *(const u32x4*)(st + v * 64 + k0);
        *(LAS u32x4*)(Cs + v * LQ + k0 + 8) = *(const u32x4*)(st + v * 64 + k0 + 8);
        if (tid < 64) Cs[128 * LQ + tid] = f2bf(((const float*)(a.ws + WS_DN))[(size_t)task * 64 + tid]);
    }
    {
        const int s = tid >> 3, cg = (tid & 7) * 8;
        float y[8];
        conv8_finish(qtap, c * 64 + s, a.in[I_CONVW], a.in[I_CONVB], h * 64 + cg, y);
        const float eb = eb_s;
#pragma unroll
        for (int e = 0; e < 8; ++e) y[e] *= 0.125f;
        u32x4 w; w.x = pk2(y[0], y[1]); w.y = pk2(y[2], y[3]); w.z = pk2(y[4], y[5]); w.w = pk2(y[6], y[7]);
        *(LAS u32x4*)(Qs + s * LQ + cg) = w;
        w.x = pk2(y[0] * eb, y[1] * eb); w.y = pk2(y[2] * eb, y[3] * eb); w.z = pk2(y[4] * eb, y[5] * eb); w.w = pk2(y[6] * eb, y[7] * eb);
        *(LAS u32x4*)(Qp + s * LQ + cg) = w;
    }
    __syncthreads();
    {
        const int mt = wave >> 1;
#pragma unroll
        for (int i = 0; i < 2; ++i) {
            const int nt = (wave & 1) * 2 + i;
            f32x4 acc = {0.f, 0.f, 0.f, 0.f};
#pragma unroll
            for (int ks = 0; ks < 2; ++ks) {
                const bf16x8 av = *(const LAS bf16x8*)(Qs + (mt * 16 + (lane & 15)) * LQ + ks * 32 + 8 * (lane >> 4));
                const bf16x8 bv = *(const LAS bf16x8*)(Ks + (nt * 16 + (lane & 15)) * LQ + ks * 32 + 8 * (lane >> 4));
                acc = mfma16(av, bv, acc);
            }
            const int s = nt * 16 + (lane & 15);
            const float bs = bS[s], is = iS[s];
#pragma unroll
            for (int r = 0; r < 4; ++r) {
                const int t = mt * 16 + (lane >> 4) * 4 + r;
                const float p = (s <= t) ? acc[r] * __expf(bS[t] - bs + is) : 0.f;
                Ps[t * LQ + s] = f2bf(p);
            }
        }
    }
    __syncthreads();
    const int mt = wave & 3, ng = wave >> 2;
    f32x4 acc[5];
#pragma unroll
    for (int i = 0; i < 5; ++i) acc[i] = (f32x4){0.f, 0.f, 0.f, 0.f};
#pragma unroll
    for (int ks = 0; ks < 4; ++ks) {
        const LAS bf16_t* Ab = (ks < 2) ? Ps : Qp; const LAS bf16_t* Bb = (ks < 2) ? VT : Cs;
        const int ko = (ks & 1) * 32 + 8 * (lane >> 4);
        const bf16x8 av = *(const LAS bf16x8*)(Ab + (mt * 16 + (lane & 15)) * LQ + ko);
#pragma unroll
        for (int i = 0; i < 4; ++i) {
            const bf16x8 bv = *(const LAS bf16x8*)(Bb + ((ng * 4 + i) * 16 + (lane & 15)) * LQ + ko);
            acc[i] = mfma16(av, bv, acc[i]);
        }
        {
            const bf16x8 bv = *(const LAS bf16x8*)(Bb + (128 + (lane & 15)) * LQ + ko);
            acc[4] = mfma16(av, bv, acc[4]);
        }
    }
    float rinv[4];
#pragma unroll
    for (int r = 0; r < 4; ++r) {
        const float den = __uint_as_float((unsigned)__builtin_amdgcn_ds_bpermute((lane & 48) * 4, (int)__float_as_uint(acc[4][r])));
        rinv[r] = 1.f / fmaxf(fabsf(den), 1.f);
        float ss = 0.f;
#pragma unroll
        for (int i = 0; i < 4; ++i) { acc[i][r] *= rinv[r]; ss += acc[i][r] * acc[i][r]; }
        ss = row16_sum_f32(ss);
        if ((lane & 15) == 0) ssqS[ng * 64 + mt * 16 + (lane >> 4) * 4 + r] = ss;
    }
    __syncthreads();
    bf16_t* mix = (bf16_t*)(a.ws + WS_C);
    const float* gmh = a.in[I_GMHEAD];
#pragma unroll
    for (int r = 0; r < 4; ++r) {
        const int t = mt * 16 + (lane >> 4) * 4 + r;
        const float rn = rsqrtf((ssqS[t] + ssqS[64 + t]) * (1.f / 128.f) + EPS);
#pragma unroll
        for (int i = 0; i < 4; ++i) {
            const int v = (ng * 4 + i) * 16 + (lane & 15);
            const float mo = bf2f(mo_pre[r][i]);
            mix[(size_t)(row0 + t) * D + h * 128 + v] = f2bf(acc[i][r] * rn * gmh[h * 128 + v] * sigmoidf_(mo));
        }
    }
    __syncthreads();
}

constexpr int LV = 264;
__device__ __forceinline__ void swa_task(const Args& a, LAS unsigned char* lds, int task) {
    const int tid = threadIdx.x, lane = tid & 63, wave = tid >> 6;
    const int b = task >> 7, kvh = (task >> 6) & 1, blk = task & 63, qh = kvh * 4 + (wave >> 1);
    const int rowq0 = b * SEQ + blk * 128;
    const bf16_t* proj = (const bf16_t*)(a.ws + WS_A);
    LAS bf16_t* Ksm = (LAS bf16_t*)lds;
    LAS bf16_t* VTs = Ksm + 256 * LQ;
    {
        const int j = tid >> 1, half = tid & 1;
        const bool ex = (blk > 0) || (j >= 128);
        u32x4 kv[4], vv[4];
#pragma unroll
        for (int i = 0; i < 4; ++i) { kv[i] = (u32x4){0u, 0u, 0u, 0u}; vv[i] = (u32x4){0u, 0u, 0u, 0u}; }
        if (ex) {
            const bf16_t* kp = proj + (size_t)(rowq0 - 128 + j) * NPROJ + C_AK + kvh * 64 + half * 32;
            const bf16_t* vp = proj + (size_t)(rowq0 - 128 + j) * NPROJ + C_AV + kvh * 64 + half * 32;
#pragma unroll
            for (int i = 0; i < 4; ++i) { kv[i] = *(const u32x4*)(kp + 8 * i); vv[i] = *(const u32x4*)(vp + 8 * i); }
        }
#pragma unroll
        for (int i = 0; i < 4; ++i) {
            *(LAS u32x4*)(Ksm + j * LQ + half * 32 + 8 * i) = kv[i];
            const unsigned xs[4] = {vv[i].x, vv[i].y, vv[i].z, vv[i].w};
#pragma unroll
            for (int e = 0; e < 4; ++e) { VTs[(half * 32 + 8 * i + 2 * e) * LV + j] = (bf16_t)(xs[e] & 0xffffu); VTs[(half * 32 + 8 * i + 2 * e + 1) * LV + j] = (bf16_t)(xs[e] >> 16); }
        }
    }
    __syncthreads();
#pragma unroll 1
    for (int qk = 0; qk < 4; ++qk) {
    const int qtile = (wave & 1) * 4 + qk;
    const int qi = 16 * qtile + (lane & 15);
    bf16x8 qf[2];
#pragma unroll
    for (int ks = 0; ks < 2; ++ks) qf[ks] = *(const bf16x8*)(proj + (size_t)(rowq0 + qi) * NPROJ + C_AQ + qh * 64 + ks * 32 + 8 * (lane >> 4));
    f32x4 sc[10];
    const float sink = a.in[I_SINKS][qh];
    float mx = sink;
#pragma unroll
    for (int t = 0; t < 9; ++t) {
        const int kt = qtile + t;
        f32x4 acc = {0.f, 0.f, 0.f, 0.f};
#pragma unroll
        for (int ks = 0; ks < 2; ++ks) {
            const bf16x8 kf = *(const LAS bf16x8*)(Ksm + (kt * 16 + (lane & 15)) * LQ + ks * 32 + 8 * (lane >> 4));
            acc = mfma16(kf, qf[ks], acc);
        }
#pragma unroll
        for (int r = 0; r < 4; ++r) {
            const int j = kt * 16 + (lane >> 4) * 4 + r;
            const bool valid = (j >= qi + 1) && (j <= qi + 128) && (blk > 0 || j >= 128);
            acc[r] = valid ? acc[r] * 0.125f : -INFINITY;
            mx = fmaxf(mx, acc[r]);
        }
        sc[t] = acc;
    }
    mx = fmaxf(mx, __shfl_xor(mx, 16)); mx = fmaxf(mx, __shfl_xor(mx, 32));
    float sum = 0.f;
#pragma unroll
    for (int t = 0; t < 9; ++t)
#pragma unroll
        for (int r = 0; r < 4; ++r) { const float p = __expf(sc[t][r] - mx); sc[t][r] = p; sum += p; }
    sum += __shfl_xor(sum, 16); sum += __shfl_xor(sum, 32);
    const float inv = 1.f / (sum + __expf(sink - mx));
    sc[9] = (f32x4){0.f, 0.f, 0.f, 0.f};
    bf16x8 pf[5];
#pragma unroll
    for (int p = 0; p < 5; ++p) {
        const f32x4 x0 = sc[2 * p] * inv, x1 = sc[2 * p + 1] * inv;
        u32x4 w; w.x = pk2(x0[0], x0[1]); w.y = pk2(x0[2], x0[3]); w.z = pk2(x1[0], x1[1]); w.w = pk2(x1[2], x1[3]);
        pf[p] = __builtin_bit_cast(bf16x8, w);
    }
    bf16_t* mix = (bf16_t*)(a.ws + WS_C);
#pragma unroll
    for (int dt = 0; dt < 4; ++dt) {
        f32x4 acc = {0.f, 0.f, 0.f, 0.f};
#pragma unroll
        for (int p = 0; p < 5; ++p) {
            const int k0 = qtile + 2 * p, k1 = (k0 + 1 > 15) ? 15 : k0 + 1;
            const LAS bf16_t* vr = VTs + (dt * 16 + (lane & 15)) * LV + 4 * (lane >> 4);
            const u32x2 lo = *(const LAS u32x2*)(vr + k0 * 16), hi = *(const LAS u32x2*)(vr + k1 * 16);
            const u32x4 w = {lo.x, lo.y, hi.x, hi.y};
            acc = mfma16(__builtin_bit_cast(bf16x8, w), pf[p], acc);
        }
        u32x2 o; o.x = pk2(acc[0], acc[1]); o.y = pk2(acc[2], acc[3]);
        *(u32x2*)(mix + (size_t)(rowq0 + qi) * D + 512 + qh * 64 + dt * 16 + 4 * (lane >> 4)) = o;
    }
    }
    __syncthreads();
}


#ifndef PEER_HQ_LO
#define PEER_HQ_LO 0
#endif
constexpr int LSK = 136;
__device__ __forceinline__ unsigned f2sort(float f) { const unsigned u = __float_as_uint(f); return u ^ ((unsigned)((int)u >> 31) | 0x80000000u); }
__device__ __forceinline__ float sort2f(unsigned s) { return __uint_as_float((s & 0x80000000u) ? (s ^ 0x80000000u) : ~s); }

#define CE_(i, j) { const unsigned hi_ = key[i][r] > key[j][r] ? key[i][r] : key[j][r], lo_ = key[i][r] > key[j][r] ? key[j][r] : key[i][r]; key[i][r] = hi_; key[j][r] = lo_; }
template <int NT>
__device__ __forceinline__ void top16(unsigned (&key)[NT][4], unsigned (&top)[4], int l15) {
    static_assert(NT == 8, "8 keys per lane");
#pragma unroll
    for (int r = 0; r < 4; ++r) {
        CE_(0, 1) CE_(2, 3) CE_(4, 5) CE_(6, 7)
        CE_(0, 2) CE_(1, 3) CE_(4, 6) CE_(5, 7)
        CE_(1, 2) CE_(5, 6)
        CE_(0, 4) CE_(1, 5) CE_(2, 6) CE_(3, 7)
        CE_(2, 4) CE_(3, 5)
        CE_(1, 2) CE_(3, 4) CE_(5, 6)
        top[r] = 0u;
    }
    for (int it = 0; it < 16; ++it) {
        unsigned m[4];
#pragma unroll
        for (int r = 0; r < 4; ++r) m[r] = key[0][r];
#pragma unroll
        for (int st = 0; st < 4; ++st)
#pragma unroll
            for (int r = 0; r < 4; ++r) { const unsigned y = dppu(m[r], st); m[r] = m[r] > y ? m[r] : y; }
        const bool rec = (l15 == it);
#pragma unroll
        for (int r = 0; r < 4; ++r) {
            top[r] = rec ? m[r] : top[r];
            const bool own = key[0][r] == m[r];
#pragma unroll
            for (int t = 0; t < 7; ++t) key[t][r] = own ? key[t + 1][r] : key[t][r];
            key[7][r] = own ? 0u : key[7][r];
        }
    }
}
#undef CE_
__device__ __forceinline__ float gelu_erf(float x) { return 0.5f * x * (1.f + erff(x * 0.70710678118654752f)); }

__device__ __forceinline__ void peer_hq_row(const Args& a, int row, int lane) {
    {
        const bf16_t* hrow = (const bf16_t*)(a.ws + WS_B) + (size_t)row * D + 16 * lane;
        const u32x4 hb0 = *(const u32x4*)hrow, hb1 = *(const u32x4*)(hrow + 8);
        f32x4 v[4]; float am = 0.f;
        v[0] = (f32x4){bflo(hb0.x), bfhi(hb0.x), bflo(hb0.y), bfhi(hb0.y)}; v[1] = (f32x4){bflo(hb0.z), bfhi(hb0.z), bflo(hb0.w), bfhi(hb0.w)};
        v[2] = (f32x4){bflo(hb1.x), bfhi(hb1.x), bflo(hb1.y), bfhi(hb1.y)}; v[3] = (f32x4){bflo(hb1.z), bfhi(hb1.z), bflo(hb1.w), bfhi(hb1.w)};
#pragma unroll
        for (int j = 0; j < 4; ++j) am = fmaxf(am, fmaxf(fmaxf(fabsf(v[j][0]), fabsf(v[j][1])), fmaxf(fabsf(v[j][2]), fabsf(v[j][3]))));
        am = fmaxf(am, __uint_as_float(dppu(__float_as_uint(am), 0))); am = fmaxf(am, __uint_as_float(dppu(__float_as_uint(am), 1))); am = fmaxf(am, __uint_as_float(dppu(__float_as_uint(am), 2)));
        const float s1 = am > 0.f ? am * (1.f / 127.f) : 1.f, i1 = 1.f / s1, i2 = 254.f * i1;
        u32x4 wh, wl;
#pragma unroll
        for (int j = 0; j < 4; ++j) {
            unsigned ph = 0, pl = 0;
#pragma unroll
            for (int e = 0; e < 4; ++e) {
                const float qh = rintf(v[j][e] * i1);
                const float ql = rintf((v[j][e] - qh * s1) * i2);
                ph |= ((unsigned)((int)qh & 255)) << (8 * e); pl |= ((unsigned)((int)ql & 255)) << (8 * e);
            }
            wh[j] = ph; wl[j] = pl;
        }
        *(u32x4*)(a.ws + WS_HQH + (size_t)row * D + 16 * lane) = wh;
        if (PEER_HQ_LO) *(u32x4*)(a.ws + WS_HQL + (size_t)row * D + 16 * lane) = wl;
        if ((lane & 7) == 0) ((float*)(a.ws + WS_HS))[(size_t)row * 8 + (lane >> 3)] = s1;
    }
}
__device__ __forceinline__ void peer_score_unit(const Args& a, LAS unsigned char* lds, int pm, int hsel) {
    const int tid = threadIdx.x, lane = tid & 63, wave = tid >> 6, l15 = lane & 15, lq = lane >> 4;
    const bf16_t* pq = (const bf16_t*)(a.ws + WS_A);
    LAS u32x2* SEL = (LAS u32x2*)lds;
    const int T0 = pm * 256;
    {
#pragma unroll 1
        for (int hh = 0; hh < 2; ++hh) {
            const int h = hsel, tt = wave + 8 * hh;
            unsigned tc[2][4];
#pragma unroll
            for (int c = 0; c < 2; ++c) {
                unsigned key[8][4];
#pragma unroll
                for (int r = 0; r < 4; ++r) {
                    const u32x4 sv = *(const u32x4*)(pq + (size_t)(T0 + tt * 16 + lq * 4 + r) * 2048 + h * 256 + c * 128 + 8 * l15);
                    const unsigned sw[4] = {sv.x, sv.y, sv.z, sv.w};
#pragma unroll
                    for (int j = 0; j < 4; ++j) {
                        key[2 * j][r] = (f2sort(bflo(sw[j])) & ~127u) | (unsigned)(8 * l15 + 2 * j);
                        key[2 * j + 1][r] = (f2sort(bfhi(sw[j])) & ~127u) | (unsigned)(8 * l15 + 2 * j + 1);
                    }
                }
                top16<8>(key, tc[c], l15);
            }
            const int gb = lane & 48;
            int ci[4], cj[4]; bool ok[4];
            ci[0] = 0; cj[0] = l15; ok[0] = true;
            ci[1] = l15; cj[1] = 0; ok[1] = l15 >= 1;
            ci[2] = l15 < 7 ? 1 : (l15 < 11 ? 2 : (l15 < 14 ? 3 : 4)); cj[2] = l15 < 7 ? l15 + 1 : (l15 < 11 ? l15 - 6 : (l15 < 14 ? l15 - 10 : l15 - 13)); ok[2] = true;
            ci[3] = l15 < 3 ? 5 + l15 : 0; cj[3] = 1; ok[3] = l15 < 3;
            unsigned ck[4][4]; int ce[4][4];
#pragma unroll
            for (int r = 0; r < 4; ++r) {
                const unsigned t1 = tc[0][r], t2 = tc[1][r];
                const float v1 = sort2f(t1 & ~127u), v2 = sort2f(t2 & ~127u);
                const int i1 = (int)(t1 & 127u), i2 = (int)(t2 & 127u);
#pragma unroll
                for (int sl = 0; sl < 4; ++sl) {
                    const float a1 = __uint_as_float((unsigned)__builtin_amdgcn_ds_bpermute((gb + ci[sl]) * 4, (int)__float_as_uint(v1)));
                    const float a2 = __uint_as_float((unsigned)__builtin_amdgcn_ds_bpermute((gb + cj[sl]) * 4, (int)__float_as_uint(v2)));
                    const int e1 = __builtin_amdgcn_ds_bpermute((gb + ci[sl]) * 4, i1);
                    const int e2 = __builtin_amdgcn_ds_bpermute((gb + cj[sl]) * 4, i2);
                    ce[sl][r] = e1 * 128 + e2;
                    ck[sl][r] = ok[sl] ? ((f2sort(a1 + a2) & ~63u) | (unsigned)(l15 * 4 + sl)) : 0u;
                }
#define CE4_(i, j) { const unsigned hi_ = ck[i][r] > ck[j][r] ? ck[i][r] : ck[j][r], lo_ = ck[i][r] > ck[j][r] ? ck[j][r] : ck[i][r]; ck[i][r] = hi_; ck[j][r] = lo_; }
                CE4_(0, 1) CE4_(2, 3) CE4_(0, 2) CE4_(1, 3) CE4_(1, 2)
#undef CE4_
            }
            unsigned topk[4] = {0u, 0u, 0u, 0u};
            for (int it = 0; it < 16; ++it) {
                unsigned m[4];
#pragma unroll
                for (int r = 0; r < 4; ++r) m[r] = ck[0][r];
#pragma unroll
                for (int st = 0; st < 4; ++st)
#pragma unroll
                    for (int r = 0; r < 4; ++r) { const unsigned y = dppu(m[r], st); m[r] = m[r] > y ? m[r] : y; }
                const bool rec = (l15 == it);
#pragma unroll
                for (int r = 0; r < 4; ++r) {
                    topk[r] = rec ? m[r] : topk[r];
                    const bool own = ck[0][r] == m[r];
                    ck[0][r] = own ? ck[1][r] : ck[0][r]; ck[1][r] = own ? ck[2][r] : ck[1][r]; ck[2][r] = own ? ck[3][r] : ck[2][r]; ck[3][r] = own ? 0u : ck[3][r];
                }
            }
#pragma unroll
            for (int r = 0; r < 4; ++r) {
                const int own = (int)((topk[r] >> 2) & 15u), slot = (int)(topk[r] & 3u);
                int eid = 0;
#pragma unroll
                for (int sl = 0; sl < 4; ++sl) { const int t = __builtin_amdgcn_ds_bpermute((gb + own) * 4, ce[sl][r]); eid = (slot == sl) ? t : eid; }
                const float ts = sort2f(topk[r] & ~63u);
                const float tmax = row16_max_f32(ts);
                const float p = __expf(ts - tmax);
                const float g = p / row16_sum_f32(p);
                { u32x2 o; o.x = (unsigned)eid; o.y = __float_as_uint(g); SEL[(tt * 16 + lq * 4 + r) * 16 + l15] = o; }
            }
        }
    }
    __syncthreads();
    {
        unsigned* sele = (unsigned*)(a.ws + WS_SELE); float* selg = (float*)(a.ws + WS_SELG);
        for (int i = tid; i < 256 * 16; i += NTHREADS) { const u32x2 o = SEL[i]; const size_t gi = (size_t)(T0 + (i >> 4)) * 128 + hsel * 16 + (i & 15); sele[gi] = o.x << 7; selg[gi] = __uint_as_float(o.y); }
    }
    const int r0 = T0 + 32 * hsel;
    if (tid < 32) ((float*)(a.ws + WS_R2))[r0 + tid] = row_rscale((const float*)(a.ws + WS_SSQ), r0 + tid);
    for (int tk = 0; tk < 4; ++tk) peer_hq_row(a, r0 + wave * 4 + tk, lane);
    __syncthreads();
}
struct PeerSplit { int p0, pstep, trank, tn; };
__device__ __forceinline__ PeerSplit peer_split() {
    PeerSplit s; const int G = gridDim.x;
    if ((G & 7) == 0) { s.p0 = blockIdx.x & 7; s.pstep = 8; s.trank = blockIdx.x >> 3; s.tn = G >> 3; }
    else { s.p0 = 0; s.pstep = 1; s.trank = blockIdx.x; s.tn = G; }
    return s;
}
__device__ __forceinline__ void peer_down(const Args& a, LAS unsigned char* lds) {
    const int lane = threadIdx.x & 63, wave = threadIdx.x >> 6;
    const PeerSplit sp = peer_split();
    const unsigned* sele = (const unsigned*)(a.ws + WS_SELE);
    const float* hs = (const float*)(a.ws + WS_HS);
    LAS unsigned* stage = (LAS unsigned*)(lds + wave * 512);
    const LAS u32x4* stq = (const LAS u32x4*)(lds + wave * 512 + 64 * (lane >> 3));
    const unsigned loff = 16u * (lane & 7);
    const int t0 = sp.trank * NWAVES + wave, tstep = sp.tn * NWAVES;
    const bool b2 = lane & 4, b1 = lane & 2, b0 = lane & 1;
    for (int p = sp.p0; p < 8; p += sp.pstep) {
        const unsigned char* EDp = a.ws + WS_ED + (size_t)p * (16384 * 128);
        unsigned* part = (unsigned*)(a.ws + WS_PART) + (size_t)p * MTOK * 64 + lane;
        const unsigned char* hqh = a.ws + WS_HQH + 128 * p + loff;
        if (t0 >= MTOK) continue;
        unsigned e0n = sele[(size_t)t0 * 128 + lane], e1n = sele[(size_t)t0 * 128 + 64 + lane];
        stage[lane] = e0n; stage[64 + lane] = e1n;
        u32x4 en[4];
#pragma unroll
        for (int k = 0; k < 4; ++k) en[k] = stq[k];
        u32x4 h0n = *(const u32x4*)(hqh + (size_t)t0 * D); float s1n = hs[(size_t)t0 * 8 + p];
        { const int tc = min(t0 + tstep, MTOK - 1); e0n = sele[(size_t)tc * 128 + lane]; e1n = sele[(size_t)tc * 128 + 64 + lane]; }
        for (int t = t0; t < MTOK; t += tstep) {
            const u32x4 hh = h0n; const float s1 = s1n;
            u32x4 x[16];
#pragma unroll
            for (int i = 0; i < 16; ++i) x[i] = *(const u32x4*)(EDp + (en[i >> 2][i & 3] + loff));
            __builtin_amdgcn_sched_barrier(0);
            stage[lane] = e0n; stage[64 + lane] = e1n;
#pragma unroll
            for (int k = 0; k < 4; ++k) en[k] = stq[k];
            { const int tc = min(t + tstep, MTOK - 1); h0n = *(const u32x4*)(hqh + (size_t)tc * D); s1n = hs[(size_t)tc * 8 + p]; }
            { const int tc = min(t + 2 * tstep, MTOK - 1); e0n = sele[(size_t)tc * 128 + lane]; e1n = sele[(size_t)tc * 128 + 64 + lane]; }
            __builtin_amdgcn_sched_barrier(0);
            int v[16];
#pragma unroll
            for (int i = 0; i < 16; ++i) {
                int ah = 0;
#pragma unroll
                for (int j = 0; j < 4; ++j) ah = __builtin_amdgcn_sdot4((int)x[i][j], (int)hh[j], ah, false);
                v[i] = ah;
            }
            int m[2];
#pragma unroll
            for (int hf = 0; hf < 2; ++hf) {
                int k4[4], k2[2];
#pragma unroll
                for (int j = 0; j < 4; ++j) k4[j] = (b2 ? v[8 * hf + 4 + j] : v[8 * hf + j]) + (int)dppu((unsigned)(b2 ? v[8 * hf + j] : v[8 * hf + 4 + j]), 2);
#pragma unroll
                for (int j = 0; j < 2; ++j) k2[j] = (b1 ? k4[2 + j] : k4[j]) + (int)dppu((unsigned)(b1 ? k4[j] : k4[2 + j]), 1);
                m[hf] = (b0 ? k2[1] : k2[0]) + (int)dppu((unsigned)(b0 ? k2[0] : k2[1]), 0);
            }
            part[(size_t)t * 64] = pk2((float)m[0] * s1, (float)m[1] * s1);
        }
    }
}
__device__ __forceinline__ void peer_coef(const Args& a) {
    const int lane = threadIdx.x & 63, wave = threadIdx.x >> 6;
    const unsigned* sele = (const unsigned*)(a.ws + WS_SELE); const float* selg = (const float*)(a.ws + WS_SELG);
    const unsigned* part = (const unsigned*)(a.ws + WS_PART);
    const float* esc = (const float*)(a.ws + WS_ESC);
    const float* r2g = (const float*)(a.ws + WS_R2);
    unsigned* coefd = (unsigned*)(a.ws + WS_COEF);
    for (int t = blockIdx.x * NWAVES + wave; t < MTOK; t += gridDim.x * NWAVES) {
        const float r2 = r2g[t];
        float c[2], s[2] = {0.f, 0.f};
#pragma unroll
        for (int p = 0; p < 8; ++p) { const unsigned w = part[(size_t)p * MTOK * 64 + (size_t)t * 64 + lane]; s[0] += bflo(w); s[1] += bfhi(w); }
#pragma unroll
        for (int half = 0; half < 2; ++half) {
            const size_t i = (size_t)t * 128 + 16 * (lane >> 3) + 8 * half + (lane & 7);
            const unsigned e = sele[i] >> 7;
            c[half] = selg[i] * gelu_erf(s[half] * r2 * esc[e]) * esc[16384 + e];
        }
        float cm = fmaxf(fabsf(c[0]), fabsf(c[1]));
        cm = row16_max_f32(cm); cm = fmaxf(cm, __shfl_xor(cm, 16)); cm = fmaxf(cm, __shfl_xor(cm, 32));
        const float sc = cm > 0.f ? cm * (1.f / 127.f) : 1.f, inv = 1.f / sc;
        const int sh = 8 * (lane & 3);
        unsigned w0 = ((unsigned)((int)rintf(c[0] * inv) & 255)) << sh, w1 = ((unsigned)((int)rintf(c[1] * inv) & 255)) << sh;
        w0 |= dppu(w0, 0); w0 |= dppu(w0, 1);
        w1 |= dppu(w1, 0); w1 |= dppu(w1, 1);
        if ((lane & 3) == 0) { const int wi = 4 * (lane >> 3) + ((lane >> 2) & 1); coefd[(size_t)t * 32 + wi] = w0; coefd[(size_t)t * 32 + wi + 2] = w1; }
        if (lane == 0) ((float*)(a.ws + WS_CS))[t] = sc;
    }
}
__device__ __forceinline__ void peer_up(const Args& a, LAS unsigned char* lds) {
    const int lane = threadIdx.x & 63, wave = threadIdx.x >> 6;
    const PeerSplit sp = peer_split();
    const unsigned* sele = (const unsigned*)(a.ws + WS_SELE);
    const u32x4* coefd = (const u32x4*)(a.ws + WS_COEF) + (lane >> 3);
    const float* csg = (const float*)(a.ws + WS_CS);
    LAS unsigned* stage = (LAS unsigned*)(lds + wave * 512);
    const LAS u32x4* stq = (const LAS u32x4*)(lds + wave * 512 + 64 * (lane >> 3));
    const unsigned loff = 16u * (lane & 7);
    const int t0 = sp.trank * NWAVES + wave, tstep = sp.tn * NWAVES;
    const bool b3 = lane & 8;
    for (int p = sp.p0; p < 8; p += sp.pstep) {
        const unsigned char* EUp = a.ws + WS_EU + (size_t)p * (16384 * 128);
        const bf16_t* hbase = (const bf16_t*)(a.ws + WS_B) + 128 * p + 16 * (lane & 7) + 2 * (lane >> 3);
        float* h3base = (float*)(a.ws + WS_H3) + 128 * p + 16 * (lane & 7) + 2 * (lane >> 3);
        if (t0 >= MTOK) continue;
        unsigned e0n = sele[(size_t)t0 * 128 + lane], e1n = sele[(size_t)t0 * 128 + 64 + lane];
        stage[lane] = e0n; stage[64 + lane] = e1n;
        u32x4 en[4];
#pragma unroll
        for (int k = 0; k < 4; ++k) en[k] = stq[k];
        u32x4 cdn = coefd[(size_t)t0 * 8]; float csn = csg[t0]; unsigned h2n = *(const unsigned*)(hbase + (size_t)t0 * D);
        { const int tc = min(t0 + tstep, MTOK - 1); e0n = sele[(size_t)tc * 128 + lane]; e1n = sele[(size_t)tc * 128 + 64 + lane]; }
        for (int t = t0; t < MTOK; t += tstep) {
            const u32x4 cd = cdn; const float cs = csn; const f32x2_t h2 = {bflo(h2n), bfhi(h2n)};
            u32x4 x[16];
#pragma unroll
            for (int i = 0; i < 16; ++i) x[i] = *(const u32x4*)(EUp + (en[i >> 2][i & 3] + loff));
            __builtin_amdgcn_sched_barrier(0);
            stage[lane] = e0n; stage[64 + lane] = e1n;
#pragma unroll
            for (int k = 0; k < 4; ++k) en[k] = stq[k];
            { const int tc = min(t + tstep, MTOK - 1); cdn = coefd[(size_t)tc * 8]; csn = csg[tc]; h2n = *(const unsigned*)(hbase + (size_t)tc * D); }
            { const int tc = min(t + 2 * tstep, MTOK - 1); e0n = sele[(size_t)tc * 128 + lane]; e1n = sele[(size_t)tc * 128 + 64 + lane]; }
            __builtin_amdgcn_sched_barrier(0);
            int acc[16];
#pragma unroll
            for (int j = 0; j < 16; ++j) acc[j] = 0;
#pragma unroll
            for (int g = 0; g < 4; ++g) {
                const int cw = (int)cd[g];
#pragma unroll
                for (int j = 0; j < 4; ++j) {
                    const unsigned xa = x[4 * g][j], xb = x[4 * g + 1][j], xc = x[4 * g + 2][j], xd = x[4 * g + 3][j];
                    const unsigned t0_ = __builtin_amdgcn_perm(xb, xa, 0x05010400u), t1_ = __builtin_amdgcn_perm(xb, xa, 0x07030602u);
                    const unsigned t2_ = __builtin_amdgcn_perm(xd, xc, 0x05010400u), t3_ = __builtin_amdgcn_perm(xd, xc, 0x07030602u);
                    const unsigned o0 = __builtin_amdgcn_perm(t2_, t0_, 0x05040100u), o1 = __builtin_amdgcn_perm(t2_, t0_, 0x07060302u);
                    const unsigned o2 = __builtin_amdgcn_perm(t3_, t1_, 0x05040100u), o3 = __builtin_amdgcn_perm(t3_, t1_, 0x07060302u);
                    acc[4 * j + 0] = __builtin_amdgcn_sdot4((int)o0, cw, acc[4 * j + 0], false);
                    acc[4 * j + 1] = __builtin_amdgcn_sdot4((int)o1, cw, acc[4 * j + 1], false);
                    acc[4 * j + 2] = __builtin_amdgcn_sdot4((int)o2, cw, acc[4 * j + 2], false);
                    acc[4 * j + 3] = __builtin_amdgcn_sdot4((int)o3, cw, acc[4 * j + 3], false);
                }
            }
            int k8[8], k4[4], k2[2];
#pragma unroll
            for (int j = 0; j < 8; ++j) { const auto r = __builtin_amdgcn_permlane32_swap((unsigned)acc[j], (unsigned)acc[8 + j], false, false); k8[j] = (int)(r[0] + r[1]); }
#pragma unroll
            for (int j = 0; j < 4; ++j) { const auto r = __builtin_amdgcn_permlane16_swap((unsigned)k8[j], (unsigned)k8[4 + j], false, false); k4[j] = (int)(r[0] + r[1]); }
#pragma unroll
            for (int j = 0; j < 2; ++j) k2[j] = (b3 ? k4[2 + j] : k4[j]) + __builtin_amdgcn_update_dpp(0, b3 ? k4[j] : k4[2 + j], 0x128, 0xF, 0xF, true);
            const f32x2_t h3 = h2 + (f32x2_t){(float)k2[0] * cs, (float)k2[1] * cs};
            *(f32x2_t*)(h3base + (size_t)t * D) = h3;
        }
    }
}
__device__ __forceinline__ void peer_final(const Args& a) {
    const int lane = threadIdx.x & 63, wave = threadIdx.x >> 6;
    const float* gf = a.in[I_GFINAL];
    for (int t = blockIdx.x * NWAVES + wave; t < MTOK; t += gridDim.x * NWAVES) {
        const float* hrow = (const float*)(a.ws + WS_H3) + (size_t)t * D + 4 * lane;
        float* orow = a.out + (size_t)t * D + 4 * lane;
        f32x4 v[4]; float s = 0.f;
#pragma unroll
        for (int j = 0; j < 4; ++j) { v[j] = *(const f32x4*)(hrow + 256 * j); s += v[j][0] * v[j][0] + v[j][1] * v[j][1] + v[j][2] * v[j][2] + v[j][3] * v[j][3]; }
        const float r3 = rsqrtf(wave_sum(s) * (1.f / D) + EPS);
#pragma unroll
        for (int j = 0; j < 4; ++j) *(f32x4*)(orow + 256 * j) = v[j] * r3 * *(const f32x4*)(gf + 4 * lane + 256 * j);
    }
}
__device__ __forceinline__ void peer_fold_task(const Args& a, int task) {
    const int lane = threadIdx.x & 63, wave = threadIdx.x >> 6, l15 = lane & 15, lq = lane >> 4;
    const int hc = task >> 2, c = hc & 1, k0 = (task & 3) * 256 + wave * 32;
    const bf16_t* wgr = (const bf16_t*)(a.ws + WS_WGR);
    const bf16_t* sk = (const bf16_t*)(a.ws + WS_SK) + (size_t)c * 128 * 128;
    bf16_t* btp = (bf16_t*)(a.ws + WS_WPQ);
    f32x4 acc[2][8];
#pragma unroll
    for (int mt = 0; mt < 2; ++mt)
#pragma unroll
        for (int nt = 0; nt < 8; ++nt) acc[mt][nt] = (f32x4){0.f, 0.f, 0.f, 0.f};
#pragma unroll
    for (int ks = 0; ks < 4; ++ks) {
        bf16x8 af[2];
#pragma unroll
        for (int mt = 0; mt < 2; ++mt) af[mt] = *(const bf16x8*)(wgr + (size_t)(k0 + mt * 16 + l15) * 2048 + hc * 128 + ks * 32 + 8 * lq);
#pragma unroll
        for (int nt = 0; nt < 8; ++nt) {
            const bf16x8 bv = *(const bf16x8*)(sk + (size_t)(nt * 16 + l15) * 128 + ks * 32 + 8 * lq);
#pragma unroll
            for (int mt = 0; mt < 2; ++mt) acc[mt][nt] = mfma16(af[mt], bv, acc[mt][nt]);
        }
    }
#pragma unroll
    for (int mt = 0; mt < 2; ++mt)
#pragma unroll
        for (int nt = 0; nt < 8; ++nt) {
            u32x2 o; o.x = pk2(acc[mt][nt][0], acc[mt][nt][1]); o.y = pk2(acc[mt][nt][2], acc[mt][nt][3]);
            *(u32x2*)(btp + (size_t)(hc * 128 + nt * 16 + l15) * 1024 + k0 + mt * 16 + 4 * lq) = o;
        }
}

#define XB_TMO      128
#define XB_XCNT(j)  (256  + 64 * (j))
#define XB_XSUB(j)  (1280 + 64 * (j))
#define XB_XGEN(j)  (2304 + 64 * (j))
#define XB_TOP      3328
#define XB_TOPGEN   3392
#define XCD_BAR_WORDS 3456
#define XB_SPIN_CAP (1u << 22)
__device__ __forceinline__ unsigned xb_ld(unsigned* p)              { return __hip_atomic_load(p, __ATOMIC_RELAXED, __HIP_MEMORY_SCOPE_AGENT); }
__device__ __forceinline__ unsigned xb_add(unsigned* p, unsigned v) { return __hip_atomic_fetch_add(p, v, __ATOMIC_RELAXED, __HIP_MEMORY_SCOPE_AGENT); }
__device__ __forceinline__ unsigned xb_xcc_id() { return (unsigned)__builtin_amdgcn_s_getreg((3 << 11) | 20) & 0xFu; }
#define XB_SPIN(cond, bar) do { unsigned _sp = 0; while (cond) { __builtin_amdgcn_s_sleep(1); \
    if ((++_sp & 255u) == 0u) { if (xb_ld(&(bar)[XB_TMO])) break; if (_sp > XB_SPIN_CAP) { atomicAdd(&(bar)[XB_TMO], 1u); break; } } } } while (0)
struct XcdBarrier { unsigned* bar; unsigned x; volatile LAS unsigned* st; };
__device__ __forceinline__ XcdBarrier xcd_barrier_post(unsigned* bar, volatile LAS unsigned* st) {
    XcdBarrier b; b.bar = bar; b.x = xb_xcc_id(); b.st = st;
    if (threadIdx.x == 0) (void)xb_add(&bar[XB_XCNT(b.x)], 1u);
    return b;
}
__device__ __forceinline__ void xcd_barrier_complete(unsigned* bar, unsigned x, unsigned& nloc, unsigned& nx) {
    const unsigned G = gridDim.x * gridDim.y * gridDim.z;
    unsigned sum, cnt, mine, sp = 0u;
    for (;;) {
        sum = 0u; cnt = 0u; mine = 0u;
#pragma unroll
        for (unsigned j = 0; j < 16; ++j) { const unsigned c = xb_ld(&bar[XB_XCNT(j)]); sum += c; cnt += (c > 0u) ? 1u : 0u; mine = (j == x) ? c : mine; }
        if (sum == G) break;
        __builtin_amdgcn_s_sleep(1);
        if ((++sp & 255u) == 0u) { if (xb_ld(&bar[XB_TMO])) break; if (sp > XB_SPIN_CAP) { atomicAdd(&bar[XB_TMO], 1u); break; } }
    }
    nloc = mine > 0u ? mine : 1u; nx = cnt > 0u ? cnt : 1u;
}
__device__ __forceinline__ void xcd_barrier(const XcdBarrier& b) {
    asm volatile("s_waitcnt vmcnt(0)" ::: "memory");
    __syncthreads();
    if (threadIdx.x == 0) {
        unsigned* bar = b.bar;
        __builtin_amdgcn_s_waitcnt(0);
        unsigned nloc = b.st[0], nx = b.st[1];
        if (nloc == 0u) { xcd_barrier_complete(bar, b.x, nloc, nx); b.st[0] = nloc; b.st[1] = nx; }
        const unsigned old = xb_add(&bar[XB_XSUB(b.x)], 1u);
        const unsigned gen = old / nloc;
        if (old + 1u == (gen + 1u) * nloc) {
            __builtin_amdgcn_fence(__ATOMIC_RELEASE, "agent");
            asm volatile("s_waitcnt vmcnt(0)" ::: "memory");
            const unsigned og = xb_add(&bar[XB_TOP], 1u);
            const unsigned tg = og / nx;
            if (og + 1u == (tg + 1u) * nx) xb_add(&bar[XB_TOPGEN], 1u);
            else XB_SPIN(xb_ld(&bar[XB_TOPGEN]) == tg, bar);
            __builtin_amdgcn_fence(__ATOMIC_ACQUIRE, "agent");
            xb_add(&bar[XB_XGEN(b.x)], 1u);
            asm volatile("s_waitcnt vmcnt(0)" ::: "memory");
        } else {
            XB_SPIN(xb_ld(&bar[XB_XGEN(b.x)]) == gen, bar);
            __builtin_amdgcn_fence(__ATOMIC_ACQUIRE, "agent");
            asm volatile("s_waitcnt vmcnt(0)" ::: "memory");
        }
    }
    __syncthreads();
}


#ifndef FUSE_SCORE
#define FUSE_SCORE 1
#endif
constexpr int NPHASES = 15;
__global__ __launch_bounds__(NTHREADS, 2) void hybrid_fwd(Args a) {
    extern __shared__ __attribute__((aligned(16))) unsigned char smem[];
    LAS unsigned char* lds = (LAS unsigned char*)smem;
    volatile LAS unsigned* xbw = (volatile LAS unsigned*)(lds + LDS_BYTES - 16);
    unsigned char* ws = a.ws;
    const int G = gridDim.x;
    if (threadIdx.x == 0) { xbw[0] = 0u; xbw[1] = 0u; xbw[2] = 0u; xbw[3] = 0u; }
    __syncthreads();
    XcdBarrier xb; xb.bar = (unsigned*)(ws + WS_BAR); xb.x = 0; xb.st = xbw;
    const bool multi = (a.ph_hi - a.ph_lo) > 1;
    if (multi) xb = xcd_barrier_post((unsigned*)(ws + WS_BAR), xbw);
#define PHON(n) 1
#define PH_BEGIN(n) if (PHON(n) && a.ph_lo <= (n) && (n) < a.ph_hi) { auto body_ = [&]() __attribute__((always_inline)) {
#define PH_END(n) }; body_(); if ((n) + 1 < a.ph_hi) xcd_barrier(xb); }
    PH_BEGIN(0) phase0(a, lds); PH_END(0)
    PH_BEGIN(1)
        { pg8::Gemm g{(const bf16_t*)(ws + WS_B), (const bf16_t*)(ws + WS_WIN), MTOK, NPROJ, D};
          pg8::StaticOrder S; S.init(g.M, g.N, G, blockIdx.x);
          EpiRowBf16 E{(bf16_t*)(ws + WS_A), NPROJ, nullptr, 1.0f};
          pg8::gemm_phase<EpiRowBf16, pg8::StaticOrder, false>(lds, g, S, E, nullptr); }
        { pg8::Gemm g{(const bf16_t*)(ws + WS_C), (const bf16_t*)(ws + WS_WXKV), NB * MEMLEN, 2048, D};
          pg8::StaticOrder S; S.init(g.M, g.N, G, (blockIdx.x + G - (64 % G)) % G);
          EpiKV E{(bf16_t*)(ws + WS_KMEM), (bf16_t*)(ws + WS_VTMEM)};
          pg8::gemm_phase<EpiKV, pg8::StaticOrder, false>(lds, g, S, E, nullptr); }
        { const int lo = (G > 160) ? 80 : 0;
          if ((int)blockIdx.x >= lo) p0_experts(a, blockIdx.x - lo, G - lo); }
    PH_END(1)
    PH_BEGIN(2) for (int t = blockIdx.x; t < 1280; t += G) { if (t < 1024) mlstm_local(a, lds, t); else swa_task(a, lds, t - 1024); } PH_END(2)
    PH_BEGIN(3) p0_late_transposes(a, lds); mlstm_scan(a); PH_END(3)
    PH_BEGIN(4)
        {
            for (int fu = blockIdx.x; fu < 128; fu += G) {
                if (fu < 64) {
                    const int j = fu >> 2, bh = j & 7, b = bh >> 2, h = bh & 3;
                    const bf16_t* Kh = (const bf16_t*)(ws + WS_KMEM) + (size_t)bh * 65536; const bf16_t* Vh = (const bf16_t*)(ws + WS_VTMEM) + (size_t)bh * 65536;
                    const bf16_t* WqR = (const bf16_t*)(ws + WS_WXQ) + (size_t)h * 1024 * 256; const bf16_t* WoR = (const bf16_t*)(ws + WS_WXO) + (size_t)h * 1024 * 256;
                    pg8::Gemm g{}; EpiRowBf16 E{nullptr, 1024, nullptr, 1.0f};
                    if (j < 8) { g.A = Kh; g.Bt = WqR; g.M = 256; g.N = 1024; g.K = 256; E.O = (bf16_t*)(ws + WS_WXKV) + ((size_t)b * 1024 + h * 256) * 1024; }
                    else { g.A = WoR; g.Bt = Vh; g.M = 1024; g.N = 256; g.K = 256; E.O = (bf16_t*)(ws + WS_BTO) + (size_t)b * 1024 * 1024 + h * 256; }
                    pg8::StaticOrder S; S.init(g.M, g.N, 4, fu & 3);
                    pg8::gemm_phase<EpiRowBf16, pg8::StaticOrder, false>(lds, g, S, E, nullptr);
                } else peer_fold_task(a, fu - 64);
                __syncthreads();
            }
            __syncthreads();
        }
        for (int t = blockIdx.x; t < 1024; t += G) mlstm_out(a, lds, t);
    PH_END(4)
    PH_BEGIN(5) { pg8::Gemm g{(const bf16_t*)(ws + WS_C), (const bf16_t*)(ws + WS_WOUT), MTOK, D, D};
          pg8::StaticOrder S; S.init(g.M, g.N, G, blockIdx.x);
          EpiResid<false> E{a.in[I_X], (bf16_t*)(ws + WS_B), (float*)(ws + WS_SSQ)};
          pg8::gemm_phase<EpiResid<false>, pg8::StaticOrder, false>(lds, g, S, E, nullptr); } PH_END(5)
    PH_BEGIN(6) { pg8::Gemm g{(const bf16_t*)(ws + WS_B), (const bf16_t*)(ws + WS_WXKV), MTOK, D, D, 32, (size_t)1024 * 1024 * 2};
          EpiSoftmax E{(bf16_t*)(ws + WS_A), (const float*)(ws + WS_SSQ)};
          for (int L = blockIdx.x; L < (MTOK / 256) * (D / 256); L += G) {
              pg8::StaticOrder S; S.init(g.M, g.N, (MTOK / 256) * (D / 256), L);
              pg8::gemm_phase<EpiSoftmax, pg8::StaticOrder, false>(lds, g, S, E, nullptr);
          } } PH_END(6)
    PH_BEGIN(8) { pg8::Gemm g{(const bf16_t*)(ws + WS_A), (const bf16_t*)(ws + WS_BTO), MTOK, D, D, 32, (size_t)1024 * 1024 * 2};
          pg8::StaticOrder S; S.init(g.M, g.N, G, blockIdx.x);
          EpiResid<true> E{(const void*)(ws + WS_B), (bf16_t*)(ws + WS_B), (float*)(ws + WS_SSQ)};
          pg8::gemm_phase<EpiResid<true>, pg8::StaticOrder, false>(lds, g, S, E, nullptr); } PH_END(8)
    PH_BEGIN(9) { pg8::Gemm g{(const bf16_t*)(ws + WS_B), (const bf16_t*)(ws + WS_WPQ), MTOK, 2048, D};
          pg8::StaticOrder S; S.init(g.M, g.N, G, blockIdx.x);
          EpiRowBf16 E{(bf16_t*)(ws + WS_A), 2048, (const float*)(ws + WS_SSQ), 1.0f};
          pg8::gemm_phase<EpiRowBf16, pg8::StaticOrder, false>(lds, g, S, E, nullptr);
#if FUSE_SCORE
          asm volatile("s_waitcnt vmcnt(0)" ::: "memory"); __syncthreads();
          pg8::Unit u;
          for (int i = 0; S.next(i, u); ++i) peer_score_unit(a, lds, u.pm, u.pn);
#endif
          } PH_END(9)

    PH_BEGIN(11) peer_down(a, lds); PH_END(11)
    PH_BEGIN(12) peer_coef(a); PH_END(12)
    PH_BEGIN(13) peer_up(a, lds); PH_END(13)
    PH_BEGIN(14) peer_final(a); PH_END(14)
}

#ifndef MK_ONE_LAUNCH
#define MK_ONE_LAUNCH 1
#endif
extern "C" void kernel_launch(void* const* d_in, const int* in_sizes, int n_in, void* d_out, int out_size, void* d_ws, size_t ws_size, hipStream_t stream) {
    static int grid = 0;
    if (grid == 0) {
        if (n_in != 24 || out_size != MTOK * D || ws_size < WS_END) { fprintf(stderr, "kernel_launch: unexpected shapes (n_in %d out %d ws %zu)\n", n_in, out_size, ws_size); grid = -1; return; }
        int dev = 0, cus = 0;
        if (hipGetDevice(&dev) != hipSuccess || hipDeviceGetAttribute(&cus, hipDeviceAttributeMultiprocessorCount, dev) != hipSuccess) { grid = -1; return; }
        if (hipFuncSetAttribute((const void*)hybrid_fwd, hipFuncAttributeMaxDynamicSharedMemorySize, LDS_BYTES) != hipSuccess) { fprintf(stderr, "kernel_launch: hipFuncSetAttribute failed\n"); grid = -1; return; }
        int per_cu = 0;
        if (hipOccupancyMaxActiveBlocksPerMultiprocessor(&per_cu, (const void*)hybrid_fwd, NTHREADS, LDS_BYTES) != hipSuccess || per_cu < 1) { fprintf(stderr, "kernel_launch: occupancy query says %d\n", per_cu); }
        (void)hipGetLastError();
        grid = cus;
    }
    if (grid < 0) return;
    (void)hipMemsetAsync((char*)d_ws + WS_BAR, 0, XCD_BAR_WORDS * 4, stream);
    Args a{};
    for (int i = 0; i < 24; ++i) a.in[i] = (const float*)d_in[i];
    a.out = (float*)d_out; a.ws = (unsigned char*)d_ws;
#if MK_ONE_LAUNCH
    a.ph_lo = 0; a.ph_hi = NPHASES;
    hipLaunchKernelGGL(hybrid_fwd, dim3(grid), dim3(NTHREADS), LDS_BYTES, stream, a);
#else
    for (int ph = 0; ph < NPHASES; ++ph) {
        a.ph_lo = ph; a.ph_hi = ph + 1;
        hipLaunchKernelGGL(hybrid_fwd, dim3(grid), dim3(NTHREADS), LDS_BYTES, stream, a);
    }
#endif
}
```

```cpp
#include <hip/hip_runtime.h>
#include <cstdio>
#include <cstdint>
namespace pg8 {
#define PG8_LAS __attribute__((address_space(3)))
typedef unsigned short bf16_t;
typedef short bf16x8 __attribute__((ext_vector_type(8)));
typedef float f32x4 __attribute__((ext_vector_type(4)));
typedef unsigned u32x4 __attribute__((ext_vector_type(4)));
constexpr int BM = 256, BK = 64, HALF = 128, HTB = HALF * BK * 2  , STAGE_BYTES = 8 * HTB, NXCD = 8, WGM = 8;

__host__ __device__ __forceinline__ int lds_byte(int r, int c) { const int st = (r >> 4) * 2 + (c >> 5), rr = r & 15, cc = c & 31, ob = rr * 64 + cc * 2; return st * 1024 + (ob ^ (((ob >> 9) & 1) << 5)); }
__host__ __device__ __forceinline__ void stage_rc(int b, int& R, int& C) { const int st = b / 1024, sb = b % 1024, swz = sb ^ (((sb >> 9) & 1) << 5); R = (st >> 1) * 16 + swz / 64; C = (st & 1) * 32 + (swz % 64) / 2; }
__host__ __device__ __forceinline__ int perm32(int rho) { const int n = rho >> 4, i = rho & 15; return 8 * (i >> 2) + 4 * n + (i & 3); }

struct Unit { int pm, pn; };
struct Gemm { const bf16_t* A; const bf16_t* Bt; int M, N, K; int pm_split; size_t bt_split_bytes; };

struct StaticOrder {
    int nM, nN, nwg, G, c;
    __host__ __device__ void init(int M, int N, int G_, int c_) { nM = M / BM; nN = N / BM; nwg = nM * nN; G = G_; c = c_; }
    __host__ __device__ bool next(int i, Unit& u) const {
        const long L = (long)i * G + c; if (L >= nwg) return false;
        int wgid = (int)L; { const int q = nwg / NXCD, r = nwg % NXCD, xcd = wgid % NXCD, off = wgid / NXCD; wgid = (xcd < r ? xcd * (q + 1) : r * (q + 1) + (xcd - r) * q) + off; }
        const int nig = WGM * nN, gid = wgid / nig, fm = gid * WGM, gsz = (nM - fm) < WGM ? (nM - fm) : WGM;
        u.pm = fm + ((wgid % nig) % gsz); u.pn = (wgid % nig) / gsz; return true;
    }
    __device__ __forceinline__ void a_ready(const Unit&) const {}
    __device__ __forceinline__ void done(const Unit&) const {}
};
__device__ __forceinline__ unsigned cvt_pk_bf16(float lo, float hi) { unsigned r; asm volatile("v_cvt_pk_bf16_f32 %0, %1, %2" : "=v"(r) : "v"(lo), "v"(hi)); return r; }
typedef float f32x2 __attribute__((ext_vector_type(2)));
__device__ __forceinline__ f32x2 gelu_pk(f32x2 v) {
    const f32x2 av = __builtin_elementwise_abs(v), d = av * 0.2316418882f + 1.0f;
    f32x2 t; t.x = __builtin_amdgcn_rcpf(d.x); t.y = __builtin_amdgcn_rcpf(d.y);
    f32x2 q = t * 0.5307027145f + (-0.7265760135f); q = q * t + 0.7107068705f; q = q * t + (-0.142248368f); q = q * t + 0.127414796f; q = q * t;
    const f32x2 s = (v * v) * (-0.72134752044f);
    f32x2 e; e.x = __builtin_amdgcn_exp2f(s.x); e.y = __builtin_amdgcn_exp2f(s.y);
    const f32x2 m = v * (q * e), r = v - m;
    f32x2 o; o.x = v.x < 0.f ? m.x : r.x; o.y = v.y < 0.f ? m.y : r.y; return o;
}

template <bool I8> __device__ __forceinline__ f32x4 mma_frag(bf16x8 b, bf16x8 a, f32x4 c) {
    if constexpr (I8) {
        typedef int v4i_t __attribute__((ext_vector_type(4)));
        return __builtin_bit_cast(f32x4, __builtin_amdgcn_mfma_i32_16x16x64_i8(__builtin_bit_cast(v4i_t, b), __builtin_bit_cast(v4i_t, a), __builtin_bit_cast(v4i_t, c), 0, 0, 0));
    } else return __builtin_amdgcn_mfma_f32_16x16x32_bf16(b, a, c, 0, 0, 0);
}
template <class Epi, class Sched, bool STAMP = false, bool I8 = false>
__device__ __forceinline__ void gemm_phase(PG8_LAS unsigned char* lds, const Gemm g, const Sched& S, const Epi& E, unsigned long long* stamps) {
    const int tid = threadIdx.x, wid = __builtin_amdgcn_readfirstlane(tid >> 6), lane = tid & 63, wr = wid >> 2, wc = wid & 3, fr = lane & 15, fq = lane >> 4;
    const int K = g.K, nt = K / BK;
    int ts_lo = 0, ts_hi = 0, nts = 0; const unsigned long long rt_entry = STAMP ? (unsigned long long)wall_clock64() : 0ull;
#define PG8_STAMP() do { if (STAMP && wid == 0 && nts < 64) { const unsigned long long _c = (unsigned long long)clock64(); \
        ts_lo = (lane == nts) ? (int)(unsigned)_c : ts_lo; ts_hi = (lane == nts) ? (int)(unsigned)(_c >> 32) : ts_hi; ++nts; } } while (0)
    PG8_STAMP();
    unsigned voffA[2], voffB[2];
#pragma unroll
    for (int i = 0; i < 2; ++i) { int R, C; stage_rc(tid * 16 + i * 8192, R, C); const int Rb = Epi::PERM ? ((R & ~31) + perm32(R & 31)) : R;
        voffA[i] = (unsigned)(R * K + C) * 2u; voffB[i] = (unsigned)(Rb * K + C) * 2u; }
    const size_t kstep = (size_t)(BK * 2);
    const size_t hstep = (size_t)HALF * K * 2;
    const size_t tstep = 2 * hstep;
    const unsigned ldsw = (unsigned)wid * 1024u;
    const int aoff = lds_byte(wr * 64 + fr, fq * 8), boff = lds_byte(wc * 32 + fr, fq * 8);
#define PG8_SA(b, h) (((b) * 2 + (h)) * HTB)
#define PG8_SB(b, h) ((4 + (b) * 2 + (h)) * HTB)
#define PG8_STAGE(bufoff, gbase, voff) do { _Pragma("unroll") for (int _i = 0; _i < 2; ++_i) \
        __builtin_amdgcn_global_load_lds((const unsigned*)((const char*)(gbase) + (voff)[_i]), (PG8_LAS unsigned*)(lds + (bufoff) + ldsw + _i * 8192), 16, 0, 0); } while (0)
#define PG8_LDA(dst, b, h) do { _Pragma("unroll") for (int m = 0; m < 4; ++m) _Pragma("unroll") for (int k = 0; k < 2; ++k) dst[m][k] = *(const PG8_LAS bf16x8*)(lds + PG8_SA(b, h) + aoff + m * 2048 + k * 1024); } while (0)
#define PG8_LDB(dst, b, h) do { _Pragma("unroll") for (int n = 0; n < 2; ++n) _Pragma("unroll") for (int k = 0; k < 2; ++k) dst[n][k] = *(const PG8_LAS bf16x8*)(lds + PG8_SB(b, h) + boff + n * 2048 + k * 1024); } while (0)
#define PG8_MMA(ai, bj, At, Bt) do { __builtin_amdgcn_s_setprio(1); _Pragma("unroll") for (int m = 0; m < 4; ++m) _Pragma("unroll") for (int n = 0; n < 2; ++n) _Pragma("unroll") for (int k = 0; k < 2; ++k) \
        acc[ai][bj][m][n] = mma_frag<I8>(Bt[n][k], At[m][k], acc[ai][bj][m][n]); __builtin_amdgcn_s_setprio(0); } while (0)
#define PG8_WAIT_V(n) asm volatile("s_waitcnt vmcnt(" #n ")" ::: "memory")
#define PG8_WAIT_L(n) asm volatile("s_waitcnt lgkmcnt(" #n ")" ::: "memory")
#define PG8_BAR __builtin_amdgcn_s_barrier()
#define PG8_SCHED __builtin_amdgcn_sched_barrier(0)
    Unit cur, nxt; int ui = 0;
    if (!S.next(0, cur)) return;
    f32x4 acc[2][2][4][2];
#pragma unroll
    for (int a = 0; a < 2; ++a)
#pragma unroll
        for (int b = 0; b < 2; ++b)
#pragma unroll
            for (int m = 0; m < 4; ++m)
#pragma unroll
                for (int n = 0; n < 2; ++n) acc[a][b][m][n] = (f32x4){0.f, 0.f, 0.f, 0.f};
    bf16x8 At[4][2], B0[2][2], B1[2][2];
    const char* cA = (const char*)g.A + (size_t)cur.pm * tstep; const char* cB = (const char*)g.Bt + (size_t)cur.pn * tstep + ((g.pm_split > 0 && cur.pm >= g.pm_split) ? g.bt_split_bytes : (size_t)0);
    S.a_ready(cur);
    PG8_STAGE(PG8_SB(0, 0), cB, voffB); PG8_STAGE(PG8_SA(0, 0), cA, voffA); PG8_STAGE(PG8_SB(0, 1), cB + hstep, voffB); PG8_STAGE(PG8_SA(0, 1), cA + hstep, voffA);
    if (wr == 1) PG8_BAR;
    PG8_WAIT_V(4); PG8_BAR;
    PG8_STAGE(PG8_SB(1, 0), cB + kstep, voffB); PG8_STAGE(PG8_SA(1, 0), cA + kstep, voffA); PG8_STAGE(PG8_SB(1, 1), cB + hstep + kstep, voffB);
    PG8_WAIT_V(6); PG8_BAR;
    PG8_STAMP();
    for (;;) {
        const bool has_next = S.next(ui + 1, nxt);
        const char* nA = has_next ? (const char*)g.A + (size_t)nxt.pm * tstep : cA; const char* nB = has_next ? (const char*)g.Bt + (size_t)nxt.pn * tstep + ((g.pm_split > 0 && nxt.pm >= g.pm_split) ? g.bt_split_bytes : (size_t)0) : cB;
        for (int t = 0; t < nt; t += 2) {
            const bool last = (t == nt - 2);
            const char* a1 = cA + (size_t)(t + 1) * kstep;
            const char* a2 = last ? nA : cA + (size_t)(t + 2) * kstep; const char* b2 = last ? nB : cB + (size_t)(t + 2) * kstep;
            const char* a3 = a2 + kstep; const char* b3 = b2 + kstep;
            if (last && has_next) S.a_ready(nxt);
            PG8_LDB(B0, 0, 0); PG8_SCHED; PG8_LDA(At, 0, 0); PG8_STAGE(PG8_SA(1, 1), a1 + hstep, voffA);
            PG8_WAIT_L(8); PG8_BAR; PG8_WAIT_L(0); PG8_MMA(0, 0, At, B0); PG8_BAR; PG8_SCHED;
            PG8_LDB(B1, 0, 1); PG8_STAGE(PG8_SB(0, 0), b2, voffB);
            PG8_BAR; PG8_WAIT_L(0); PG8_MMA(0, 1, At, B1); PG8_BAR;
            PG8_LDA(At, 0, 1); PG8_STAGE(PG8_SA(0, 0), a2, voffA);
            PG8_BAR; PG8_WAIT_L(0); PG8_MMA(1, 0, At, B0); PG8_BAR; PG8_SCHED;
            PG8_STAGE(PG8_SB(0, 1), b2 + hstep, voffB);
            PG8_WAIT_V(6); PG8_BAR; PG8_MMA(1, 1, At, B1); PG8_BAR;
            PG8_LDB(B0, 1, 0); PG8_SCHED; PG8_LDA(At, 1, 0); PG8_STAGE(PG8_SA(0, 1), a2 + hstep, voffA);
            PG8_WAIT_L(8); PG8_BAR; PG8_WAIT_L(0); PG8_MMA(0, 0, At, B0); PG8_BAR; PG8_SCHED;
            PG8_LDB(B1, 1, 1); PG8_STAGE(PG8_SB(1, 0), b3, voffB);
            PG8_BAR; PG8_WAIT_L(0); PG8_MMA(0, 1, At, B1); PG8_BAR;
            PG8_LDA(At, 1, 1); PG8_STAGE(PG8_SA(1, 0), a3, voffA);
            PG8_BAR; PG8_WAIT_L(0); PG8_MMA(1, 0, At, B0); PG8_BAR; PG8_SCHED;
            PG8_STAGE(PG8_SB(1, 1), b3 + hstep, voffB);
            PG8_WAIT_V(6); PG8_BAR; PG8_MMA(1, 1, At, B1); PG8_BAR;
        }
        PG8_STAMP();
        if constexpr (!Epi::AFTER_DRAIN) { E(acc, cur, wr, wc, fr, fq); S.done(cur); }
        PG8_STAMP();
        if (!has_next) break;
#pragma unroll
        for (int a = 0; a < 2; ++a)
#pragma unroll
            for (int b = 0; b < 2; ++b)
#pragma unroll
                for (int m = 0; m < 4; ++m)
#pragma unroll
                    for (int n = 0; n < 2; ++n) acc[a][b][m][n] = (f32x4){0.f, 0.f, 0.f, 0.f};
        cur = nxt; cA = nA; cB = nB; ++ui;
    }
    PG8_WAIT_V(0);
    if (wr == 0) PG8_BAR;
    PG8_BAR;
    if constexpr (Epi::AFTER_DRAIN) { E.fused(acc, cur, wr, wc, fr, fq, lds, wid, lane); S.done(cur); }
    PG8_STAMP();
    if (STAMP && wid == 0) { stamps[lane] = lane < nts ? (((unsigned long long)(unsigned)ts_hi << 32) | (unsigned)ts_lo) : 0ull;
        if (lane == 62) stamps[62] = rt_entry; if (lane == 63) stamps[63] = (unsigned long long)wall_clock64(); }
#undef PG8_STAMP
#undef PG8_SA
#undef PG8_SB
#undef PG8_STAGE
#undef PG8_LDA
#undef PG8_LDB
#undef PG8_MMA
#undef PG8_WAIT_V
#undef PG8_WAIT_L
#undef PG8_BAR
#undef PG8_SCHED
}
}

#define LAS __attribute__((address_space(3)))
typedef unsigned short bf16_t;
typedef short bf16x8 __attribute__((ext_vector_type(8)));
typedef short bf16x4 __attribute__((ext_vector_type(4)));
typedef float f32x4 __attribute__((ext_vector_type(4)));
typedef unsigned u32x4 __attribute__((ext_vector_type(4)));
typedef unsigned u32x2 __attribute__((ext_vector_type(2)));

constexpr int D = 1024, NB = 2, SEQ = 8192, MTOK = NB * SEQ, MEMLEN = 256;
constexpr int NPROJ = 2304;
constexpr int C_MQ = 0, C_MK = 256, C_MV = 512, C_MO = 1024, C_AQ = 1536, C_AK = 2048, C_AV = 2176;
constexpr float EPS = 1e-6f;
constexpr int NTHREADS = 512, NWAVES = 8;
constexpr int LDS_BYTES = 144 * 1024;

constexpr size_t MiB = (size_t)1 << 20;
constexpr size_t WS_A = 0;
constexpr size_t WS_B = 72 * MiB;
constexpr size_t WS_C = 104 * MiB;
constexpr size_t WS_ED = 136 * MiB;
constexpr size_t WS_EU = 144 * MiB;
constexpr size_t WS_WIN = 200 * MiB;
constexpr size_t WS_WOUT = WS_WIN + 2304 * 1024 * 2;
constexpr size_t WS_WXQ = WS_WOUT + 2 * MiB;
constexpr size_t WS_WXKV = WS_WXQ + 2 * MiB;
constexpr size_t WS_WXO = WS_WXKV + 4 * MiB;
constexpr size_t WS_WPQ = WS_WXO + 2 * MiB;
constexpr size_t WS_G = 219 * MiB;
constexpr size_t WS_GATES = WS_G;
constexpr size_t WS_KMEM = WS_GATES + 512 * 1024;
constexpr size_t WS_VTMEM = WS_KMEM + MiB;
constexpr size_t WS_SSQ = WS_VTMEM + MiB;
constexpr size_t WS_DN = WS_SSQ + MiB;
constexpr size_t WS_DECAY = WS_DN + 256 * 1024;
constexpr size_t WS_SK = WS_DECAY + 4096;
constexpr size_t WS_ESC = WS_SK + 65536;
constexpr size_t WS_SELE = WS_A + 64 * MiB;
constexpr size_t WS_SELG = WS_C;
constexpr size_t WS_COEF = WS_C + 8 * MiB;
constexpr size_t WS_R2 = WS_C + 16 * MiB;
constexpr size_t WS_SSQ3 = WS_C + 17 * MiB;
constexpr size_t WS_PART = WS_A;
constexpr size_t WS_H3 = WS_A + 32 * MiB;
constexpr size_t WS_XB = 168 * MiB;
constexpr size_t WS_RX = WS_C + 20 * MiB;
constexpr size_t WS_ST = 152 * MiB;
constexpr size_t WS_HQH = 168 * MiB;
constexpr size_t WS_HQ8 = 184 * MiB;
constexpr size_t WS_HQL = 184 * MiB;
constexpr size_t WS_HS = WS_C + 18 * MiB;
constexpr size_t WS_CSUM = WS_C + 21 * MiB;
constexpr size_t WS_SA8 = WS_C + 22 * MiB;
constexpr size_t WS_R1 = WS_C + 20 * MiB;
constexpr size_t WS_CS = WS_C + 19 * MiB;
constexpr size_t WS_BAR = 223 * MiB;
constexpr size_t WS_BTO = 224 * MiB;
constexpr size_t WS_BTP8 = 228 * MiB;
constexpr size_t WS_WGR = 228 * MiB;
constexpr size_t WS_END = 232 * MiB;

struct Args {
    const float* in[24];
    float* out;
    unsigned char* ws;
    int ph_lo, ph_hi;
};
enum { I_X = 0, I_MEM, I_GMIX, I_WIN, I_CONVW, I_CONVB, I_BI, I_BF, I_GMHEAD, I_SINKS, I_WOUT, I_GCROSS, I_GMEM, I_WXQ, I_WXK, I_WXV, I_WXO,
       I_GFFN, I_WPQ, I_SK1, I_SK2, I_EDOWN, I_EUP, I_GFINAL };

typedef __bf16 bf16x2_t __attribute__((ext_vector_type(2)));
typedef float f32x2_t __attribute__((ext_vector_type(2)));
__device__ __forceinline__ unsigned pk2(float lo, float hi) { f32x2_t v = {lo, hi}; bf16x2_t b = __builtin_convertvector(v, bf16x2_t); return __builtin_bit_cast(unsigned, b); }
__device__ __forceinline__ bf16_t f2bf(float f) { return (bf16_t)(pk2(f, 0.f) & 0xffffu); }
__device__ __forceinline__ float bf2f(unsigned b) { return __uint_as_float(b << 16); }
__device__ __forceinline__ float bflo(unsigned w) { return __uint_as_float(w << 16); }
__device__ __forceinline__ float bfhi(unsigned w) { return __uint_as_float(w & 0xffff0000u); }
__device__ __forceinline__ float wave_sum(float v) {
#pragma unroll
    for (int o = 1; o < 64; o <<= 1) v += __shfl_xor(v, o);
    return v;
}
__device__ __forceinline__ float sigmoidf_(float x) { return 1.f / (1.f + __expf(-x)); }
#define LDS_FENCE() asm volatile("s_waitcnt lgkmcnt(0)" ::: "memory")

__device__ __forceinline__ unsigned dppu(unsigned x, int ctrl_sel) {
    switch (ctrl_sel) {
        case 0: return (unsigned)__builtin_amdgcn_update_dpp(0, (int)x, 0xB1, 0xF, 0xF, true);
        case 1: return (unsigned)__builtin_amdgcn_update_dpp(0, (int)x, 0x4E, 0xF, 0xF, true);
        case 2: return (unsigned)__builtin_amdgcn_update_dpp(0, (int)x, 0x141, 0xF, 0xF, true);
        default: return (unsigned)__builtin_amdgcn_update_dpp(0, (int)x, 0x140, 0xF, 0xF, true);
    }
}
__device__ __forceinline__ unsigned row16_max_u32(unsigned x) {
    unsigned y;
    y = dppu(x, 0); x = x > y ? x : y;
    y = dppu(x, 1); x = x > y ? x : y;
    y = dppu(x, 2); x = x > y ? x : y;
    y = dppu(x, 3); x = x > y ? x : y;
    return x;
}
__device__ __forceinline__ float row16_sum_f32(float x) {
    x += __uint_as_float(dppu(__float_as_uint(x), 0));
    x += __uint_as_float(dppu(__float_as_uint(x), 1));
    x += __uint_as_float(dppu(__float_as_uint(x), 2));
    x += __uint_as_float(dppu(__float_as_uint(x), 3));
    return x;
}
__device__ __forceinline__ float row16_max_f32(float x) {
    x = fmaxf(x, __uint_as_float(dppu(__float_as_uint(x), 0)));
    x = fmaxf(x, __uint_as_float(dppu(__float_as_uint(x), 1)));
    x = fmaxf(x, __uint_as_float(dppu(__float_as_uint(x), 2)));
    x = fmaxf(x, __uint_as_float(dppu(__float_as_uint(x), 3)));
    return x;
}
__device__ __forceinline__ f32x4 mfma16(bf16x8 a, bf16x8 b, f32x4 c) { return __builtin_amdgcn_mfma_f32_16x16x32_bf16(a, b, c, 0, 0, 0); }

__device__ __forceinline__ float row_rscale(const float* ssq, int row) {
    float s = 0.f;
#pragma unroll
    for (int p = 0; p < 16; ++p) s += ssq[(size_t)p * MTOK + row];
    return rsqrtf(s * (1.f / D) + EPS);
}
struct EpiRowBf16 {
    static constexpr bool PERM = true, AFTER_DRAIN = false;
    bf16_t* O; int ldc; const float* ssq; float mul;
    __device__ __forceinline__ void operator()(const f32x4 (&acc)[2][2][4][2], const pg8::Unit& u, int wr, int wc, int fr, int fq) const {
        const int row0 = u.pm * 256 + wr * 64 + fr, col0 = u.pn * 256 + wc * 32 + 8 * fq;
#pragma unroll
        for (int ai = 0; ai < 2; ++ai)
#pragma unroll
            for (int m = 0; m < 4; ++m) {
                const int row = row0 + ai * 128 + m * 16;
                const float sc = ssq ? ssq[row] * mul : mul;
                bf16_t* rowp = O + (size_t)row * ldc + col0;
#pragma unroll
                for (int bj = 0; bj < 2; ++bj) {
                    const f32x4 v0 = acc[ai][bj][m][0] * sc, v1 = acc[ai][bj][m][1] * sc;
                    u32x4 w; w.x = pk2(v0[0], v0[1]); w.y = pk2(v0[2], v0[3]); w.z = pk2(v1[0], v1[1]); w.w = pk2(v1[2], v1[3]);
                    *(u32x4*)(rowp + bj * 128) = w;
                }
            }
    }
};
__device__ __forceinline__ float row_to_i8_finish(const u32x4 a0, const u32x4 a1, unsigned char* dst, int lane) {
    const unsigned ws_[8] = {a0.x, a0.y, a0.z, a0.w, a1.x, a1.y, a1.z, a1.w};
    float v[16], am = 0.f;
#pragma unroll
    for (int j = 0; j < 8; ++j) { v[2 * j] = bflo(ws_[j]); v[2 * j + 1] = bfhi(ws_[j]); am = fmaxf(am, fmaxf(fabsf(v[2 * j]), fabsf(v[2 * j + 1]))); }
    am = row16_max_f32(am); am = fmaxf(am, __shfl_xor(am, 16)); am = fmaxf(am, __shfl_xor(am, 32));
    const float sc = am > 0.f ? am * (1.f / 127.f) : 1.f, inv = 1.f / sc;
    unsigned o[4];
#pragma unroll
    for (int j = 0; j < 4; ++j) {
        unsigned w = 0;
#pragma unroll
        for (int e = 0; e < 4; ++e) w |= ((unsigned)((int)rintf(v[4 * j + e] * inv) & 255)) << (8 * e);
        o[j] = w;
    }
    *(u32x4*)(dst + 16 * lane) = (u32x4){o[0], o[1], o[2], o[3]};
    return sc;
}
__device__ __forceinline__ float row_to_i8(const bf16_t* src, unsigned char* dst, int lane) {
    return row_to_i8_finish(*(const u32x4*)(src + 16 * lane), *(const u32x4*)(src + 16 * lane + 8), dst, lane);
}
struct EpiRowI8 {
    static constexpr bool PERM = true, AFTER_DRAIN = false;
    bf16_t* O; int ldc; const float* sa; const float* sb;
    __device__ __forceinline__ void operator()(const f32x4 (&acc)[2][2][4][2], const pg8::Unit& u, int wr, int wc, int fr, int fq) const {
        typedef int v4i_t __attribute__((ext_vector_type(4)));
        const int row0 = u.pm * 256 + wr * 64 + fr, col0 = u.pn * 256 + wc * 32 + 8 * fq;
        f32x4 sb0[2], sb1[2];
#pragma unroll
        for (int bj = 0; bj < 2; ++bj) { sb0[bj] = *(const f32x4*)(sb + col0 + bj * 128); sb1[bj] = *(const f32x4*)(sb + col0 + bj * 128 + 4); }
#pragma unroll
        for (int ai = 0; ai < 2; ++ai)
#pragma unroll
            for (int m = 0; m < 4; ++m) {
                const int row = row0 + ai * 128 + m * 16;
                const float sc = sa[row];
                bf16_t* rowp = O + (size_t)row * ldc + col0;
#pragma unroll
                for (int bj = 0; bj < 2; ++bj) {
                    const v4i_t i0 = __builtin_bit_cast(v4i_t, acc[ai][bj][m][0]), i1 = __builtin_bit_cast(v4i_t, acc[ai][bj][m][1]);
                    const f32x4 v0 = (f32x4){(float)i0[0], (float)i0[1], (float)i0[2], (float)i0[3]} * sc * sb0[bj];
                    const f32x4 v1 = (f32x4){(float)i1[0], (float)i1[1], (float)i1[2], (float)i1[3]} * sc * sb1[bj];
                    u32x4 w; w.x = pk2(v0[0], v0[1]); w.y = pk2(v0[2], v0[3]); w.z = pk2(v1[0], v1[1]); w.w = pk2(v1[2], v1[3]);
#pragma unroll
                    for (int e = 0; e < 4; ++e) { const unsigned m_ = (w[e] >> 15) & 0x00010001u; w[e] ^= (m_ * 0x7FFFu) | 0x80008000u; }
                    *(u32x4*)(rowp + bj * 128) = w;
                }
            }
    }
};
template <bool RES_BF16>
struct EpiResid {
    static constexpr bool PERM = true, AFTER_DRAIN = false;
    const void* R; bf16_t* Hb; float* ssq;
    __device__ __forceinline__ void operator()(const f32x4 (&acc)[2][2][4][2], const pg8::Unit& u, int wr, int wc, int fr, int fq) const {
        const int row0 = u.pm * 256 + wr * 64 + fr, col0 = u.pn * 256 + wc * 32 + 8 * fq;
#pragma unroll
        for (int ai = 0; ai < 2; ++ai)
#pragma unroll
            for (int m = 0; m < 4; ++m) {
                const int row = row0 + ai * 128 + m * 16;
                const size_t off = (size_t)row * D + col0;
                float ss = 0.f;
#pragma unroll
                for (int bj = 0; bj < 2; ++bj) {
                    f32x4 r0, r1;
                    if (RES_BF16) { const u32x4 rb = *(const u32x4*)((const bf16_t*)R + off + bj * 128);
                        r0 = (f32x4){bflo(rb.x), bfhi(rb.x), bflo(rb.y), bfhi(rb.y)}; r1 = (f32x4){bflo(rb.z), bfhi(rb.z), bflo(rb.w), bfhi(rb.w)}; }
                    else { r0 = __builtin_nontemporal_load((const f32x4*)((const float*)R + off + bj * 128)); r1 = __builtin_nontemporal_load((const f32x4*)((const float*)R + off + bj * 128 + 4)); }
                    const f32x4 v0 = acc[ai][bj][m][0] + r0, v1 = acc[ai][bj][m][1] + r1;
                    u32x4 w; w.x = pk2(v0[0], v0[1]); w.y = pk2(v0[2], v0[3]); w.z = pk2(v1[0], v1[1]); w.w = pk2(v1[2], v1[3]);
                    *(u32x4*)(Hb + off + bj * 128) = w;
                    ss += v0[0] * v0[0] + v0[1] * v0[1] + v0[2] * v0[2] + v0[3] * v0[3] + v1[0] * v1[0] + v1[1] * v1[1] + v1[2] * v1[2] + v1[3] * v1[3];
                }
                ss += __shfl_xor(ss, 16); ss += __shfl_xor(ss, 32);
                if (fq == 0) ssq[(size_t)(u.pn * 4 + wc) * MTOK + row] = ss;
            }
    }
};
struct EpiKV {
    static constexpr bool PERM = true, AFTER_DRAIN = false;
    bf16_t* Kh; bf16_t* Vh;
    __device__ __forceinline__ void operator()(const f32x4 (&acc)[2][2][4][2], const pg8::Unit& u, int wr, int wc, int fr, int fq) const {
        const int row0 = u.pm * 256 + wr * 64 + fr, col0 = u.pn * 256 + wc * 32 + 8 * fq;
#pragma unroll
        for (int ai = 0; ai < 2; ++ai)
#pragma unroll
            for (int m = 0; m < 4; ++m) {
                const int row = row0 + ai * 128 + m * 16;
#pragma unroll
                for (int bj = 0; bj < 2; ++bj) {
                    const f32x4 v0 = acc[ai][bj][m][0], v1 = acc[ai][bj][m][1];
                    const int c = col0 + bj * 128, cc = c & 1023;
                    u32x4 w; w.x = pk2(v0[0], v0[1]); w.y = pk2(v0[2], v0[3]); w.z = pk2(v1[0], v1[1]); w.w = pk2(v1[2], v1[3]);
                    *(u32x4*)((c < 1024 ? Kh : Vh) + ((size_t)((row >> 8) * 4 + (cc >> 8)) * 256 + (row & 255)) * 256 + (cc & 255)) = w;
                }
            }
    }
};
struct EpiSoftmax {
    static constexpr bool PERM = true, AFTER_DRAIN = true;
    bf16_t* O; const float* ssq;
    __device__ __forceinline__ void operator()(const f32x4 (&)[2][2][4][2], const pg8::Unit&, int, int, int, int) const {}
    __device__ __forceinline__ void fused(const f32x4 (&acc)[2][2][4][2], const pg8::Unit& u, int wr, int wc, int fr, int fq, LAS unsigned char* lds, int wid, int lane) const {
        LAS float* red = (LAS float*)lds;
        const int row0 = u.pm * 256 + wr * 64 + fr, col0 = u.pn * 256 + wc * 32 + 8 * fq;
        float sc[2][4];
#pragma unroll
        for (int ai = 0; ai < 2; ++ai)
#pragma unroll
            for (int m = 0; m < 4; ++m) {
                sc[ai][m] = ssq[row0 + ai * 128 + m * 16];
                float v = -INFINITY;
#pragma unroll
                for (int bj = 0; bj < 2; ++bj)
#pragma unroll
                    for (int n = 0; n < 2; ++n)
#pragma unroll
                        for (int j = 0; j < 4; ++j) v = fmaxf(v, acc[ai][bj][m][n][j] * sc[ai][m]);
                v = fmaxf(v, __shfl_xor(v, 16)); v = fmaxf(v, __shfl_xor(v, 32));
                if (fq == 0) red[wc * 256 + ai * 128 + wr * 64 + m * 16 + fr] = v;
            }
        __syncthreads();
        float rsum[2][4], rmax[2][4];
#pragma unroll
        for (int ai = 0; ai < 2; ++ai)
#pragma unroll
            for (int m = 0; m < 4; ++m) {
                const int rl = ai * 128 + wr * 64 + m * 16 + fr;
                rmax[ai][m] = fmaxf(fmaxf(red[rl], red[256 + rl]), fmaxf(red[512 + rl], red[768 + rl]));
                float s = 0.f;
#pragma unroll
                for (int bj = 0; bj < 2; ++bj)
#pragma unroll
                    for (int n = 0; n < 2; ++n)
#pragma unroll
                        for (int j = 0; j < 4; ++j) s += __expf(acc[ai][bj][m][n][j] * sc[ai][m] - rmax[ai][m]);
                s += __shfl_xor(s, 16); s += __shfl_xor(s, 32);
                if (fq == 0) red[1024 + wc * 256 + rl] = s;
            }
        __syncthreads();
#pragma unroll
        for (int ai = 0; ai < 2; ++ai)
#pragma unroll
            for (int m = 0; m < 4; ++m) {
                const int rl = ai * 128 + wr * 64 + m * 16 + fr;
                const float inv = 1.f / ((red[1024 + rl] + red[1280 + rl]) + (red[1536 + rl] + red[1792 + rl]));
                rsum[ai][m] = inv;
                bf16_t* rowp = O + (size_t)(row0 + ai * 128 + m * 16) * D + col0;
#pragma unroll
                for (int bj = 0; bj < 2; ++bj) {
                    float e[2][4];
#pragma unroll
                    for (int n = 0; n < 2; ++n)
#pragma unroll
                        for (int j = 0; j < 4; ++j) e[n][j] = __expf(acc[ai][bj][m][n][j] * sc[ai][m] - rmax[ai][m]) * inv;
                    u32x4 w; w.x = pk2(e[0][0], e[0][1]); w.y = pk2(e[0][2], e[0][3]); w.z = pk2(e[1][0], e[1][1]); w.w = pk2(e[1][2], e[1][3]);
                    *(u32x4*)(rowp + bj * 128) = w;
                }
            }
        __syncthreads();
    }
};

__device__ __forceinline__ void p0_transpose_item(const float* W, int ldw, int col0, int K, bf16_t* WT, int row0, const float* g, LAS float* scr, int item, int nblk, int lane) {
    const int kb = item / nblk, nb = item % nblk, k0 = 64 * kb, n0 = 32 * nb;
    float tv[32];
#pragma unroll
    for (int i = 0; i < 32; ++i) tv[i] = __builtin_nontemporal_load(W + (size_t)(k0 + 2 * i + (lane >> 5)) * ldw + col0 + n0 + (lane & 31));
#pragma unroll
    for (int i = 0; i < 32; ++i) {
        const int kk = 2 * i + (lane >> 5);
        float v = tv[i];
        if (g) v *= g[k0 + kk];
        scr[kk * 33 + (lane & 31)] = v;
    }
    LDS_FENCE();
    const int c = lane & 7;
#pragma unroll
    for (int j = 0; j < 4; ++j) {
        const int n = (lane >> 3) + 8 * j; const LAS float* s = scr + (8 * c) * 33 + n;
        u32x4 o; o.x = pk2(s[0 * 33], s[1 * 33]); o.y = pk2(s[2 * 33], s[3 * 33]); o.z = pk2(s[4 * 33], s[5 * 33]); o.w = pk2(s[6 * 33], s[7 * 33]);
        *(u32x4*)(WT + (size_t)(row0 + n0 + n) * K + k0 + 8 * c) = o;
    }
    LDS_FENCE();
}
__device__ __forceinline__ void rms_row_load(const float* xrow, int lane, f32x4 (&v)[4]) {
    const f32x4* xr = (const f32x4*)xrow + lane;
#pragma unroll
    for (int j = 0; j < 4; ++j) v[j] = __builtin_nontemporal_load(xr + 64 * j);
}
template <bool RAW>
__device__ __forceinline__ float rms_row_finish(const float* g, bf16_t* orow, int lane, f32x4 (&v)[4]) {
    float s = 0.f;
#pragma unroll
    for (int j = 0; j < 4; ++j) s += (v[j][0] * v[j][0] + v[j][1] * v[j][1]) + (v[j][2] * v[j][2] + v[j][3] * v[j][3]);
    const float r = rsqrtf(wave_sum(s) * (1.f / D) + EPS);
    unsigned long long* o8 = (unsigned long long*)orow + lane;
#pragma unroll
    for (int j = 0; j < 4; ++j) {
        const f32x4 gv = ((const f32x4*)g)[lane + 64 * j];
        if (RAW) o8[64 * j] = (unsigned long long)pk2(v[j][0], v[j][1]) | ((unsigned long long)pk2(v[j][2], v[j][3]) << 32);
        v[j] = v[j] * r * gv;
        if (!RAW) o8[64 * j] = (unsigned long long)pk2(v[j][0], v[j][1]) | ((unsigned long long)pk2(v[j][2], v[j][3]) << 32);
    }
    return r;
}
__device__ __forceinline__ void p0_late_transposes(const Args& a, LAS unsigned char* lds) {
    const int tid = threadIdx.x, lane = tid & 63, wave = tid >> 6;
    if (wave < 5) return;
    const int G = gridDim.x, gw = blockIdx.x * 3 + (wave - 5), NGW = G * 3;
    unsigned char* ws = a.ws;
    LAS float* scr = (LAS float*)(lds + wave * 8704);
    constexpr int I_SQ = 16 * 32, I_HD = 4 * 32;
    constexpr int NITEMS = I_SQ + 4 * I_HD;
    for (int it = gw; it < NITEMS; it += NGW) {
        int r = it;
        if (r < I_SQ) { p0_transpose_item(a.in[I_WOUT], D, 0, D, (bf16_t*)(ws + WS_WOUT), 0, nullptr, scr, r, 32, lane); continue; } r -= I_SQ;
        { const int h = r / I_HD; p0_transpose_item(a.in[I_WXO] + (size_t)h * 256 * D, D, 0, 256, (bf16_t*)(ws + WS_WXO) + (size_t)h * 1024 * 256, 0, nullptr, scr, r % I_HD, 32, lane); }
    }
    {
        const float* wp = a.in[I_WPQ]; const float* gf = a.in[I_GFFN];
        bf16_t* wgr = (bf16_t*)(ws + WS_WGR);
        for (int i = (blockIdx.x * 3 + (wave - 5)) * 64 + lane; i < 1024 * 256; i += G * 3 * 64) {
            const int k = i >> 8, c8 = (i & 255) * 8;
            const float gk = gf[k];
            const f32x4 v0 = *(const f32x4*)(wp + (size_t)k * 2048 + c8) * gk, v1 = *(const f32x4*)(wp + (size_t)k * 2048 + c8 + 4) * gk;
            u32x4 w; w.x = pk2(v0[0], v0[1]); w.y = pk2(v0[2], v0[3]); w.z = pk2(v1[0], v1[1]); w.w = pk2(v1[2], v1[3]);
            *(u32x4*)(wgr + (size_t)k * 2048 + c8) = w;
        }
    }
    const float* wq = a.in[I_WXQ]; const float* gc = a.in[I_GCROSS];
    bf16_t* wqr = (bf16_t*)(ws + WS_WXQ);
    for (int i = (blockIdx.x * 3 + (wave - 5)) * 64 + lane; i < 1024 * 128; i += G * 3 * 64) {
        const int k = i >> 7, c8 = (i & 127) * 8, h = c8 >> 8, dh = c8 & 255;
        const float gk = gc[k] * 0.0625f;
        const f32x4 v0 = *(const f32x4*)(wq + (size_t)k * D + c8) * gk, v1 = *(const f32x4*)(wq + (size_t)k * D + c8 + 4) * gk;
        u32x4 w; w.x = pk2(v0[0], v0[1]); w.y = pk2(v0[2], v0[3]); w.z = pk2(v1[0], v1[1]); w.w = pk2(v1[2], v1[3]);
        *(u32x4*)(wqr + ((size_t)h * 1024 + k) * 256 + dh) = w;
    }
}
__device__ __forceinline__ void p0_experts(const Args& a, int part, int npart) {
    const int tid = threadIdx.x, lane = tid & 63, wave = tid >> 6;
    const int gw = part * NWAVES + wave, NGW = npart * NWAVES;
    unsigned char* ws = a.ws;
    {
        const float* gf = a.in[I_GFFN];
        float* esc = (float*)(ws + WS_ESC);
        f32x4 gv[4];
#pragma unroll
        for (int j = 0; j < 4; ++j) gv[j] = *(const f32x4*)(gf + 4 * lane + 256 * j);
        for (int r0 = 4 * gw; r0 < 2 * 16384; r0 += 4 * NGW) {
            f32x4 v[4][4];
#pragma unroll
            for (int q = 0; q < 4; ++q) {
                const int r = r0 + q; const bool up = r >= 16384; const int e = up ? r - 16384 : r;
                const float* src = (up ? a.in[I_EUP] : a.in[I_EDOWN]) + (size_t)e * D + 4 * lane;
#pragma unroll
                for (int j = 0; j < 4; ++j) v[q][j] = __builtin_nontemporal_load((const f32x4*)(src + 256 * j));
            }
#pragma unroll
            for (int q = 0; q < 4; ++q) {
                const int r = r0 + q; const bool up = r >= 16384; const int e = up ? r - 16384 : r;
                float am = 0.f;
#pragma unroll
                for (int j = 0; j < 4; ++j) { if (!up) v[q][j] = v[q][j] * gv[j];
                    am = fmaxf(am, fmaxf(fmaxf(fabsf(v[q][j][0]), fabsf(v[q][j][1])), fmaxf(fabsf(v[q][j][2]), fabsf(v[q][j][3])))); }
                am = row16_max_f32(am); am = fmaxf(am, __shfl_xor(am, 16)); am = fmaxf(am, __shfl_xor(am, 32));
                if (!up) {
                    const float sc4 = am > 0.f ? am * (1.f / 7.f) : 1.f, inv4 = 1.f / sc4;
                    const bool hi = lane & 1;
#pragma unroll
                    for (int j = 0; j < 4; ++j) {
                        unsigned w = 0;
#pragma unroll
                        for (int c = 0; c < 4; ++c) { const int qq = (int)rintf(v[q][j][c] * inv4); w |= (hi ? (((unsigned)qq & 15u) << 4) : ((unsigned)qq & 15u)) << (8 * c); }
                        w |= dppu(w, 0);
                        if (!hi) *(unsigned*)(ws + WS_ED + (size_t)j * (16384 * 128) + (size_t)e * 128 + 4 * (lane >> 1)) = w;
                    }
                    if (lane == 0) esc[r] = sc4;
                    continue;
                }
                {
                    const float sc4 = am > 0.f ? am * (1.f / 7.f) : 1.f, inv4 = 1.f / sc4;
#pragma unroll
                    for (int j = 0; j < 4; ++j) {
                        const int q0 = (int)rintf(v[q][j][0] * inv4), q1 = (int)rintf(v[q][j][1] * inv4), q2 = (int)rintf(v[q][j][2] * inv4), q3 = (int)rintf(v[q][j][3] * inv4);
                        unsigned w = (((unsigned)(q0 + 8) & 15u) | (((unsigned)q1 & 15u) << 4) | (((unsigned)(q2 + 8) & 15u) << 8) | (((unsigned)q3 & 15u) << 12)) << (16 * (lane & 1));
                        w |= dppu(w, 0);
                        if (!(lane & 1)) *(unsigned*)(ws + WS_EU + (size_t)j * (16384 * 128) + (size_t)e * 128 + 4 * (lane >> 1)) = w;
                    }
                    if (lane == 0) esc[r] = sc4;
                }
            }
        }
    }
}
__device__ __forceinline__ void phase0(const Args& a, LAS unsigned char* lds) {
    const int tid = threadIdx.x, lane = tid & 63, wave = tid >> 6;
    const int G = gridDim.x, gw = blockIdx.x * NWAVES + wave, NGW = G * NWAVES;
    unsigned char* ws = a.ws;
    LAS float* scr = (LAS float*)(lds + wave * 8704);
    {
        constexpr int I_W1 = 16 * 48, I_W2 = 16 * 24, I_SQ = 16 * 32;
        constexpr int NITEMS = I_W1 + I_W2 + 2 * I_SQ;
        for (int it = gw; it < NITEMS; it += NGW) {
            int r = it;
            if (r < I_W1) { p0_transpose_item(a.in[I_WIN], 2312, 0, D, (bf16_t*)(ws + WS_WIN), 0, a.in[I_GMIX], scr, r, 48, lane); continue; } r -= I_W1;
            if (r < I_W2) { p0_transpose_item(a.in[I_WIN], 2312, 1544, D, (bf16_t*)(ws + WS_WIN), 1536, a.in[I_GMIX], scr, r, 24, lane); continue; } r -= I_W2;
            if (r < I_SQ) { p0_transpose_item(a.in[I_WXK], D, 0, D, (bf16_t*)(ws + WS_WXKV), 0, nullptr, scr, r, 32, lane); continue; } r -= I_SQ;
            p0_transpose_item(a.in[I_WXV], D, 0, D, (bf16_t*)(ws + WS_WXKV), 1024, nullptr, scr, r, 32, lane);
        }
    }
    {
        const size_t T = (size_t)G * NTHREADS, gt = (size_t)blockIdx.x * NTHREADS + tid;
        for (size_t i = gt; i < 2 * 16384 / 8; i += T) {
            const bool s2 = i >= 2048; const size_t j = s2 ? i - 2048 : i;
            const float* src = (s2 ? a.in[I_SK2] : a.in[I_SK1]) + j * 8;
            const f32x4 v0 = *(const f32x4*)src, v1 = *(const f32x4*)(src + 4);
            u32x4 w; w.x = pk2(v0[0], v0[1]); w.y = pk2(v0[2], v0[3]); w.z = pk2(v1[0], v1[1]); w.w = pk2(v1[2], v1[3]);
            *(u32x4*)((bf16_t*)(ws + WS_SK) + (s2 ? 16384 : 0) + j * 8) = w;
        }
    }
    {
        const float* win = a.in[I_WIN];
        float* gates = (float*)(ws + WS_GATES);
        const float* bi = a.in[I_BI]; const float* bfg = a.in[I_BF];
        LAS f32x4* wg = (LAS f32x4*)(lds + 8 * 8704);
        __syncthreads();
        for (int i = tid; i < 2048; i += NTHREADS) {
            const int ln = i & 63, e = (i >> 6) & 3, j = (i >> 8) & 3, half = i >> 10;
            wg[i] = *(const f32x4*)(win + (size_t)(4 * ln + 256 * j + e) * 2312 + 1536 + 4 * half);
        }
        __syncthreads();
        for (int rowp = 2 * gw; rowp < MTOK; rowp += 2 * NGW) {
          f32x4 vv[2][4];
          rms_row_load(a.in[I_X] + (size_t)rowp * D, lane, vv[0]); rms_row_load(a.in[I_X] + (size_t)(rowp + 1) * D, lane, vv[1]);
#pragma unroll
          for (int q = 0; q < 2; ++q) {
            const int row = rowp + q;
            f32x4 (&v)[4] = vv[q];
            const float rx = rms_row_finish<true>(a.in[I_GMIX], (bf16_t*)(ws + WS_XB) + (size_t)row * D, lane, v);
            if (lane == 0) ((float*)(ws + WS_RX))[row] = rx;
            f32x4 g0 = {0.f, 0.f, 0.f, 0.f}, g1 = {0.f, 0.f, 0.f, 0.f};
#pragma unroll
            for (int j = 0; j < 4; ++j)
#pragma unroll
                for (int e = 0; e < 4; ++e) { const float xv = v[j][e]; g0 += xv * wg[(j * 4 + e) * 64 + lane]; g1 += xv * wg[1024 + (j * 4 + e) * 64 + lane]; }
            const bool b5 = lane & 32, b4 = lane & 16, b3 = lane & 8;
            f32x4 k4, s4;
#pragma unroll
            for (int i = 0; i < 4; ++i) { k4[i] = b5 ? g1[i] : g0[i]; s4[i] = b5 ? g0[i] : g1[i]; }
#pragma unroll
            for (int i = 0; i < 4; ++i) k4[i] += __shfl_xor(s4[i], 32);
            float k2a = b4 ? k4[2] : k4[0], k2b = b4 ? k4[3] : k4[1];
            k2a += __shfl_xor(b4 ? k4[0] : k4[2], 16); k2b += __shfl_xor(b4 ? k4[1] : k4[3], 16);
            float k1 = (b3 ? k2b : k2a) + __shfl_xor(b3 ? k2a : k2b, 8);
            k1 += __uint_as_float(dppu(__float_as_uint(k1), 0)); k1 += __uint_as_float(dppu(__float_as_uint(k1), 1)); k1 += __uint_as_float(dppu(__float_as_uint(k1), 2));
            if ((lane & 7) == 0) {
                const int c = lane >> 3;
                float val = k1;
                if (c < 4) val += bi[c];
                else { const float f = val + bfg[c - 4]; val = fminf(f, 0.f) - log1pf(__expf(-fabsf(f))); }
                gates[(size_t)row * 8 + c] = val;
            }
          }
        }
    }
    for (int row = gw; row < NB * MEMLEN; row += NGW) {
        f32x4 v[4];
        rms_row_load(a.in[I_MEM] + (size_t)row * D, lane, v);
        (void)rms_row_finish<false>(a.in[I_GMEM], (bf16_t*)(ws + WS_C) + (size_t)row * D, lane, v);
    }
}

constexpr int LVS = 144;
constexpr int LQ = 72;
__device__ __forceinline__ void conv8_load(const bf16_t* src, int tok_in_seq, u32x4 (&xv)[4]) {
#pragma unroll
    for (int j = 0; j < 4; ++j) { const int d = (tok_in_seq - 3 + j >= 0) ? j - 3 : 0; xv[j] = *(const u32x4*)(src + (ptrdiff_t)d * NPROJ); }
}
__device__ __forceinline__ void conv8_finish(const u32x4 (&xv)[4], int tok_in_seq, const float* cw, const float* cb, int ch, float (&y)[8]) {
#pragma unroll
    for (int e = 0; e < 8; ++e) y[e] = cb[ch + e];
#pragma unroll
    for (int j = 0; j < 4; ++j) {
        const float m = (tok_in_seq - 3 + j >= 0) ? 1.f : 0.f;
        const f32x4 w0 = *(const f32x4*)(cw + j * 512 + ch) * m, w1 = *(const f32x4*)(cw + j * 512 + ch + 4) * m;
        y[0] += w0[0] * bflo(xv[j].x); y[1] += w0[1] * bfhi(xv[j].x); y[2] += w0[2] * bflo(xv[j].y); y[3] += w0[3] * bfhi(xv[j].y);
        y[4] += w1[0] * bflo(xv[j].z); y[5] += w1[1] * bfhi(xv[j].z); y[6] += w1[2] * bflo(xv[j].w); y[7] += w1[3] * bfhi(xv[j].w);
    }
#pragma unroll
    for (int e = 0; e < 8; ++e) y[e] = y[e] * sigmoidf_(y[e]);
}
__device__ __forceinline__ void conv8(const bf16_t* src, int tok_in_seq, const float* cw, const float* cb, int ch, float (&y)[8]) {
    u32x4 xv[4]; conv8_load(src, tok_in_seq, xv); conv8_finish(xv, tok_in_seq, cw, cb, ch, y);
}
__device__ __forceinline__ float chunk_cumsum(float lf, int lane) {
    float b = lf;
#pragma unroll
    for (int o = 1; o < 64; o <<= 1) { const float t = __shfl_up(b, o); if (lane >= o) b += t; }
    return b;
}

struct MlIn { u32x4 ktap[4]; u32x4 v0, v1; float ig, lf; };
__device__ __forceinline__ void mlstm_local_load(const Args& a, int task, MlIn& in) {
    const int tid = threadIdx.x, lane = tid & 63;
    const int b = task >> 9, h = (task >> 7) & 3, c = task & 127;
    const int row0 = b * SEQ + c * 64;
    const bf16_t* proj = (const bf16_t*)(a.ws + WS_A);
    const float* gates = (const float*)(a.ws + WS_GATES);
    conv8_load(proj + (size_t)(row0 + (tid >> 3)) * NPROJ + C_MK + h * 64 + (tid & 7) * 8, c * 64 + (tid >> 3), in.ktap);
    in.v0 = *(const u32x4*)(proj + (size_t)(row0 + (tid >> 3)) * NPROJ + C_MV + h * 128 + (tid & 7) * 16);
    in.v1 = *(const u32x4*)(proj + (size_t)(row0 + (tid >> 3)) * NPROJ + C_MV + h * 128 + (tid & 7) * 16 + 8);
    in.ig = gates[(size_t)(row0 + lane) * 8 + h]; in.lf = gates[(size_t)(row0 + lane) * 8 + 4 + h];
}
__device__ __forceinline__ void mlstm_local(const Args& a, LAS unsigned char* lds, int task, const MlIn& in, bool fill) {
    const int tid = threadIdx.x, lane = tid & 63, wave = tid >> 6;
    const int h = (task >> 7) & 3, c = task & 127;
    LAS bf16_t* VTw = (LAS bf16_t*)lds;
    LAS bf16_t* Ksr = (LAS bf16_t*)(lds + 144 * LQ * 2);
    LAS float* wS = (LAS float*)(lds + 144 * LQ * 2 + 64 * LQ * 2);
    LAS bf16_t* Vsr = (LAS bf16_t*)(lds + 144 * LQ * 2 + 64 * LQ * 2 + 256);
    if (wave == 0) {
        const float ig = in.ig, lf = in.lf;
        const float bs = chunk_cumsum(lf, lane);
        const float bL = __shfl(bs, 63);
        wS[lane] = __expf(bL - bs + ig);
        if (lane == 63) ((float*)(a.ws + WS_DECAY))[task] = __expf(bL);
    }
    {
        const int s = tid >> 3, cg = (tid & 7) * 8;
        float y[8];
        conv8_finish(in.ktap, c * 64 + s, a.in[I_CONVW], a.in[I_CONVB], 256 + h * 64 + cg, y);
        u32x4 w; w.x = pk2(y[0], y[1]); w.y = pk2(y[2], y[3]); w.z = pk2(y[4], y[5]); w.w = pk2(y[6], y[7]);
        *(LAS u32x4*)(Ksr + s * LQ + cg) = w;
    }
    __syncthreads();
    {
        const int s = tid >> 3, vg = (tid & 7) * 16;
        const float w = wS[s];
        const u32x4 x0 = in.v0, x1 = in.v1;
        const unsigned xs[8] = {x0.x, x0.y, x0.z, x0.w, x1.x, x1.y, x1.z, x1.w};
        unsigned ys[8];
#pragma unroll
        for (int e = 0; e < 8; ++e) ys[e] = pk2(w * bflo(xs[e]), w * bfhi(xs[e]));
        *(LAS u32x4*)(Vsr + s * LVS + vg) = (u32x4){ys[0], ys[1], ys[2], ys[3]};
        *(LAS u32x4*)(Vsr + s * LVS + vg + 8) = (u32x4){ys[4], ys[5], ys[6], ys[7]};
        if ((tid & 7) == 0) VTw[128 * LQ + s] = f2bf(w);
        if (fill) for (int i = tid; i < 15 * 64; i += NTHREADS) VTw[(129 + (i >> 6)) * LQ + (i & 63)] = 0;
    }
    __syncthreads();
    float* dC = (float*)(a.ws + WS_B) + (size_t)task * 8192;
    float* dn = (float*)(a.ws + WS_DN) + (size_t)task * 64;
    for (int T = wave; T < 36; T += 8) {
        const int mt = T >> 2, nt = T & 3;
        f32x4 acc = {0.f, 0.f, 0.f, 0.f};
#pragma unroll
        for (int ks = 0; ks < 2; ++ks) {
            typedef short v4s_t __attribute__((ext_vector_type(4)));
            const int s0 = ks * 32 + 8 * (lane >> 4) + ((lane & 15) >> 2);
            bf16x8 av, bv;
            if (mt < 8) {
                const LAS bf16_t* vr = Vsr + s0 * LVS + mt * 16 + 4 * (lane & 3);
                const u32x2 lo = __builtin_bit_cast(u32x2, __builtin_amdgcn_ds_read_tr16_b64_v4i16((LAS v4s_t*)vr));
                const u32x2 hi = __builtin_bit_cast(u32x2, __builtin_amdgcn_ds_read_tr16_b64_v4i16((LAS v4s_t*)(vr + 4 * LVS)));
                av = __builtin_bit_cast(bf16x8, (u32x4){lo.x, lo.y, hi.x, hi.y});
            } else av = *(const LAS bf16x8*)(VTw + (mt * 16 + (lane & 15)) * LQ + ks * 32 + 8 * (lane >> 4));
            {
                const LAS bf16_t* kr = Ksr + s0 * LQ + nt * 16 + 4 * (lane & 3);
                const u32x2 lo = __builtin_bit_cast(u32x2, __builtin_amdgcn_ds_read_tr16_b64_v4i16((LAS v4s_t*)kr));
                const u32x2 hi = __builtin_bit_cast(u32x2, __builtin_amdgcn_ds_read_tr16_b64_v4i16((LAS v4s_t*)(kr + 4 * LQ)));
                bv = __builtin_bit_cast(bf16x8, (u32x4){lo.x, lo.y, hi.x, hi.y});
            }
            acc = mfma16(av, bv, acc);
        }
        const int col = nt * 16 + (lane & 15);
        if (mt < 8) {
#pragma unroll
            for (int r = 0; r < 4; ++r) dC[(mt * 16 + (lane >> 4) * 4 + r) * 64 + col] = acc[r];
        } else if ((lane >> 4) == 0) dn[col] = acc[0];
    }
    __syncthreads();
}

__device__ __forceinline__ void mlstm_scan(const Args& a) {
    const size_t T = (size_t)gridDim.x * NTHREADS;
    const float* decay = (const float*)(a.ws + WS_DECAY);
    for (size_t chain = ((size_t)(threadIdx.x >> 6) * gridDim.x + blockIdx.x) * 64 + (threadIdx.x & 63); chain < 8 * 8256; chain += T) {
        const int bh = (int)(chain / 8256), e = (int)(chain % 8256);
        float* p; size_t stride; bf16_t* pst = nullptr;
        if (e < 8192) { p = (float*)(a.ws + WS_B) + (size_t)bh * 128 * 8192 + e; stride = 8192; pst = (bf16_t*)(a.ws + WS_ST) + (size_t)bh * 128 * 8192 + e; }
        else { p = (float*)(a.ws + WS_DN) + (size_t)bh * 128 * 64 + (e - 8192); stride = 64; }
        float C = 0.f;
        for (int c0 = 0; c0 < 128; c0 += 32) {
            float t[32], dk[32];
#pragma unroll
            for (int j = 0; j < 32; ++j) { t[j] = __builtin_nontemporal_load(p + (size_t)(c0 + j) * stride); dk[j] = decay[bh * 128 + c0 + j]; }
#pragma unroll
            for (int j = 0; j < 32; ++j) {
                if (pst) pst[(size_t)(c0 + j) * 8192] = f2bf(C); else p[(size_t)(c0 + j) * stride] = C;
                C = dk[j] * C + t[j];
            }
        }
    }
}

__device__ __forceinline__ void mlstm_out(const Args& a, LAS unsigned char* lds, int task, bool fill) {
    const int tid = threadIdx.x, lane = tid & 63, wave = tid >> 6;
    const int b = task >> 9, h = (task >> 7) & 3, c = task & 127;
    const int row0 = b * SEQ + c * 64;
    const bf16_t* proj = (const bf16_t*)(a.ws + WS_A);
    const float* gates = (const float*)(a.ws + WS_GATES);
    LAS bf16_t* Qs = (LAS bf16_t*)lds;
    LAS bf16_t* Ks = Qs + 64 * LQ;
    LAS bf16_t* Qp = Ks + 64 * LQ;
    LAS bf16_t* Ps = Qp + 64 * LQ;
    LAS bf16_t* VT = Ps + 64 * LQ;
    LAS bf16_t* Cs = VT + 144 * LQ;
    LAS float* bS = (LAS float*)(Cs + 144 * LQ);
    LAS float* iS = bS + 64;
    LAS float* denS = iS + 64;
    LAS float* ssqS = denS + 64;
    LAS bf16_t* Vs = (LAS bf16_t*)(ssqS + 128);
    const float ig_l = gates[(size_t)(row0 + lane) * 8 + h], lf_l = gates[(size_t)(row0 + lane) * 8 + 4 + h];
    const float b_l = chunk_cumsum(lf_l, lane);
    if (wave == 0) { bS[lane] = b_l; iS[lane] = ig_l; }
    const float eb_s = __expf(__shfl(b_l, tid >> 3));
    u32x4 qtap[4];
    conv8_load(proj + (size_t)(row0 + (tid >> 3)) * NPROJ + C_MQ + h * 64 + (tid & 7) * 8, c * 64 + (tid >> 3), qtap);
    bf16_t mo_pre[4][4];
#pragma unroll
    for (int r = 0; r < 4; ++r)
#pragma unroll
        for (int i = 0; i < 4; ++i)
            mo_pre[r][i] = proj[(size_t)(row0 + (wave & 3) * 16 + (lane >> 4) * 4 + r) * NPROJ + C_MO + h * 128 + ((wave >> 2) * 4 + i) * 16 + (lane & 15)];
    {
        const int s = tid >> 3, cg = (tid & 7) * 8;
        float y[8];
        conv8(proj + (size_t)(row0 + s) * NPROJ + C_MK + h * 64 + cg, c * 64 + s, a.in[I_CONVW], a.in[I_CONVB], 256 + h * 64 + cg, y);
        u32x4 w; w.x = pk2(y[0], y[1]); w.y = pk2(y[2], y[3]); w.z = pk2(y[4], y[5]); w.w = pk2(y[6], y[7]);
        *(LAS u32x4*)(Ks + s * LQ + cg) = w;
        const int vg = (tid & 7) * 16;
        const u32x4 x0 = *(const u32x4*)(proj + (size_t)(row0 + s) * NPROJ + C_MV + h * 128 + vg), x1 = *(const u32x4*)(proj + (size_t)(row0 + s) * NPROJ + C_MV + h * 128 + vg + 8);
        *(LAS u32x4*)(Vs + s * LVS + vg) = x0; *(LAS u32x4*)(Vs + s * LVS + vg + 8) = x1;
        if (fill) {
            if ((tid & 7) == 0) VT[128 * LQ + s] = 0x3F80;
            for (int i = tid; i < 15 * 64; i += NTHREADS) { VT[(129 + (i >> 6)) * LQ + (i & 63)] = 0; Cs[(129 + (i >> 6)) * LQ + (i & 63)] = 0; }
        }
        const bf16_t* st = (const bf16_t*)(a.ws + WS_ST) + (size_t)task * 8192;
        const int v = tid >> 2, k0 = (tid & 3) * 16;
        *(LAS u32x4*)(Cs + v * LQ + k0) = *(const u32x4*)(st + v * 64 + k0);
        *(LAS u32x4*)(Cs + v * LQ + k0 + 8) = *(const u32x4*)(st + v * 64 + k0 + 8);
        if (tid < 64) Cs[128 * LQ + tid] = f2bf(((const float*)(a.ws + WS_DN))[(size_t)task * 64 + tid]);
    }
    {
        const int s = tid >> 3, cg = (tid & 7) * 8;
        float y[8];
        conv8_finish(qtap, c * 64 + s, a.in[I_CONVW], a.in[I_CONVB], h * 64 + cg, y);
        const float eb = eb_s;
#pragma unroll
        for (int e = 0; e < 8; ++e) y[e] *= 0.125f;
        u32x4 w; w.x = pk2(y[0], y[1]); w.y = pk2(y[2], y[3]); w.z = pk2(y[4], y[5]); w.w = pk2(y[6], y[7]);
        *(LAS u32x4*)(Qs + s * LQ + cg) = w;
        w.x = pk2(y[0] * eb, y[1] * eb); w.y = pk2(y[2] * eb, y[3] * eb); w.z = pk2(y[4] * eb, y[5] * eb); w.w = pk2(y[6] * eb, y[7] * eb);
        *(LAS u32x4*)(Qp + s * LQ + cg) = w;
    }
    __syncthreads();
    {
        const int mt = wave >> 1;
#pragma unroll
        for (int i = 0; i < 2; ++i) {
            const int nt = (wave & 1) * 2 + i;
            f32x4 acc = {0.f, 0.f, 0.f, 0.f};
#pragma unroll
            for (int ks = 0; ks < 2; ++ks) {
                const bf16x8 av = *(const LAS bf16x8*)(Qs + (mt * 16 + (lane & 15)) * LQ + ks * 32 + 8 * (lane >> 4));
                const bf16x8 bv = *(const LAS bf16x8*)(Ks + (nt * 16 + (lane & 15)) * LQ + ks * 32 + 8 * (lane >> 4));
                acc = mfma16(av, bv, acc);
            }
            const int s = nt * 16 + (lane & 15);
            const float bs = bS[s], is = iS[s];
            float pv[4];
#pragma unroll
            for (int r = 0; r < 4; ++r) {
                const int t = mt * 16 + (lane >> 4) * 4 + r;
                pv[r] = (s <= t) ? acc[r] * __expf(bS[t] - bs + is) : 0.f;
            }
            { u32x2 w; w.x = pk2(pv[0], pv[1]); w.y = pk2(pv[2], pv[3]); *(LAS u32x2*)(Ps + s * LQ + mt * 16 + (lane >> 4) * 4) = w; }
        }
    }
    __syncthreads();
    const int mt = wave & 3, ng = wave >> 2;
    f32x4 acc[5];
#pragma unroll
    for (int i = 0; i < 5; ++i) acc[i] = (f32x4){0.f, 0.f, 0.f, 0.f};
#pragma unroll
    for (int ks = 0; ks < 4; ++ks) {
        const LAS bf16_t* Ab = (ks < 2) ? Ps : Qp; const LAS bf16_t* Bb = (ks < 2) ? VT : Cs;
        const int ko = (ks & 1) * 32 + 8 * (lane >> 4);
        bf16x8 av;
        if (ks < 2) {
            typedef short v4s_t __attribute__((ext_vector_type(4)));
            const LAS bf16_t* pr = Ps + (ko + ((lane & 15) >> 2)) * LQ + mt * 16 + 4 * (lane & 3);
            const u32x2 lo = __builtin_bit_cast(u32x2, __builtin_amdgcn_ds_read_tr16_b64_v4i16((LAS v4s_t*)pr));
            const u32x2 hi = __builtin_bit_cast(u32x2, __builtin_amdgcn_ds_read_tr16_b64_v4i16((LAS v4s_t*)(pr + 4 * LQ)));
            const u32x4 w = {lo.x, lo.y, hi.x, hi.y};
            av = __builtin_bit_cast(bf16x8, w);
        } else av = *(const LAS bf16x8*)(Ab + (mt * 16 + (lane & 15)) * LQ + ko);
#pragma unroll
        for (int i = 0; i < 4; ++i) {
            bf16x8 bv;
            if (ks < 2) {
                typedef short v4s_t __attribute__((ext_vector_type(4)));
                const LAS bf16_t* vr = Vs + (ko + ((lane & 15) >> 2)) * LVS + (ng * 4 + i) * 16 + 4 * (lane & 3);
                const u32x2 lo = __builtin_bit_cast(u32x2, __builtin_amdgcn_ds_read_tr16_b64_v4i16((LAS v4s_t*)vr));
                const u32x2 hi = __builtin_bit_cast(u32x2, __builtin_amdgcn_ds_read_tr16_b64_v4i16((LAS v4s_t*)(vr + 4 * LVS)));
                const u32x4 w = {lo.x, lo.y, hi.x, hi.y};
                bv = __builtin_bit_cast(bf16x8, w);
            } else bv = *(const LAS bf16x8*)(Bb + ((ng * 4 + i) * 16 + (lane & 15)) * LQ + ko);
            acc[i] = mfma16(av, bv, acc[i]);
        }
        {
            const bf16x8 bv = *(const LAS bf16x8*)(Bb + (128 + (lane & 15)) * LQ + ko);
            acc[4] = mfma16(av, bv, acc[4]);
        }
    }
    float rinv[4];
#pragma unroll
    for (int r = 0; r < 4; ++r) {
        const float den = __uint_as_float((unsigned)__builtin_amdgcn_ds_bpermute((lane & 48) * 4, (int)__float_as_uint(acc[4][r])));
        rinv[r] = 1.f / fmaxf(fabsf(den), 1.f);
        float ss = 0.f;
#pragma unroll
        for (int i = 0; i < 4; ++i) { acc[i][r] *= rinv[r]; ss += acc[i][r] * acc[i][r]; }
        ss = row16_sum_f32(ss);
        if ((lane & 15) == 0) ssqS[ng * 64 + mt * 16 + (lane >> 4) * 4 + r] = ss;
    }
    __syncthreads();
    bf16_t* mix = (bf16_t*)(a.ws + WS_C);
    const float* gmh = a.in[I_GMHEAD];
#pragma unroll
    for (int r = 0; r < 4; ++r) {
        const int t = mt * 16 + (lane >> 4) * 4 + r;
        const float rn = rsqrtf((ssqS[t] + ssqS[64 + t]) * (1.f / 128.f) + EPS);
#pragma unroll
        for (int i = 0; i < 4; ++i) {
            const int v = (ng * 4 + i) * 16 + (lane & 15);
            const float mo = bf2f(mo_pre[r][i]);
            mix[(size_t)(row0 + t) * D + h * 128 + v] = f2bf(acc[i][r] * rn * gmh[h * 128 + v] * sigmoidf_(mo));
        }
    }
    __syncthreads();
}

constexpr int LV = 264;
__device__ __forceinline__ void swa_task(const Args& a, LAS unsigned char* lds, int task) {
    const int tid = threadIdx.x, lane = tid & 63, wave = tid >> 6;
    const int b = task >> 7, kvh = (task >> 6) & 1, blk = task & 63, qh = kvh * 4 + (wave >> 1);
    const int rowq0 = b * SEQ + blk * 128;
    const bf16_t* proj = (const bf16_t*)(a.ws + WS_A);
    LAS bf16_t* Ksm = (LAS bf16_t*)lds;
    LAS bf16_t* Vsm = Ksm + 256 * LQ;
    const bf16_t* qbase = proj + (size_t)(rowq0 + 16 * ((wave & 1) * 4) + (lane & 15)) * NPROJ + C_AQ + qh * 64 + 8 * (lane >> 4);
    bf16x8 qn[2];
#pragma unroll
    for (int ks = 0; ks < 2; ++ks) qn[ks] = *(const bf16x8*)(qbase + ks * 32);
    const float sink = a.in[I_SINKS][qh];
    {
        const int j = tid >> 1, half = tid & 1;
        const bool ex = (blk > 0) || (j >= 128);
        u32x4 kv[4], vv[4];
#pragma unroll
        for (int i = 0; i < 4; ++i) { kv[i] = (u32x4){0u, 0u, 0u, 0u}; vv[i] = (u32x4){0u, 0u, 0u, 0u}; }
        if (ex) {
            const bf16_t* kp = proj + (size_t)(rowq0 - 128 + j) * NPROJ + C_AK + kvh * 64 + half * 32;
            const bf16_t* vp = proj + (size_t)(rowq0 - 128 + j) * NPROJ + C_AV + kvh * 64 + half * 32;
#pragma unroll
            for (int i = 0; i < 4; ++i) { kv[i] = *(const u32x4*)(kp + 8 * i); vv[i] = *(const u32x4*)(vp + 8 * i); }
        }
#pragma unroll
        for (int i = 0; i < 4; ++i) {
            *(LAS u32x4*)(Ksm + j * LQ + half * 32 + 8 * i) = kv[i];
            *(LAS u32x4*)(Vsm + j * LQ + half * 32 + 8 * i) = vv[i];
        }
    }
    __syncthreads();
#pragma unroll 1
    for (int qk = 0; qk < 4; ++qk) {
    const int qtile = (wave & 1) * 4 + qk;
    const int qi = 16 * qtile + (lane & 15);
    const bf16x8 qf[2] = {qn[0], qn[1]};
    {
        const int qkn = qk < 3 ? qk + 1 : 3;
#pragma unroll
        for (int ks = 0; ks < 2; ++ks) qn[ks] = *(const bf16x8*)(qbase + (size_t)(16 * qkn) * NPROJ + ks * 32);
    }
    constexpr float L2E8 = 0.125f * 1.44269504088896341f;
    const float sinkl = sink * 1.44269504088896341f;
    const int dj = 4 * (lane >> 4) - (lane & 15);
    f32x4 sc[10];
    float mx = sinkl;
#pragma unroll
    for (int t = 0; t < 9; ++t) {
        const int kt = qtile + t;
        f32x4 acc = {0.f, 0.f, 0.f, 0.f};
#pragma unroll
        for (int ks = 0; ks < 2; ++ks) {
            const bf16x8 kf = *(const LAS bf16x8*)(Ksm + (kt * 16 + (lane & 15)) * LQ + ks * 32 + 8 * (lane >> 4));
            acc = mfma16(kf, qf[ks], acc);
        }
        acc = acc * L2E8;
        if (t == 0) {
#pragma unroll
            for (int r = 0; r < 4; ++r) acc[r] = (dj + r >= 1) ? acc[r] : -INFINITY;
        }
        if (t == 8) {
#pragma unroll
            for (int r = 0; r < 4; ++r) acc[r] = (dj + r <= 0) ? acc[r] : -INFINITY;
        }
        if (blk == 0 && kt < 8) acc = (f32x4){-INFINITY, -INFINITY, -INFINITY, -INFINITY};
#pragma unroll
        for (int r = 0; r < 4; ++r) mx = fmaxf(mx, acc[r]);
        sc[t] = acc;
    }
    mx = fmaxf(mx, __shfl_xor(mx, 16)); mx = fmaxf(mx, __shfl_xor(mx, 32));
    float sum = 0.f;
#pragma unroll
    for (int t = 0; t < 9; ++t)
#pragma unroll
        for (int r = 0; r < 4; ++r) { const float p = __builtin_amdgcn_exp2f(sc[t][r] - mx); sc[t][r] = p; sum += p; }
    sum += __shfl_xor(sum, 16); sum += __shfl_xor(sum, 32);
    const float inv = 1.f / (sum + __builtin_amdgcn_exp2f(sinkl - mx));
    sc[9] = (f32x4){0.f, 0.f, 0.f, 0.f};
    bf16x8 pf[5];
#pragma unroll
    for (int p = 0; p < 5; ++p) {
        const f32x4 x0 = sc[2 * p] * inv, x1 = sc[2 * p + 1] * inv;
        u32x4 w; w.x = pk2(x0[0], x0[1]); w.y = pk2(x0[2], x0[3]); w.z = pk2(x1[0], x1[1]); w.w = pk2(x1[2], x1[3]);
        pf[p] = __builtin_bit_cast(bf16x8, w);
    }
    bf16_t* mix = (bf16_t*)(a.ws + WS_C);
#pragma unroll
    for (int dt = 0; dt < 4; ++dt) {
        f32x4 acc = {0.f, 0.f, 0.f, 0.f};
#pragma unroll
        for (int p = 0; p < 5; ++p) {
            const int k0 = qtile + 2 * p, k1 = (k0 + 1 > 15) ? 15 : k0 + 1;
            const LAS bf16_t* vr = Vsm + (4 * (lane >> 4) + ((lane & 15) >> 2)) * LQ + dt * 16 + 4 * (lane & 3);
            typedef short v4s_t __attribute__((ext_vector_type(4)));
            const u32x2 lo = __builtin_bit_cast(u32x2, __builtin_amdgcn_ds_read_tr16_b64_v4i16((LAS v4s_t*)(vr + k0 * 16 * LQ)));
            const u32x2 hi = __builtin_bit_cast(u32x2, __builtin_amdgcn_ds_read_tr16_b64_v4i16((LAS v4s_t*)(vr + k1 * 16 * LQ)));
            const u32x4 w = {lo.x, lo.y, hi.x, hi.y};
            acc = mfma16(__builtin_bit_cast(bf16x8, w), pf[p], acc);
        }
        u32x2 o; o.x = pk2(acc[0], acc[1]); o.y = pk2(acc[2], acc[3]);
        *(u32x2*)(mix + (size_t)(rowq0 + qi) * D + 512 + qh * 64 + dt * 16 + 4 * (lane >> 4)) = o;
    }
    }
    __syncthreads();
}


#ifndef PEER_HQ_LO
#define PEER_HQ_LO 0
#endif
constexpr int LSK = 136;
__device__ __forceinline__ unsigned f2sort(float f) { const unsigned u = __float_as_uint(f); return u ^ ((unsigned)((int)u >> 31) | 0x80000000u); }
__device__ __forceinline__ float sort2f(unsigned s) { return __uint_as_float((s & 0x80000000u) ? (s ^ 0x80000000u) : ~s); }
__device__ __forceinline__ float sort2f16(unsigned s) { return __uint_as_float(((s & 0x80000000u) ? (s ^ 0x80000000u) : ~s) & 0xffff0000u); }

#define CE_(i, j) { const unsigned hi_ = key[i][r] > key[j][r] ? key[i][r] : key[j][r], lo_ = key[i][r] > key[j][r] ? key[j][r] : key[i][r]; key[i][r] = hi_; key[j][r] = lo_; }
template <int NT>
__device__ __forceinline__ void top16(unsigned (&key)[NT][4], unsigned (&top)[4], int l15) {
    static_assert(NT == 8, "8 keys per lane");
#pragma unroll
    for (int r = 0; r < 4; ++r) {
        CE_(0, 1) CE_(2, 3) CE_(4, 5) CE_(6, 7)
        CE_(0, 2) CE_(1, 3) CE_(4, 6) CE_(5, 7)
        CE_(1, 2) CE_(5, 6)
        CE_(0, 4) CE_(1, 5) CE_(2, 6) CE_(3, 7)
        CE_(2, 4) CE_(3, 5)
        CE_(1, 2) CE_(3, 4) CE_(5, 6)
        top[r] = 0u;
    }
#pragma unroll
    for (int it = 0; it < 16; ++it) {
        unsigned m[4];
#pragma unroll
        for (int r = 0; r < 4; ++r) m[r] = key[0][r];
#pragma unroll
        for (int st = 0; st < 4; ++st)
#pragma unroll
            for (int r = 0; r < 4; ++r) { const unsigned y = dppu(m[r], st); m[r] = m[r] > y ? m[r] : y; }
        const bool rec = (l15 == it);
#pragma unroll
        for (int r = 0; r < 4; ++r) {
            top[r] = rec ? m[r] : top[r];
            const bool own = key[0][r] == m[r];
#pragma unroll
            for (int t = 0; t < 7; ++t) if (t < 15 - it) key[t][r] = own ? key[t + 1][r] : key[t][r];
            if (7 < 15 - it) key[7][r] = own ? 0u : key[7][r];
        }
    }
}
#undef CE_
__device__ __forceinline__ float gelu_erf(float x) { return 0.5f * x * (1.f + erff(x * 0.70710678118654752f)); }

__device__ __forceinline__ void peer_hq_row(const Args& a, int row, int lane, const u32x4 hb0, const u32x4 hb1) {
    float v[16]; float am = 0.f;
    { const unsigned ws_[8] = {hb0.x, hb0.y, hb0.z, hb0.w, hb1.x, hb1.y, hb1.z, hb1.w};
#pragma unroll
      for (int j = 0; j < 8; ++j) { v[2 * j] = bflo(ws_[j]); v[2 * j + 1] = bfhi(ws_[j]); } }
#pragma unroll
    for (int j = 0; j < 16; ++j) am = fmaxf(am, fabsf(v[j]));
    am = row16_max_f32(am);
    const float s1 = am > 0.f ? am * (1.f / 119.f) : 1.f, i1 = 1.f / s1;
    unsigned hh[2] = {0u, 0u}, hl[2] = {0u, 0u};
#pragma unroll
    for (int j = 0; j < 16; ++j) {
        const int qh = (int)rintf(v[j] * i1);
        const int lo = ((qh + 8) & 15) - 8, hi = (qh - lo) >> 4;
        const int g = j >> 3, pos = j & 7, nib = (pos < 4) ? 2 * pos : 2 * (pos - 4) + 1;
        hh[g] |= ((unsigned)hi & 15u) << (4 * nib); hl[g] |= ((unsigned)lo & 15u) << (4 * nib);
    }
    *(u32x2*)(a.ws + WS_HQH + (size_t)row * 512 + 8 * lane) = (u32x2){hh[0], hh[1]};
    *(u32x2*)(a.ws + WS_HQH + 8 * MiB + (size_t)row * 512 + 8 * lane) = (u32x2){hl[0], hl[1]};
    if ((lane & 15) == 0) ((float*)(a.ws + WS_HS))[(size_t)row * 4 + (lane >> 4)] = s1;
}
__device__ __forceinline__ void peer_score_unit(const Args& a, LAS unsigned char* lds, int pm, int hsel) {
    const int tid = threadIdx.x, lane = tid & 63, wave = tid >> 6, l15 = lane & 15, lq = lane >> 4;
    const bf16_t* pq = (const bf16_t*)(a.ws + WS_A);
    LAS u32x2* SEL = (LAS u32x2*)lds;
    const int T0 = pm * 256;
    {
#pragma unroll 1
        for (int hh = 0; hh < 2; ++hh) {
            const int h = hsel, tt = wave + 8 * hh;
            unsigned tc[2][4];
#pragma unroll
            for (int c = 0; c < 2; ++c) {
                unsigned key[8][4];
#pragma unroll
                for (int r = 0; r < 4; ++r) {
                    const u32x4 sv = *(const u32x4*)(pq + (size_t)(T0 + tt * 16 + lq * 4 + r) * 2048 + h * 256 + c * 128 + 8 * l15);
                    const unsigned sw[4] = {sv.x, sv.y, sv.z, sv.w};
#pragma unroll
                    for (int j = 0; j < 4; ++j) {
                        key[2 * j][r] = (sw[j] << 16) | (unsigned)(8 * l15 + 2 * j);
                        key[2 * j + 1][r] = (sw[j] & 0xffff0000u) | (unsigned)(8 * l15 + 2 * j + 1);
                    }
                }
                top16<8>(key, tc[c], l15);
            }
            const int gb = lane & 48;
            int ci[4], cj[4]; bool ok[4];
            ci[0] = 0; cj[0] = l15; ok[0] = true;
            ci[1] = l15; cj[1] = 0; ok[1] = l15 >= 1;
            ci[2] = l15 < 7 ? 1 : (l15 < 11 ? 2 : (l15 < 14 ? 3 : 4)); cj[2] = l15 < 7 ? l15 + 1 : (l15 < 11 ? l15 - 6 : (l15 < 14 ? l15 - 10 : l15 - 13)); ok[2] = true;
            ci[3] = l15 < 3 ? 5 + l15 : 0; cj[3] = 1; ok[3] = l15 < 3;
            unsigned ck[4][4]; int ce[4][4];
#pragma unroll
            for (int r = 0; r < 4; ++r) {
                const unsigned t1 = tc[0][r], t2 = tc[1][r];
                const float v1 = sort2f16(t1), v2 = sort2f16(t2);
                const int i1 = (int)(t1 & 127u), i2 = (int)(t2 & 127u);
#pragma unroll
                for (int sl = 0; sl < 4; ++sl) {
                    const float a1 = __uint_as_float((unsigned)__builtin_amdgcn_ds_bpermute((gb + ci[sl]) * 4, (int)__float_as_uint(v1)));
                    const float a2 = __uint_as_float((unsigned)__builtin_amdgcn_ds_bpermute((gb + cj[sl]) * 4, (int)__float_as_uint(v2)));
                    const int e1 = __builtin_amdgcn_ds_bpermute((gb + ci[sl]) * 4, i1);
                    const int e2 = __builtin_amdgcn_ds_bpermute((gb + cj[sl]) * 4, i2);
                    ce[sl][r] = e1 * 128 + e2;
                    ck[sl][r] = ok[sl] ? ((f2sort(a1 + a2) & ~63u) | (unsigned)(l15 * 4 + sl)) : 0u;
                }
#define CE4_(i, j) { const unsigned hi_ = ck[i][r] > ck[j][r] ? ck[i][r] : ck[j][r], lo_ = ck[i][r] > ck[j][r] ? ck[j][r] : ck[i][r]; ck[i][r] = hi_; ck[j][r] = lo_; }
                CE4_(0, 1) CE4_(2, 3) CE4_(0, 2) CE4_(1, 3) CE4_(1, 2)
#undef CE4_
            }
            unsigned topk[4] = {0u, 0u, 0u, 0u};
#pragma unroll
            for (int it = 0; it < 16; ++it) {
                unsigned m[4];
#pragma unroll
                for (int r = 0; r < 4; ++r) m[r] = ck[0][r];
#pragma unroll
                for (int st = 0; st < 4; ++st)
#pragma unroll
                    for (int r = 0; r < 4; ++r) { const unsigned y = dppu(m[r], st); m[r] = m[r] > y ? m[r] : y; }
                const bool rec = (l15 == it);
#pragma unroll
                for (int r = 0; r < 4; ++r) {
                    topk[r] = rec ? m[r] : topk[r];
                    const bool own = ck[0][r] == m[r];
                    if (0 < 15 - it) ck[0][r] = own ? ck[1][r] : ck[0][r];
                    if (1 < 15 - it) ck[1][r] = own ? ck[2][r] : ck[1][r];
                    if (2 < 15 - it) ck[2][r] = own ? ck[3][r] : ck[2][r];
                    if (3 < 15 - it) ck[3][r] = own ? 0u : ck[3][r];
                }
            }
#pragma unroll
            for (int r = 0; r < 4; ++r) {
                const int own = (int)((topk[r] >> 2) & 15u), slot = (int)(topk[r] & 3u);
                int eid = 0;
#pragma unroll
                for (int sl = 0; sl < 4; ++sl) { const int t = __builtin_amdgcn_ds_bpermute((gb + own) * 4, ce[sl][r]); eid = (slot == sl) ? t : eid; }
                const float ts = sort2f(topk[r] & ~63u);
                const float tmax = row16_max_f32(ts);
                const float p = __expf(ts - tmax);
                const float g = p / row16_sum_f32(p);
                { u32x2 o; o.x = (unsigned)eid; o.y = __float_as_uint(g); SEL[(tt * 16 + lq * 4 + r) * 16 + l15] = o; }
            }
        }
    }
    __syncthreads();
    {
        unsigned* sele = (unsigned*)(a.ws + WS_SELE); float* selg = (float*)(a.ws + WS_SELG);
        for (int i = tid; i < 256 * 16; i += NTHREADS) { const u32x2 o = SEL[i]; const size_t gi = (size_t)(T0 + (i >> 4)) * 128 + hsel * 16 + (i & 15); sele[gi] = o.x << 7; selg[gi] = __uint_as_float(o.y); }
    }
    __syncthreads();
}
struct PeerSplit { int p0, pstep, trank, tn; };
__device__ __forceinline__ PeerSplit peer_split() {
    PeerSplit s; const int G = gridDim.x;
    if ((G & 7) == 0) { s.p0 = blockIdx.x & 7; s.pstep = 8; s.trank = blockIdx.x >> 3; s.tn = G >> 3; }
    else { s.p0 = 0; s.pstep = 1; s.trank = blockIdx.x; s.tn = G; }
    return s;
}
struct PeerSplit4 { int p0, pstep, trank, tn; };
__device__ __forceinline__ PeerSplit4 peer_split4() {
    PeerSplit4 s; const int G = gridDim.x;
    if ((G & 3) == 0) { s.p0 = blockIdx.x & 3; s.pstep = 4; s.trank = blockIdx.x >> 2; s.tn = G >> 2; }
    else { s.p0 = 0; s.pstep = 1; s.trank = blockIdx.x; s.tn = G; }
    return s;
}
__device__ __forceinline__ void peer_down(const Args& a, LAS unsigned char* lds) {
    const int lane = threadIdx.x & 63, wave = threadIdx.x >> 6;
    const PeerSplit4 sp = peer_split4();
    const unsigned* sele = (const unsigned*)(a.ws + WS_SELE);
    const float* hs = (const float*)(a.ws + WS_HS);
    LAS unsigned* stage = (LAS unsigned*)(lds + wave * 512);
    const LAS u32x4* stq = (const LAS u32x4*)(lds + wave * 512 + 64 * (lane >> 3));
    const unsigned loff = 16u * (lane & 7);
    const int t0 = sp.trank * NWAVES + wave, tstep = sp.tn * NWAVES;
    const bool b2 = lane & 4, b1 = lane & 2, b0 = lane & 1;
    for (int p = sp.p0; p < 4; p += sp.pstep) {
        const unsigned char* EDp = a.ws + WS_ED + (size_t)p * (16384 * 128);
        unsigned* part = (unsigned*)(a.ws + WS_PART) + (size_t)p * MTOK * 64 + lane;
        const unsigned char* hqh = a.ws + WS_HQH + 128 * p + 16 * (lane & 7);
        if (t0 >= MTOK) continue;
        unsigned e0n = sele[(size_t)t0 * 128 + lane], e1n = sele[(size_t)t0 * 128 + 64 + lane];
        stage[lane] = e0n; stage[64 + lane] = e1n;
        u32x4 en[4];
#pragma unroll
        for (int k = 0; k < 4; ++k) en[k] = stq[k];
        u32x4 hAn = *(const u32x4*)(hqh + (size_t)t0 * 512), hBn = *(const u32x4*)(hqh + 8 * MiB + (size_t)t0 * 512); float s1n = hs[(size_t)t0 * 4 + p];
        { const int tc = min(t0 + tstep, MTOK - 1); e0n = sele[(size_t)tc * 128 + lane]; e1n = sele[(size_t)tc * 128 + 64 + lane]; }
        for (int t = t0; t < MTOK; t += tstep) {
            const u32x4 hA = hAn, hB = hBn; const float s1 = s1n;
            u32x4 x[16];
#pragma unroll
            for (int i = 0; i < 16; ++i) x[i] = *(const u32x4*)(EDp + (en[i >> 2][i & 3] + loff));
            __builtin_amdgcn_sched_barrier(0);
            stage[lane] = e0n; stage[64 + lane] = e1n;
#pragma unroll
            for (int k = 0; k < 4; ++k) en[k] = stq[k];
            { const int tc = min(t + tstep, MTOK - 1); hAn = *(const u32x4*)(hqh + (size_t)tc * 512); hBn = *(const u32x4*)(hqh + 8 * MiB + (size_t)tc * 512); s1n = hs[(size_t)tc * 4 + p]; }
            { const int tc = min(t + 2 * tstep, MTOK - 1); e0n = sele[(size_t)tc * 128 + lane]; e1n = sele[(size_t)tc * 128 + 64 + lane]; }
            __builtin_amdgcn_sched_barrier(0);
            int v[16];
#pragma unroll
            for (int i = 0; i < 16; ++i) {
                int ah = 0, al = 0;
#pragma unroll
                for (int d = 0; d < 4; ++d) {
                    ah = __builtin_amdgcn_sdot8((int)x[i][d], (int)hA[d], ah, false);
                    al = __builtin_amdgcn_sdot8((int)x[i][d], (int)hB[d], al, false);
                }
                v[i] = (ah << 4) + al;
            }
            int m[2];
#pragma unroll
            for (int hf = 0; hf < 2; ++hf) {
                int k4[4], k2[2];
#pragma unroll
                for (int j = 0; j < 4; ++j) k4[j] = (b2 ? v[8 * hf + 4 + j] : v[8 * hf + j]) + (int)dppu((unsigned)(b2 ? v[8 * hf + j] : v[8 * hf + 4 + j]), 2);
#pragma unroll
                for (int j = 0; j < 2; ++j) k2[j] = (b1 ? k4[2 + j] : k4[j]) + (int)dppu((unsigned)(b1 ? k4[j] : k4[2 + j]), 1);
                m[hf] = (b0 ? k2[1] : k2[0]) + (int)dppu((unsigned)(b0 ? k2[0] : k2[1]), 0);
            }
            part[(size_t)t * 64] = pk2((float)m[0] * s1, (float)m[1] * s1);
        }
    }
}
__device__ __forceinline__ float wave_max_dpp(float x) {
    x = row16_max_f32(x);
    const int xi = (int)__float_as_uint(x);
    const float r0 = __uint_as_float((unsigned)__builtin_amdgcn_readlane(xi, 0)), r1 = __uint_as_float((unsigned)__builtin_amdgcn_readlane(xi, 16));
    const float r2 = __uint_as_float((unsigned)__builtin_amdgcn_readlane(xi, 32)), r3 = __uint_as_float((unsigned)__builtin_amdgcn_readlane(xi, 48));
    return fmaxf(fmaxf(r0, r1), fmaxf(r2, r3));
}
__device__ __forceinline__ float wave_sum_dpp(float x) {
    x = row16_sum_f32(x);
    const int xi = (int)__float_as_uint(x);
    const float r0 = __uint_as_float((unsigned)__builtin_amdgcn_readlane(xi, 0)), r1 = __uint_as_float((unsigned)__builtin_amdgcn_readlane(xi, 16));
    const float r2 = __uint_as_float((unsigned)__builtin_amdgcn_readlane(xi, 32)), r3 = __uint_as_float((unsigned)__builtin_amdgcn_readlane(xi, 48));
    return (r0 + r1) + (r2 + r3);
}
__device__ __forceinline__ unsigned or_bits34(unsigned w) {
    w |= (unsigned)__builtin_amdgcn_update_dpp(0, (int)w, 0x128, 0xF, 0xF, true);
    const auto r = __builtin_amdgcn_permlane16_swap(w, w, false, false);
    return r[0] | r[1];
}
__device__ __forceinline__ void peer_coef(const Args& a) {
    const int lane = threadIdx.x & 63, wave = threadIdx.x >> 6;
    const unsigned* sele = (const unsigned*)(a.ws + WS_SELE); const float* selg = (const float*)(a.ws + WS_SELG);
    const unsigned* part = (const unsigned*)(a.ws + WS_PART);
    const float* esc = (const float*)(a.ws + WS_ESC);
    const float* r2g = (const float*)(a.ws + WS_R2);
    unsigned* coefd = (unsigned*)(a.ws + WS_COEF);
    const int tstep = gridDim.x * NWAVES;
    const int eoff = 16 * (lane >> 3) + (lane & 7);
    const int sh = 8 * ((lane >> 3) & 3);
    for (int tb = blockIdx.x * NWAVES + wave; tb < MTOK; tb += 8 * tstep) {
        unsigned pw[8][4], ee[8][2]; float gg[8][2], r2[8];
#pragma unroll
        for (int u = 0; u < 8; ++u) {
            const int t = min(tb + u * tstep, MTOK - 1);
#pragma unroll
            for (int p = 0; p < 4; ++p) pw[u][p] = __builtin_nontemporal_load(part + (size_t)p * MTOK * 64 + (size_t)t * 64 + lane);
#pragma unroll
            for (int h = 0; h < 2; ++h) { const size_t i = (size_t)t * 128 + eoff + 8 * h; ee[u][h] = sele[i] >> 7; gg[u][h] = __builtin_nontemporal_load(selg + i); }
            r2[u] = r2g[t];
        }
        float sd[8][2], su[8][2];
#pragma unroll
        for (int u = 0; u < 8; ++u)
#pragma unroll
            for (int h = 0; h < 2; ++h) { sd[u][h] = esc[ee[u][h]]; su[u][h] = esc[16384 + ee[u][h]]; }
#pragma unroll
        for (int u = 0; u < 8; ++u) {
            const int t = tb + u * tstep;
            float c[2], s[2] = {0.f, 0.f};
#pragma unroll
            for (int p = 0; p < 4; ++p) { s[0] += bflo(pw[u][p]); s[1] += bfhi(pw[u][p]); }
#pragma unroll
            for (int h = 0; h < 2; ++h) c[h] = s[h] * r2[u] * sd[u][h];
            { const pg8::f32x2 ge = pg8::gelu_pk((pg8::f32x2){c[0], c[1]}); c[0] = gg[u][0] * ge.x * su[u][0]; c[1] = gg[u][1] * ge.y * su[u][1]; }
            float cm = fmaxf(fabsf(c[0]), fabsf(c[1]));
            cm = wave_max_dpp(cm);
            const float sc = cm > 0.f ? cm * (1.f / 127.f) : 1.f, inv = 1.f / sc;
            unsigned w0 = ((unsigned)((int)rintf(c[0] * inv) & 255)) << sh, w1 = ((unsigned)((int)rintf(c[1] * inv) & 255)) << sh;
            w0 = or_bits34(w0); w1 = or_bits34(w1);
            const float qs = wave_sum_dpp(rintf(c[0] * inv) + rintf(c[1] * inv));
            if (t < MTOK) {
                if ((lane & 24) == 0) { const int wi = 2 * (lane & 7) + (lane >> 5); coefd[(size_t)t * 32 + wi] = w0; coefd[(size_t)t * 32 + 16 + wi] = w1; }
                if (lane == 0) { ((float*)(a.ws + WS_CS))[t] = sc; ((float*)(a.ws + WS_CSUM))[t] = qs; }
            }
        }
    }
}
__device__ __forceinline__ void peer_up(const Args& a, LAS unsigned char* lds) {
    typedef int v2i_t __attribute__((ext_vector_type(2)));
    const int lane = threadIdx.x & 63, wave = threadIdx.x >> 6;
    const PeerSplit4 sp = peer_split4();
    const unsigned* sele = (const unsigned*)(a.ws + WS_SELE);
    const unsigned* coefd = (const unsigned*)(a.ws + WS_COEF) + (lane & 31);
    const float* csg = (const float*)(a.ws + WS_CS);
    const float* csumg = (const float*)(a.ws + WS_CSUM);
    LAS unsigned char* buf = lds + wave * 16384;
    const unsigned m0base = (unsigned)__builtin_amdgcn_readfirstlane((int)(unsigned)(__UINTPTR_TYPE__)buf);
    LAS unsigned* stage = (LAS unsigned*)(lds + 131072 + wave * 512);
    const LAS u32x4* stq = (const LAS u32x4*)(lds + 131072 + wave * 512 + 64 * (lane >> 3));
    const unsigned loff = 16u * ((lane & 7) ^ ((lane >> 4) & 3));
    const int G_ = lane >> 4, j_ = lane & 15, q_ = j_ >> 1, c0 = 4 * (G_ & 1) + 2 * (G_ >> 1);
    const LAS unsigned char* tr0 = buf + 128 * q_ + 8 * (j_ & 1) + 16 * (c0 ^ (q_ >> 1));
    const LAS unsigned char* tr1 = buf + 128 * q_ + 8 * (j_ & 1) + 16 * ((c0 ^ (q_ >> 1)) ^ 1);
    const int d0 = 16 * c0 + j_;
    const int t0 = sp.trank * NWAVES + wave, tstep = sp.tn * NWAVES;
#define UP_DMA8(E, i0) { _Pragma("unroll") for (int i_ = 0; i_ < 8; ++i_) \
        asm volatile("s_mov_b32 m0, %0\n\ts_nop 0\n\tglobal_load_lds_dwordx4 %1, %2" :: "s"(m0base + 1024u * ((i0) + i_)), "v"(E[((i0) + i_) >> 2][i_ & 3] + loff), "s"(EUp) : "memory", "m0"); }
#define UP_HALF(i0) { _Pragma("unroll") for (int i_ = (i0); i_ < (i0) + 8; ++i_) { \
        const int ca = __builtin_amdgcn_readlane((int)cw, 2 * i_), cb = __builtin_amdgcn_readlane((int)cw, 2 * i_ + 1); \
        const v2i_t r0 = __builtin_amdgcn_ds_read_tr8_b64_v2i32((LAS v2i_t*)(tr0 + 1024 * i_)); \
        const v2i_t r1 = __builtin_amdgcn_ds_read_tr8_b64_v2i32((LAS v2i_t*)(tr1 + 1024 * i_)); \
        ae0 = __builtin_amdgcn_sdot4(r0[0] & 0x0F0F0F0F, ca, ae0, false); ae0 = __builtin_amdgcn_sdot4(r0[1] & 0x0F0F0F0F, cb, ae0, false); \
        ao0 = __builtin_amdgcn_sdot4(r0[0], ca, ao0, false); ao0 = __builtin_amdgcn_sdot4(r0[1], cb, ao0, false); \
        ae1 = __builtin_amdgcn_sdot4(r1[0] & 0x0F0F0F0F, ca, ae1, false); ae1 = __builtin_amdgcn_sdot4(r1[1] & 0x0F0F0F0F, cb, ae1, false); \
        ao1 = __builtin_amdgcn_sdot4(r1[0], ca, ao1, false); ao1 = __builtin_amdgcn_sdot4(r1[1], cb, ao1, false); } }
    for (int p = sp.p0; p < 4; p += sp.pstep) {
        const unsigned char* EUp = a.ws + WS_EU + (size_t)p * (16384 * 128);
        const unsigned* hbase = (const unsigned*)(a.ws + WS_B) + 128 * p + d0;
        unsigned* h3base = (unsigned*)(a.ws + WS_H3) + 128 * p + d0;
        if (t0 >= MTOK) continue;
        unsigned e0n = sele[(size_t)t0 * 128 + lane], e1n = sele[(size_t)t0 * 128 + 64 + lane];
        stage[lane] = e0n; stage[64 + lane] = e1n;
        u32x4 en[4], enn[4];
#pragma unroll
        for (int k = 0; k < 4; ++k) en[k] = stq[k];
        unsigned cwn = coefd[(size_t)t0 * 32]; float csn = csg[t0], cqn = csumg[t0];
        unsigned h2n[2];
#pragma unroll
        for (int k = 0; k < 2; ++k) h2n[k] = hbase[(size_t)t0 * (D / 2) + 16 * k];
        { const int tc = min(t0 + tstep, MTOK - 1); e0n = sele[(size_t)tc * 128 + lane]; e1n = sele[(size_t)tc * 128 + 64 + lane]; }
        asm volatile("s_waitcnt vmcnt(0) lgkmcnt(0)" ::: "memory");
        UP_DMA8(en, 0)
        for (int t = t0; t < MTOK; t += tstep) {
            const unsigned cw = cwn; const float cs = csn, cq = cqn;
            const unsigned h2c[2] = {h2n[0], h2n[1]};
            stage[lane] = e0n; stage[64 + lane] = e1n;
#pragma unroll
            for (int k = 0; k < 4; ++k) enn[k] = stq[k];
            __builtin_amdgcn_sched_barrier(0);
            UP_DMA8(en, 8)
            asm volatile("s_waitcnt vmcnt(8)" ::: "memory");
            __builtin_amdgcn_sched_barrier(0);
            { const int tc = min(t + tstep, MTOK - 1); cwn = coefd[(size_t)tc * 32]; csn = csg[tc]; cqn = csumg[tc];
#pragma unroll
              for (int k = 0; k < 2; ++k) h2n[k] = hbase[(size_t)tc * (D / 2) + 16 * k]; }
            { const int tc = min(t + 2 * tstep, MTOK - 1); e0n = sele[(size_t)tc * 128 + lane]; e1n = sele[(size_t)tc * 128 + 64 + lane]; }
            int ae0 = 0, ao0 = 0, ae1 = 0, ao1 = 0;
            UP_HALF(0)
            asm volatile("s_waitcnt lgkmcnt(0)" ::: "memory");
            __builtin_amdgcn_sched_barrier(0);
            UP_DMA8(enn, 0)
            asm volatile("s_waitcnt vmcnt(8)" ::: "memory");
            __builtin_amdgcn_sched_barrier(0);
            UP_HALF(8)
            const float bias = 8.f * cq, cs16 = cs * 0.0625f;
            unsigned* h3row = h3base + (size_t)t * (D / 2);
            h3row[0] = pk2(bflo(h2c[0]) + ((float)ae0 - bias) * cs, bfhi(h2c[0]) + (float)(ao0 - ae0) * cs16);
            h3row[16] = pk2(bflo(h2c[1]) + ((float)ae1 - bias) * cs, bfhi(h2c[1]) + (float)(ao1 - ae1) * cs16);
            asm volatile("s_waitcnt lgkmcnt(0)" ::: "memory");
            __builtin_amdgcn_sched_barrier(0);
#pragma unroll
            for (int k = 0; k < 4; ++k) en[k] = enn[k];
        }
        asm volatile("s_waitcnt vmcnt(0)" ::: "memory");
    }
#undef UP_HALF
#undef UP_DMA8
}
__device__ __forceinline__ void peer_final(const Args& a) {
    const int lane = threadIdx.x & 63, wave = threadIdx.x >> 6;
    const float* gf = a.in[I_GFINAL];
    f32x4 gv[4];
#pragma unroll
    for (int j = 0; j < 4; ++j) gv[j] = *(const f32x4*)(gf + 4 * lane + 256 * j);
    for (int tb = (blockIdx.x * NWAVES + wave) * 4; tb < MTOK; tb += gridDim.x * NWAVES * 4) {
        const bf16_t* hrow = (const bf16_t*)(a.ws + WS_H3) + (size_t)tb * D + 4 * lane;
        float* orow = a.out + (size_t)tb * D + 4 * lane;
        u32x2 hb[4][4];
#pragma unroll
        for (int u = 0; u < 4; ++u)
#pragma unroll
            for (int j = 0; j < 4; ++j) hb[u][j] = __builtin_nontemporal_load((const u32x2*)(hrow + (size_t)u * D + 256 * j));
        float s[4];
#pragma unroll
        for (int u = 0; u < 4; ++u) { s[u] = 0.f;
#pragma unroll
            for (int j = 0; j < 4; ++j) { const float v0 = bflo(hb[u][j].x), v1 = bfhi(hb[u][j].x), v2 = bflo(hb[u][j].y), v3 = bfhi(hb[u][j].y); s[u] += v0 * v0 + v1 * v1 + v2 * v2 + v3 * v3; } }
#pragma unroll
        for (int u = 0; u < 4; ++u) s[u] = wave_sum(s[u]);
#pragma unroll
        for (int u = 0; u < 4; ++u) {
            const float r3 = rsqrtf(s[u] * (1.f / D) + EPS);
#pragma unroll
            for (int j = 0; j < 4; ++j) { const f32x4 v = (f32x4){bflo(hb[u][j].x), bfhi(hb[u][j].x), bflo(hb[u][j].y), bfhi(hb[u][j].y)};
                __builtin_nontemporal_store(v * r3 * gv[j], (f32x4*)(orow + (size_t)u * D + 256 * j)); }
        }
    }
}
__device__ __forceinline__ void peer_fold_task(const Args& a, int task) {
    const int lane = threadIdx.x & 63, wave = threadIdx.x >> 6, l15 = lane & 15, lq = lane >> 4;
    const int hc = task >> 2, c = hc & 1, k0 = (task & 3) * 256 + wave * 32;
    const bf16_t* wgr = (const bf16_t*)(a.ws + WS_WGR);
    const bf16_t* sk = (const bf16_t*)(a.ws + WS_SK) + (size_t)c * 128 * 128;
    bf16_t* btp = (bf16_t*)(a.ws + WS_WPQ);
    f32x4 acc[2][8];
#pragma unroll
    for (int mt = 0; mt < 2; ++mt)
#pragma unroll
        for (int nt = 0; nt < 8; ++nt) acc[mt][nt] = (f32x4){0.f, 0.f, 0.f, 0.f};
#pragma unroll
    for (int ks = 0; ks < 4; ++ks) {
        bf16x8 af[2];
#pragma unroll
        for (int mt = 0; mt < 2; ++mt) af[mt] = *(const bf16x8*)(wgr + (size_t)(k0 + mt * 16 + l15) * 2048 + hc * 128 + ks * 32 + 8 * lq);
#pragma unroll
        for (int nt = 0; nt < 8; ++nt) {
            const bf16x8 bv = *(const bf16x8*)(sk + (size_t)(nt * 16 + l15) * 128 + ks * 32 + 8 * lq);
#pragma unroll
            for (int mt = 0; mt < 2; ++mt) acc[mt][nt] = mfma16(af[mt], bv, acc[mt][nt]);
        }
    }
#pragma unroll
    for (int mt = 0; mt < 2; ++mt)
#pragma unroll
        for (int nt = 0; nt < 8; ++nt) {
            u32x2 o; o.x = pk2(acc[mt][nt][0], acc[mt][nt][1]); o.y = pk2(acc[mt][nt][2], acc[mt][nt][3]);
            *(u32x2*)(btp + (size_t)(hc * 128 + nt * 16 + l15) * 1024 + k0 + mt * 16 + 4 * lq) = o;
        }
}

#define XB_TMO      128
#define XB_XCNT(j)  (256  + 64 * (j))
#define XB_XSUB(j)  (1280 + 64 * (j))
#define XB_XGEN(j)  (2304 + 64 * (j))
#define XB_TOP      3328
#define XB_TOPGEN   3392
#define XCD_BAR_WORDS 3456
#define XB_SPIN_CAP (1u << 22)
__device__ __forceinline__ unsigned xb_ld(unsigned* p)              { return __hip_atomic_load(p, __ATOMIC_RELAXED, __HIP_MEMORY_SCOPE_AGENT); }
__device__ __forceinline__ unsigned xb_add(unsigned* p, unsigned v) { return __hip_atomic_fetch_add(p, v, __ATOMIC_RELAXED, __HIP_MEMORY_SCOPE_AGENT); }
__device__ __forceinline__ unsigned xb_xcc_id() { return (unsigned)__builtin_amdgcn_s_getreg((3 << 11) | 20) & 0xFu; }
#define XB_SPIN(cond, bar) do { unsigned _sp = 0; while (cond) { __builtin_amdgcn_s_sleep(1); \
    if ((++_sp & 255u) == 0u) { if (xb_ld(&(bar)[XB_TMO])) break; if (_sp > XB_SPIN_CAP) { atomicAdd(&(bar)[XB_TMO], 1u); break; } } } } while (0)
struct XcdBarrier { unsigned* bar; unsigned x; volatile LAS unsigned* st; };
__device__ __forceinline__ XcdBarrier xcd_barrier_post(unsigned* bar, volatile LAS unsigned* st) {
    XcdBarrier b; b.bar = bar; b.x = xb_xcc_id(); b.st = st;
    if (threadIdx.x == 0) (void)xb_add(&bar[XB_XCNT(b.x)], 1u);
    return b;
}
__device__ __forceinline__ void xcd_barrier_complete(unsigned* bar, unsigned x, unsigned& nloc, unsigned& nx) {
    const unsigned G = gridDim.x * gridDim.y * gridDim.z;
    unsigned sum, cnt, mine, sp = 0u;
    for (;;) {
        sum = 0u; cnt = 0u; mine = 0u;
#pragma unroll
        for (unsigned j = 0; j < 16; ++j) { const unsigned c = xb_ld(&bar[XB_XCNT(j)]); sum += c; cnt += (c > 0u) ? 1u : 0u; mine = (j == x) ? c : mine; }
        if (sum == G) break;
        __builtin_amdgcn_s_sleep(1);
        if ((++sp & 255u) == 0u) { if (xb_ld(&bar[XB_TMO])) break; if (sp > XB_SPIN_CAP) { atomicAdd(&bar[XB_TMO], 1u); break; } }
    }
    nloc = mine > 0u ? mine : 1u; nx = cnt > 0u ? cnt : 1u;
}
__device__ __forceinline__ void xcd_barrier(const XcdBarrier& b) {
    asm volatile("s_waitcnt vmcnt(0)" ::: "memory");
    __syncthreads();
    if (threadIdx.x == 0) {
        unsigned* bar = b.bar;
        __builtin_amdgcn_s_waitcnt(0);
        unsigned nloc = b.st[0], nx = b.st[1];
        if (nloc == 0u) { xcd_barrier_complete(bar, b.x, nloc, nx); b.st[0] = nloc; b.st[1] = nx; }
        unsigned old;
        { unsigned* px = &bar[XB_XSUB(b.x)];
          asm volatile("global_atomic_add %0, %1, %2, off sc0\n\tbuffer_inv sc1\n\ts_waitcnt vmcnt(1)" : "=&v"(old) : "v"(px), "v"(1u) : "memory"); }
        const unsigned gen = old / nloc;
        if (old + 1u == (gen + 1u) * nloc) {
            __builtin_amdgcn_fence(__ATOMIC_RELEASE, "agent");
            asm volatile("s_waitcnt vmcnt(0)" ::: "memory");
            (void)xb_add(&bar[XB_TOP], 1u);
        }
        XB_SPIN(xb_ld(&bar[XB_TOP]) < (gen + 1u) * nx, bar);
        asm volatile("s_waitcnt vmcnt(0)" ::: "memory");
    }
    __syncthreads();
}


#ifndef FUSE_SCORE
#define FUSE_SCORE 1
#endif
constexpr int NPHASES = 15;
__global__ __launch_bounds__(NTHREADS, 2) void hybrid_fwd(Args a) {
    extern __shared__ __attribute__((aligned(16))) unsigned char smem[];
    LAS unsigned char* lds = (LAS unsigned char*)smem;
    volatile LAS unsigned* xbw = (volatile LAS unsigned*)(lds + LDS_BYTES - 16);
    unsigned char* ws = a.ws;
    const int G = gridDim.x;
    if (threadIdx.x == 0) { xbw[0] = 0u; xbw[1] = 0u; xbw[2] = 0u; xbw[3] = 0u; }
    __syncthreads();
    XcdBarrier xb; xb.bar = (unsigned*)(ws + WS_BAR); xb.x = 0; xb.st = xbw;
    const bool multi = (a.ph_hi - a.ph_lo) > 1;
    if (multi) xb = xcd_barrier_post((unsigned*)(ws + WS_BAR), xbw);
#define PHON(n) 1
#define PH_BEGIN(n) if (PHON(n) && a.ph_lo <= (n) && (n) < a.ph_hi) { auto body_ = [&]() __attribute__((always_inline)) {
#define PH_END(n) }; body_(); if ((n) + 1 < a.ph_hi) xcd_barrier(xb); }
    PH_BEGIN(0) phase0(a, lds); PH_END(0)
    PH_BEGIN(1)
        const int cv_lo = (G > 160) ? 80 : 0;
        const bool cv_on = (int)blockIdx.x >= cv_lo, cv_first = cv_on && (((int)blockIdx.x - cv_lo) & 1) == 0;
        if (cv_first) { p0_experts(a, blockIdx.x - cv_lo, G - cv_lo); __syncthreads(); }
        { pg8::Gemm g{(const bf16_t*)(ws + WS_XB), (const bf16_t*)(ws + WS_WIN), MTOK, NPROJ, D};
          pg8::StaticOrder S; S.init(g.M, g.N, G, blockIdx.x);
          EpiRowBf16 E{(bf16_t*)(ws + WS_A), NPROJ, (const float*)(ws + WS_RX), 1.0f};
          pg8::gemm_phase<EpiRowBf16, pg8::StaticOrder, false>(lds, g, S, E, nullptr); }
        { pg8::Gemm g{(const bf16_t*)(ws + WS_C), (const bf16_t*)(ws + WS_WXKV), NB * MEMLEN, 2048, D};
          pg8::StaticOrder S; S.init(g.M, g.N, G, (blockIdx.x + G - (64 % G)) % G);
          EpiKV E{(bf16_t*)(ws + WS_KMEM), (bf16_t*)(ws + WS_VTMEM)};
          pg8::gemm_phase<EpiKV, pg8::StaticOrder, false>(lds, g, S, E, nullptr); }
        if (cv_on && !cv_first) p0_experts(a, blockIdx.x - cv_lo, G - cv_lo);
    PH_END(1)
    PH_BEGIN(2)
        {
            int t = blockIdx.x;
            MlIn cur, nxt;
            mlstm_local_load(a, min(t, 1023), cur);
            for (; t < 1024; t += G) {
                mlstm_local_load(a, min(t + G, 1023), nxt);
                mlstm_local(a, lds, t, cur, t == (int)blockIdx.x);
                cur = nxt;
            }
            for (; t < 1280; t += G) swa_task(a, lds, t - 1024);
        }
    PH_END(2)
    PH_BEGIN(3) p0_late_transposes(a, lds); mlstm_scan(a); PH_END(3)
    PH_BEGIN(4)
        {
            for (int fu = blockIdx.x; fu < 128; fu += G) {
                if (fu < 64) {
                    const int j = fu >> 2, bh = j & 7, b = bh >> 2, h = bh & 3;
                    const bf16_t* Kh = (const bf16_t*)(ws + WS_KMEM) + (size_t)bh * 65536; const bf16_t* Vh = (const bf16_t*)(ws + WS_VTMEM) + (size_t)bh * 65536;
                    const bf16_t* WqR = (const bf16_t*)(ws + WS_WXQ) + (size_t)h * 1024 * 256; const bf16_t* WoR = (const bf16_t*)(ws + WS_WXO) + (size_t)h * 1024 * 256;
                    pg8::Gemm g{}; EpiRowBf16 E{nullptr, 1024, nullptr, 1.0f};
                    if (j < 8) { g.A = Kh; g.Bt = WqR; g.M = 256; g.N = 1024; g.K = 256; E.O = (bf16_t*)(ws + WS_WXKV) + ((size_t)b * 1024 + h * 256) * 1024; }
                    else { g.A = WoR; g.Bt = Vh; g.M = 1024; g.N = 256; g.K = 256; E.O = (bf16_t*)(ws + WS_BTO) + (size_t)b * 1024 * 1024 + h * 256; }
                    pg8::StaticOrder S; S.init(g.M, g.N, 4, fu & 3);
                    pg8::gemm_phase<EpiRowBf16, pg8::StaticOrder, false>(lds, g, S, E, nullptr);
                } else peer_fold_task(a, fu - 64);
                __syncthreads();
            }
            __syncthreads();
        }
        for (int t = blockIdx.x; t < 1024; t += G) mlstm_out(a, lds, t, t == (int)blockIdx.x);
    PH_END(4)
    PH_BEGIN(5)
        {
            const int lane = threadIdx.x & 63;
            for (int r = blockIdx.x * NWAVES + (threadIdx.x >> 6); r < 2048; r += G * NWAVES) {
                const float sc = row_to_i8((const bf16_t*)(ws + WS_WPQ) + (size_t)r * D, ws + WS_BTP8 + (size_t)r * D, lane);
                if (lane == 0) ((float*)(ws + WS_BTP8 + 2 * MiB))[r] = sc;
            }
        }
        { pg8::Gemm g{(const bf16_t*)(ws + WS_C), (const bf16_t*)(ws + WS_WOUT), MTOK, D, D};
          pg8::StaticOrder S; S.init(g.M, g.N, G, blockIdx.x);
          EpiResid<true> E{(const void*)(ws + WS_XB), (bf16_t*)(ws + WS_B), (float*)(ws + WS_SSQ)};
          pg8::gemm_phase<EpiResid<true>, pg8::StaticOrder, false>(lds, g, S, E, nullptr); } PH_END(5)
    PH_BEGIN(6) { pg8::Gemm g{(const bf16_t*)(ws + WS_B), (const bf16_t*)(ws + WS_WXKV), MTOK, D, D, 32, (size_t)1024 * 1024 * 2};
          EpiSoftmax E{(bf16_t*)(ws + WS_A), (const float*)(ws + WS_R1)};
          for (int L = blockIdx.x; L < (MTOK / 256) * (D / 256); L += G) {
              pg8::StaticOrder S; S.init(g.M, g.N, (MTOK / 256) * (D / 256), L);
              { pg8::Unit u0; if (S.next(0, u0) && threadIdx.x < 256) ((float*)(ws + WS_R1))[u0.pm * 256 + threadIdx.x] = row_rscale((const float*)(ws + WS_SSQ), u0.pm * 256 + threadIdx.x); }
              asm volatile("s_waitcnt vmcnt(0)" ::: "memory"); __syncthreads();
              pg8::gemm_phase<EpiSoftmax, pg8::StaticOrder, false>(lds, g, S, E, nullptr);
          } } PH_END(6)
    PH_BEGIN(8) { pg8::Gemm g{(const bf16_t*)(ws + WS_A), (const bf16_t*)(ws + WS_BTO), MTOK, D, D, 32, (size_t)1024 * 1024 * 2};
          pg8::StaticOrder S; S.init(g.M, g.N, G, blockIdx.x);
          EpiResid<true> E{(const void*)(ws + WS_B), (bf16_t*)(ws + WS_B), (float*)(ws + WS_SSQ)};
          pg8::gemm_phase<EpiResid<true>, pg8::StaticOrder, false>(lds, g, S, E, nullptr); } PH_END(8)
    PH_BEGIN(10)
        {
            const int lane = threadIdx.x & 63;
            const bool xmap = (G == 256);
            const int bsel = xmap ? ((int)(blockIdx.x & 7) * 32 + (int)(blockIdx.x >> 3)) : (int)blockIdx.x;
            for (int rbase = (bsel * NWAVES + (threadIdx.x >> 6)) * 8; rbase < MTOK; rbase += G * NWAVES * 8) {
                const float r2v = row_rscale((const float*)(ws + WS_SSQ), rbase + (lane & 7));
                u32x4 a0[8], a1[8];
#pragma unroll
                for (int j = 0; j < 8; ++j) { const bf16_t* src = (const bf16_t*)(ws + WS_B) + (size_t)(rbase + j) * D + 16 * lane; a0[j] = *(const u32x4*)src; a1[j] = *(const u32x4*)(src + 8); }
#pragma unroll
                for (int j = 0; j < 8; ++j) {
                    const int row = rbase + j;
                    const float sc = row_to_i8_finish(a0[j], a1[j], ws + WS_HQ8 + (size_t)row * D, lane);
                    peer_hq_row(a, row, lane, a0[j], a1[j]);
                    const float r2 = __shfl(r2v, j);
                    if (lane == 0) { ((float*)(ws + WS_R2))[row] = r2; ((float*)(ws + WS_SA8))[row] = sc * r2; }
                }
            }
        }
    PH_END(10)
    PH_BEGIN(9) { pg8::Gemm g{(const bf16_t*)(ws + WS_B), (const bf16_t*)(ws + WS_WPQ), MTOK, 2048, D};
          pg8::StaticOrder S; S.init(g.M, g.N, G, blockIdx.x);
          pg8::Gemm g8{(const bf16_t*)(ws + WS_HQ8), (const bf16_t*)(ws + WS_BTP8), MTOK, 2048, D / 2};
          EpiRowI8 E{(bf16_t*)(ws + WS_A), 2048, (const float*)(ws + WS_SA8), (const float*)(ws + WS_BTP8 + 2 * MiB)};
          pg8::gemm_phase<EpiRowI8, pg8::StaticOrder, false, true>(lds, g8, S, E, nullptr);
#if FUSE_SCORE
          asm volatile("s_waitcnt vmcnt(0)" ::: "memory"); __syncthreads();
          pg8::Unit u;
          for (int i = 0; S.next(i, u); ++i) peer_score_unit(a, lds, u.pm, u.pn);
#endif
          } PH_END(9)

    PH_BEGIN(11) peer_down(a, lds); PH_END(11)
    PH_BEGIN(12) peer_coef(a); PH_END(12)
    PH_BEGIN(13) peer_up(a, lds); PH_END(13)
    PH_BEGIN(14) peer_final(a); PH_END(14)
}

#ifndef MK_ONE_LAUNCH
#define MK_ONE_LAUNCH 1
#endif
extern "C" void kernel_launch(void* const* d_in, const int* in_sizes, int n_in, void* d_out, int out_size, void* d_ws, size_t ws_size, hipStream_t stream) {
    static int grid = 0;
    if (grid == 0) {
        if (n_in != 24 || out_size != MTOK * D || ws_size < WS_END) { fprintf(stderr, "kernel_launch: unexpected shapes (n_in %d out %d ws %zu)\n", n_in, out_size, ws_size); grid = -1; return; }
        int dev = 0, cus = 0;
        if (hipGetDevice(&dev) != hipSuccess || hipDeviceGetAttribute(&cus, hipDeviceAttributeMultiprocessorCount, dev) != hipSuccess) { grid = -1; return; }
        if (hipFuncSetAttribute((const void*)hybrid_fwd, hipFuncAttributeMaxDynamicSharedMemorySize, LDS_BYTES) != hipSuccess) { fprintf(stderr, "kernel_launch: hipFuncSetAttribute failed\n"); grid = -1; return; }
        int per_cu = 0;
        if (hipOccupancyMaxActiveBlocksPerMultiprocessor(&per_cu, (const void*)hybrid_fwd, NTHREADS, LDS_BYTES) != hipSuccess || per_cu < 1) { fprintf(stderr, "kernel_launch: occupancy query says %d\n", per_cu); }
        (void)hipGetLastError();
        grid = cus;
    }
    if (grid < 0) return;
    (void)hipMemsetAsync((char*)d_ws + WS_BAR, 0, XCD_BAR_WORDS * 4, stream);
    Args a{};
    for (int i = 0; i < 24; ++i) a.in[i] = (const float*)d_in[i];
    a.out = (float*)d_out; a.ws = (unsigned char*)d_ws;
#if MK_ONE_LAUNCH
    a.ph_lo = 0; a.ph_hi = NPHASES;
    hipLaunchKernelGGL(hybrid_fwd, dim3(grid), dim3(NTHREADS), LDS_BYTES, stream, a);
#else
    for (int ph = 0; ph < NPHASES; ++ph) {
        a.ph_lo = ph; a.ph_hi = ph + 1;
        hipLaunchKernelGGL(hybrid_fwd, dim3(grid), dim3(NTHREADS), LDS_BYTES, stream, a);
    }
#endif
}
```
